# Optimizing an MI355X kernel written in HIP

```python
import jax, jax.numpy as jnp
from jax import lax
import numpy as np

D_MODEL = 2048
BATCH = 8
SEQ = 2048
DEPTH = 4

GRID_W = 64
CTX_LEN = 256
HEAD_DIM = 128
D_BRANCH = D_MODEL // 2
N_Q_HEADS = D_BRANCH // HEAD_DIM
N_KV_HEADS = N_Q_HEADS // 4
Q_PER_KV = N_Q_HEADS // N_KV_HEADS
D_KV = N_KV_HEADS * HEAD_DIM
ROPE_THETA = 10000.0
ROPE_PAIRS_PER_AXIS = HEAD_DIM // 4
Q_BLOCK = 128
D_LRU = D_BRANCH
LRU_BLOCKS = 16
LRU_BLOCK_W = D_LRU // LRU_BLOCKS
LRU_C = 8.0
CONV_WIDTH = 4
CONV_LEFT = CONV_WIDTH // 2
D_FOURIER = D_BRANCH
FOURIER_GROUP = 128
N_FOURIER_GROUPS = D_FOURIER // FOURIER_GROUP
N_BRANCHES = 3
D_FF = -(-8 * D_MODEL // (3 * 256)) * 256
D_IN = D_BRANCH + 2 * D_KV + 2 * D_LRU + D_FOURIER
SPLITS = (D_BRANCH, D_BRANCH + D_KV, D_BRANCH + 2 * D_KV,
          D_BRANCH + 2 * D_KV + D_LRU, D_BRANCH + 2 * D_KV + 2 * D_LRU)
NORM_EPS = 1e-6

kernel_name = "hybrid_gated_gqa_rglru_fourier_dit"


def rmsnorm(x, g):
    xf = x.astype(jnp.float32)
    y = xf * lax.rsqrt(jnp.mean(xf * xf, axis=-1, keepdims=True) + NORM_EPS)
    return (y * g.astype(jnp.float32)).astype(x.dtype)


def axial_rope_tables(n):
    rows = n // GRID_W
    row = jnp.repeat(jnp.arange(rows, dtype=jnp.float32), GRID_W)
    col = jnp.tile(jnp.arange(GRID_W, dtype=jnp.float32), rows)
    inv = ROPE_THETA ** (-jnp.arange(ROPE_PAIRS_PER_AXIS, dtype=jnp.float32) / ROPE_PAIRS_PER_AXIS)
    ang = jnp.concatenate([row[:, None] * inv, col[:, None] * inv], axis=-1)
    return jnp.cos(ang), jnp.sin(ang)


def apply_rope(x, cos, sin):
    xf = x.astype(jnp.float32)
    x1, x2 = xf[..., :HEAD_DIM // 2], xf[..., HEAD_DIM // 2:]
    cb, sb = cos[None, :, None, :], sin[None, :, None, :]
    return jnp.concatenate([x1 * cb - x2 * sb, x2 * cb + x1 * sb], axis=-1).astype(x.dtype)


def attend(q, k, v):
    s = jnp.einsum('bqhgd,bkhd->bhgqk', q, k).astype(jnp.float32) * (HEAD_DIM ** -0.5)
    p = jax.nn.softmax(s, axis=-1).astype(v.dtype)
    return jnp.einsum('bhgqk,bkhd->bqhgd', p, v)


def attend_blocks(q, k, v):
    b, t = q.shape[:2]
    nb = t // Q_BLOCK
    qb = jnp.moveaxis(q.reshape(b, nb, Q_BLOCK, N_KV_HEADS, Q_PER_KV, HEAD_DIM), 1, 0)
    ob = lax.map(lambda qq: attend(qq, k, v), qb)
    return jnp.moveaxis(ob, 0, 1).reshape(b, t, D_BRANCH)


def short_conv(u, w, b):
    t = u.shape[1]
    up = jnp.pad(u, ((0, 0), (CONV_LEFT, CONV_WIDTH - 1 - CONV_LEFT), (0, 0)))
    y = b
    for j in range(CONV_WIDTH):
        y = y + up[:, j:j + t] * w[j]
    return y


def rglru_coeffs(u, w_r, b_r, w_i, b_i, lam):
    b, t, _ = u.shape
    ub = u.reshape(b, t, LRU_BLOCKS, LRU_BLOCK_W)
    r = jax.nn.sigmoid((jnp.einsum('btnc,ncd->btnd', ub, w_r).reshape(b, t, D_LRU) + b_r).astype(jnp.float32))
    i = jax.nn.sigmoid((jnp.einsum('btnc,ncd->btnd', ub, w_i).reshape(b, t, D_LRU) + b_i).astype(jnp.float32))
    log_a = -LRU_C * r * jax.nn.softplus(-lam.astype(jnp.float32))
    a = jnp.exp(log_a)
    bx = jnp.sqrt(-jnp.expm1(2.0 * log_a)) * i * u.astype(jnp.float32)
    return a, bx


def linear_scan(a, bx, h0, reverse):
    def step(h, ab):
        h = ab[0] * h + ab[1]
        return h, h
    h_last, hs = lax.scan(step, h0, (jnp.swapaxes(a, 0, 1), jnp.swapaxes(bx, 0, 1)), reverse=reverse)
    return h_last, jnp.swapaxes(hs, 0, 1)


def rglru_bidir(ul, uc, w_r, b_r, w_i, b_i, lam):
    yl = jnp.zeros(ul.shape, jnp.float32)
    yc = jnp.zeros(uc.shape, jnp.float32)
    for d, rev in enumerate((False, True)):
        ac, bc = rglru_coeffs(uc, w_r[d], b_r[d], w_i[d], b_i[d], lam[d])
        al, bl = rglru_coeffs(ul, w_r[d], b_r[d], w_i[d], b_i[d], lam[d])
        h0 = jnp.zeros((uc.shape[0], D_LRU), jnp.float32)
        hc_last, hc = linear_scan(ac, bc, h0, rev)
        _, hl = linear_scan(al, bl, hc_last, rev)
        yl = yl + hl
        yc = yc + hc
    return yl.astype(ul.dtype), yc.astype(uc.dtype)


def fourier_mix(u):
    b, t, _ = u.shape
    uf = u.astype(jnp.float32).reshape(b, t, N_FOURIER_GROUPS, FOURIER_GROUP)
    y = jnp.fft.fft2(uf, axes=(1, 3), norm='ortho').real
    return y.reshape(b, t, D_FOURIER).astype(u.dtype)


def gated_merge(h, y_att, y_rec, y_fou, w_branch, w_gate, b_gate, w_out):
    ys = jnp.stack([y_att, y_rec, y_fou], axis=2)
    br = jnp.einsum('btkc,kcd->btkd', ys, w_branch)
    g = jax.nn.sigmoid(h @ w_gate + b_gate).reshape(h.shape[0], h.shape[1], N_BRANCHES, D_MODEL)
    return jnp.sum(g * br, axis=2) @ w_out


def swiglu(h, w_in, w_out):
    gt, up = jnp.split(h @ w_in, 2, axis=-1)
    return (jax.nn.silu(gt) * up) @ w_out


def setup_inputs(seed: int = 0) -> dict:
    key = jax.random.key(seed)
    ks = jax.random.split(key, 26)
    f32 = jnp.float32

    def nrm(k, shape, scale):
        return scale * jax.random.normal(k, shape, f32)

    u = jax.random.uniform(ks[17], (DEPTH, 2, D_LRU), f32, minval=0.9, maxval=0.999)
    return {
        'x': nrm(ks[0], (BATCH, SEQ, D_MODEL), 1.0),
        'c': nrm(ks[1], (BATCH, D_MODEL), 1.0),
        'ctx': nrm(ks[2], (BATCH, CTX_LEN, D_MODEL), 1.0),
        'c_ctx': nrm(ks[3], (D_MODEL,), 1.0),
        'w_mod': nrm(ks[4], (DEPTH, D_MODEL, 6 * D_MODEL), D_MODEL ** -0.5),
        'b_mod': nrm(ks[5], (DEPTH, 6 * D_MODEL), 0.01),
        'g_norm1': 1.0 + nrm(ks[6], (DEPTH, D_MODEL), 0.02),
        'g_norm2': 1.0 + nrm(ks[7], (DEPTH, D_MODEL), 0.02),
        'w_in': nrm(ks[8], (DEPTH, D_MODEL, D_IN), D_MODEL ** -0.5),
        'q_gain': 1.0 + nrm(ks[9], (DEPTH, HEAD_DIM), 0.02),
        'k_gain': 1.0 + nrm(ks[10], (DEPTH, HEAD_DIM), 0.02),
        'conv_w': nrm(ks[11], (DEPTH, CONV_WIDTH, D_LRU), CONV_WIDTH ** -0.5),
        'conv_b': nrm(ks[12], (DEPTH, D_LRU), 0.01),
        'lru_w_r': nrm(ks[13], (DEPTH, 2, LRU_BLOCKS, LRU_BLOCK_W, LRU_BLOCK_W), LRU_BLOCK_W ** -0.5),
        'lru_b_r': nrm(ks[14], (DEPTH, 2, D_LRU), 0.01),
        'lru_w_i': nrm(ks[15], (DEPTH, 2, LRU_BLOCKS, LRU_BLOCK_W, LRU_BLOCK_W), LRU_BLOCK_W ** -0.5),
        'lru_b_i': nrm(ks[16], (DEPTH, 2, D_LRU), 0.01),
        'lru_lambda': jnp.log(u) - jnp.log1p(-u),
        'w_branch': nrm(ks[18], (DEPTH, N_BRANCHES, D_BRANCH, D_MODEL), D_BRANCH ** -0.5),
        'w_gate': nrm(ks[19], (DEPTH, D_MODEL, N_BRANCHES * D_MODEL), D_MODEL ** -0.5),
        'b_gate': nrm(ks[20], (DEPTH, N_BRANCHES * D_MODEL), 0.01),
        'w_out': nrm(ks[21], (DEPTH, D_MODEL, D_MODEL), D_MODEL ** -0.5),
        'w_ffn_in': nrm(ks[22], (DEPTH, D_MODEL, 2 * D_FF), D_MODEL ** -0.5),
        'w_ffn_out': nrm(ks[23], (DEPTH, D_FF, D_MODEL), D_FF ** -0.5),
        'g_final': 1.0 + nrm(ks[24], (D_MODEL,), 0.02),
    }


def reference(x, c, ctx, c_ctx, w_mod, b_mod, g_norm1, g_norm2, w_in, q_gain, k_gain,
              conv_w, conv_b, lru_w_r, lru_b_r, lru_w_i, lru_b_i, lru_lambda,
              w_branch, w_gate, b_gate, w_out, w_ffn_in, w_ffn_out, g_final):
    b, t = x.shape[0], x.shape[1]
    tc = ctx.shape[1]
    cos, sin = axial_rope_tables(t)
    xc = ctx
    for l in range(DEPTH):
        update_ctx = l < DEPTH - 1
        s1l, sc1l, g1l, s2l, sc2l, g2l = jnp.split(
            (jax.nn.silu(c) @ w_mod[l] + b_mod[l])[:, None, :], 6, axis=-1)
        s1c, sc1c, g1c, s2c, sc2c, g2c = jnp.split(
            jax.nn.silu(c_ctx) @ w_mod[l] + b_mod[l], 6, axis=-1)

        hl = rmsnorm(x, g_norm1[l]) * (1 + sc1l) + s1l
        hc = rmsnorm(xc, g_norm1[l]) * (1 + sc1c) + s1c
        ql, kl, vl, uxl, ugl, ufl = jnp.split(hl @ w_in[l], SPLITS, axis=-1)
        qc, kc, vc, uxc, ugc, ufc = jnp.split(hc @ w_in[l], SPLITS, axis=-1)

        kl = apply_rope(rmsnorm(kl.reshape(b, t, N_KV_HEADS, HEAD_DIM), k_gain[l]), cos, sin)
        kc = rmsnorm(kc.reshape(b, tc, N_KV_HEADS, HEAD_DIM), k_gain[l])
        vl = vl.reshape(b, t, N_KV_HEADS, HEAD_DIM)
        vc = vc.reshape(b, tc, N_KV_HEADS, HEAD_DIM)
        ql = apply_rope(rmsnorm(ql.reshape(b, t, N_Q_HEADS, HEAD_DIM), q_gain[l]), cos, sin)
        ql = ql.reshape(b, t, N_KV_HEADS, Q_PER_KV, HEAD_DIM)
        att_l = attend_blocks(ql, jnp.concatenate([kl, kc], axis=1), jnp.concatenate([vl, vc], axis=1))

        rec_l, rec_c = rglru_bidir(short_conv(uxl, conv_w[l], conv_b[l]),
                                   short_conv(uxc, conv_w[l], conv_b[l]),
                                   lru_w_r[l], lru_b_r[l], lru_w_i[l], lru_b_i[l], lru_lambda[l])
        rec_l = rec_l * jax.nn.gelu(ugl, approximate=True)

        fou_l = fourier_mix(ufl)

        x_mixed = x + g1l * gated_merge(hl, att_l, rec_l, fou_l, w_branch[l], w_gate[l], b_gate[l], w_out[l])
        if update_ctx:
            qc = rmsnorm(qc.reshape(b, tc, N_Q_HEADS, HEAD_DIM), q_gain[l])
            att_c = attend(qc.reshape(b, tc, N_KV_HEADS, Q_PER_KV, HEAD_DIM), kc, vc).reshape(b, tc, D_BRANCH)
            rec_c = rec_c * jax.nn.gelu(ugc, approximate=True)
            xc = xc + g1c * gated_merge(hc, att_c, rec_c, fourier_mix(ufc),
                                        w_branch[l], w_gate[l], b_gate[l], w_out[l])
        x = x_mixed

        x = x + g2l * swiglu(rmsnorm(x, g_norm2[l]) * (1 + sc2l) + s2l, w_ffn_in[l], w_ffn_out[l])
        if update_ctx:
            xc = xc + g2c * swiglu(rmsnorm(xc, g_norm2[l]) * (1 + sc2c) + s2c, w_ffn_in[l], w_ffn_out[l])
    return rmsnorm(x, g_final)
```

```cpp
#include <hip/hip_runtime.h>
#include <cstdio>
#include <cstdint>

namespace pg8 {
#define PG8_LAS __attribute__((address_space(3)))
typedef unsigned short bf16_t;
typedef short bf16x8 __attribute__((ext_vector_type(8)));
typedef float f32x4 __attribute__((ext_vector_type(4)));
typedef float f32x2 __attribute__((ext_vector_type(2)));
typedef unsigned u32x4 __attribute__((ext_vector_type(4)));
typedef unsigned u32x2 __attribute__((ext_vector_type(2)));
constexpr int BM = 256, BK = 64, HALF = 128, HTB = HALF * BK * 2  , STAGE_BYTES = 8 * HTB, NXCD = 8, WGM = 8;

__host__ __device__ __forceinline__ int lds_byte(int r, int c) { const int st = (r >> 4) * 2 + (c >> 5), rr = r & 15, cc = c & 31, ob = rr * 64 + cc * 2; return st * 1024 + (ob ^ (((ob >> 9) & 1) << 5)); }
__host__ __device__ __forceinline__ void stage_rc(int b, int& R, int& C) { const int st = b / 1024, sb = b % 1024, swz = sb ^ (((sb >> 9) & 1) << 5); R = (st >> 1) * 16 + swz / 64; C = (st & 1) * 32 + (swz % 64) / 2; }
__host__ __device__ __forceinline__ int perm32(int rho) { const int n = rho >> 4, i = rho & 15; return 8 * (i >> 2) + 4 * n + (i & 3); }

struct Unit { int pm, pn, aux; const char* A; const char* B; };
struct Gemm { int K, lda, ldb; };

template <class Map> struct TileOrder {
    int nM, nN, nwg, G, c, rep; Map map;
    __device__ __forceinline__ void init(int nM_, int nN_, int G_, int c_, int rep_ = 1) { nM = nM_; nN = nN_; nwg = nM * nN; G = G_; c = c_; rep = rep_; }
    __device__ __forceinline__ bool next(int i, Unit& u) const {
        const int round = i / rep, kb = i - round * rep;
        const long L = (long)round * G + c; if (L >= nwg) return false;
        int wgid = (int)L; { const int q = nwg / NXCD, r = nwg % NXCD, xcd = wgid % NXCD, off = wgid / NXCD; wgid = (xcd < r ? xcd * (q + 1) : r * (q + 1) + (xcd - r) * q) + off; }
        const int nig = WGM * nN, gid = wgid / nig, fm = gid * WGM, gsz = (nM - fm) < WGM ? (nM - fm) : WGM;
        u.pm = fm + ((wgid % nig) % gsz); u.pn = (wgid % nig) / gsz; u.aux = kb; map(u); return true;
    }
    __device__ __forceinline__ void a_ready(const Unit&) const {}
    __device__ __forceinline__ void done(const Unit&) const {}
};

typedef float f32x2_cv __attribute__((ext_vector_type(2))); typedef __bf16 bf16x2_cv __attribute__((ext_vector_type(2)));
__device__ __forceinline__ unsigned cvt_pk_bf16(float lo, float hi) { const f32x2_cv v = {lo, hi}; const bf16x2_cv b = __builtin_convertvector(v, bf16x2_cv); return __builtin_bit_cast(unsigned, b); }
__device__ __forceinline__ float bf2f(unsigned short v) { return __uint_as_float((unsigned)v << 16); }
__device__ __forceinline__ float bflo(unsigned w) { return __uint_as_float(w << 16); }
__device__ __forceinline__ float bfhi(unsigned w) { return __uint_as_float(w & 0xffff0000u); }
__device__ __forceinline__ float sigm(float x) { return __builtin_amdgcn_rcpf(1.0f + __builtin_amdgcn_exp2f(-1.4426950408889634f * x)); }


struct EpiG1 {
    static constexpr bool PERM = true, AFTER_DRAIN = false;
    bf16_t* Y1; bf16_t* G; const float* bgate;
    __device__ __forceinline__ void operator()(const f32x4 (&acc)[2][2][4][2], const Unit& u, int wr, int wc, int fr, int fq) const {
        const int row0 = u.pm * BM + wr * 64 + fr; const bool gate = u.pn >= 18;
        bf16_t* base = gate ? G : Y1; const int ldc = gate ? 6144 : 4608; const int colt = gate ? (u.pn - 18) * BM : u.pn * BM;
        const int col0 = colt + wc * 32 + 8 * fq;
        f32x4 bv[2][2];
#pragma unroll
        for (int bj = 0; bj < 2; ++bj)
#pragma unroll
            for (int n = 0; n < 2; ++n) bv[bj][n] = gate ? *(const f32x4*)(bgate + col0 + bj * HALF + 4 * n) : (f32x4){0.f, 0.f, 0.f, 0.f};
#pragma unroll
        for (int ai = 0; ai < 2; ++ai)
#pragma unroll
            for (int m = 0; m < 4; ++m) { bf16_t* rowp = base + (size_t)(row0 + ai * HALF + m * 16) * ldc + col0;
#pragma unroll
                for (int bj = 0; bj < 2; ++bj) { f32x4 v0 = acc[ai][bj][m][0] + bv[bj][0], v1 = acc[ai][bj][m][1] + bv[bj][1];
                    if (gate) { v0 = (f32x4){sigm(v0[0]), sigm(v0[1]), sigm(v0[2]), sigm(v0[3])}; v1 = (f32x4){sigm(v1[0]), sigm(v1[1]), sigm(v1[2]), sigm(v1[3])}; }
                    u32x4 w; w.x = cvt_pk_bf16(v0[0], v0[1]); w.y = cvt_pk_bf16(v0[2], v0[3]); w.z = cvt_pk_bf16(v1[0], v1[1]); w.w = cvt_pk_bf16(v1[2], v1[3]);
                    *(u32x4*)(rowp + bj * HALF) = w; } }
    }
};
struct EpiF2 {
    static constexpr bool PERM = true, AFTER_DRAIN = false;
    bf16_t* FOU; int rows_per_b, row_off; float scale;
    __device__ __forceinline__ void operator()(const f32x4 (&acc)[2][2][4][2], const Unit& u, int wr, int wc, int fr, int fq) const {
        const int b = u.pn >> 2, q = u.pn & 3;
        const int row0 = row_off + b * rows_per_b + u.pm * BM + wr * 64 + fr, col0 = q * BM + wc * 32 + 8 * fq;
#pragma unroll
        for (int ai = 0; ai < 2; ++ai)
#pragma unroll
            for (int m = 0; m < 4; ++m) { bf16_t* rowp = FOU + (size_t)(row0 + ai * HALF + m * 16) * 1024 + col0;
#pragma unroll
                for (int bj = 0; bj < 2; ++bj) { const f32x4 v0 = acc[ai][bj][m][0] * scale, v1 = acc[ai][bj][m][1] * scale;
                    u32x4 w; w.x = cvt_pk_bf16(v0[0], v0[1]); w.y = cvt_pk_bf16(v0[2], v0[3]); w.z = cvt_pk_bf16(v1[0], v1[1]); w.w = cvt_pk_bf16(v1[2], v1[3]);
                    *(u32x4*)(rowp + bj * HALF) = w; } }
    }
};
struct EpiBr {
    static constexpr bool PERM = true, AFTER_DRAIN = false;
    const bf16_t* G; bf16_t* MG; float* scr;
    __device__ __forceinline__ void operator()(const f32x4 (&acc)[2][2][4][2], const Unit& u, int wr, int wc, int fr, int fq) const {
        const int kb = u.aux, row0 = u.pm * BM + wr * 64 + fr, col0 = u.pn * BM + wc * 32 + 8 * fq, tid = ((wr * 4 + wc) << 6) | (fq << 4) | fr;
#pragma unroll
        for (int ai = 0; ai < 2; ++ai)
#pragma unroll
            for (int m = 0; m < 4; ++m) { const size_t row = (size_t)(row0 + ai * HALF + m * 16);
#pragma unroll
                for (int bj = 0; bj < 2; ++bj) {
                    const u32x4 gw = *(const u32x4*)(G + row * 6144 + kb * 2048 + col0 + bj * HALF);
                    f32x4 v0 = acc[ai][bj][m][0] * (f32x4){bflo(gw.x), bfhi(gw.x), bflo(gw.y), bfhi(gw.y)};
                    f32x4 v1 = acc[ai][bj][m][1] * (f32x4){bflo(gw.z), bfhi(gw.z), bflo(gw.w), bfhi(gw.w)};
                    float* sp = scr + ((size_t)(((ai * 4 + m) * 2 + bj) * 512 + tid)) * 8;
                    if (kb > 0) { v0 = v0 + *(const f32x4*)sp; v1 = v1 + *(const f32x4*)(sp + 4); }
                    if (kb < 2) { *(f32x4*)sp = v0; *(f32x4*)(sp + 4) = v1; }
                    else { u32x4 w; w.x = cvt_pk_bf16(v0[0], v0[1]); w.y = cvt_pk_bf16(v0[2], v0[3]); w.z = cvt_pk_bf16(v1[0], v1[1]); w.w = cvt_pk_bf16(v1[2], v1[3]);
                        *(u32x4*)(MG + row * 2048 + col0 + bj * HALF) = w; } } }
    }
};
struct EpiRes {
    static constexpr bool PERM = false, AFTER_DRAIN = false;
    float* X; const float* gv;
    __device__ __forceinline__ void operator()(const f32x4 (&acc)[2][2][4][2], const Unit& u, int wr, int wc, int fr, int fq) const {
        const int rsel = u.pm < 64 ? (u.pm >> 3) : 8; const float* gr = gv + (size_t)rsel * 12288;
        const int row0 = u.pm * BM + wr * 64 + fr, col0 = u.pn * BM + wc * 32 + 4 * fq;
        f32x4 gvv[2][2];
#pragma unroll
        for (int bj = 0; bj < 2; ++bj)
#pragma unroll
            for (int n = 0; n < 2; ++n) gvv[bj][n] = *(const f32x4*)(gr + col0 + bj * HALF + n * 16);
#pragma unroll
        for (int ai = 0; ai < 2; ++ai)
#pragma unroll
            for (int m = 0; m < 4; ++m) { float* rowp = X + (size_t)(row0 + ai * HALF + m * 16) * 2048 + col0;
#pragma unroll
                for (int bj = 0; bj < 2; ++bj)
#pragma unroll
                    for (int n = 0; n < 2; ++n) { float* p = rowp + bj * HALF + n * 16; *(f32x4*)p = *(const f32x4*)p + gvv[bj][n] * acc[ai][bj][m][n]; } }
    }
};
struct EpiSwi {
    static constexpr bool PERM = true, AFTER_DRAIN = false;
    bf16_t* ACT;
    __device__ __forceinline__ void operator()(const f32x4 (&acc)[2][2][4][2], const Unit& u, int wr, int wc, int fr, int fq) const {
        const int row0 = u.pm * BM + wr * 64 + fr, col0 = u.pn * HALF + wc * 32 + 8 * fq;
#pragma unroll
        for (int ai = 0; ai < 2; ++ai)
#pragma unroll
            for (int m = 0; m < 4; ++m) { bf16_t* rowp = ACT + (size_t)(row0 + ai * HALF + m * 16) * 5632 + col0;
                f32x4 o[2];
#pragma unroll
                for (int n = 0; n < 2; ++n) { const f32x4 g = acc[ai][0][m][n], up = acc[ai][1][m][n];
                    o[n] = (f32x4){g[0] * sigm(g[0]) * up[0], g[1] * sigm(g[1]) * up[1], g[2] * sigm(g[2]) * up[2], g[3] * sigm(g[3]) * up[3]}; }
                u32x4 w; w.x = cvt_pk_bf16(o[0][0], o[0][1]); w.y = cvt_pk_bf16(o[0][2], o[0][3]); w.z = cvt_pk_bf16(o[1][0], o[1][1]); w.w = cvt_pk_bf16(o[1][2], o[1][3]);
                *(u32x4*)rowp = w; }
    }
};

template <class Epi, class Sched, bool ALIGN_EPI = false, bool SP2 = false>
__device__ __forceinline__ void gemm_phase(PG8_LAS unsigned char* lds, const Gemm g, const Sched& S, const Epi& E, const int tid) {
    const int wid = __builtin_amdgcn_readfirstlane(tid >> 6), lane = tid & 63, wr = wid >> 2, wc = wid & 3, fr = lane & 15, fq = lane >> 4;
    const int K = g.K, nt = K / BK;
    unsigned voffA[2], voffB[2];
#pragma unroll
    for (int i = 0; i < 2; ++i) { int R, C; stage_rc(tid * 16 + i * 8192, R, C); const int Rb = Epi::PERM ? ((R & ~31) + perm32(R & 31)) : R;
        voffA[i] = (unsigned)(R * g.lda + C) * 2u; voffB[i] = (unsigned)(Rb * g.ldb + C) * 2u; }
    const size_t kstep = (size_t)(BK * 2);
    const size_t hstepA = (size_t)HALF * g.lda * 2, hstepB = (size_t)HALF * g.ldb * 2;
    const unsigned ldsw = (unsigned)wid * 1024u;
    const int aoff = lds_byte(wr * 64 + fr, fq * 8), boff = lds_byte(wc * 32 + fr, fq * 8);
#define PG8_SA(b, h) (((b) * 2 + (h)) * HTB)
#define PG8_SB(b, h) ((4 + (b) * 2 + (h)) * HTB)
#define PG8_STAGE(bufoff, gbase, voff) do { _Pragma("unroll") for (int _i = 0; _i < 2; ++_i) \
        __builtin_amdgcn_global_load_lds((const unsigned*)((const char*)(gbase) + (voff)[_i]), (PG8_LAS unsigned*)(lds + (bufoff) + ldsw + _i * 8192), 16, 0, 0); } while (0)
#define PG8_LDA(dst, b, h) do { _Pragma("unroll") for (int m = 0; m < 4; ++m) _Pragma("unroll") for (int k = 0; k < 2; ++k) dst[m][k] = *(const PG8_LAS bf16x8*)(lds + PG8_SA(b, h) + aoff + m * 2048 + k * 1024); } while (0)
#define PG8_LDB(dst, b, h) do { _Pragma("unroll") for (int n = 0; n < 2; ++n) _Pragma("unroll") for (int k = 0; k < 2; ++k) dst[n][k] = *(const PG8_LAS bf16x8*)(lds + PG8_SB(b, h) + boff + n * 2048 + k * 1024); } while (0)
#define PG8_MMA(ai, bj, At, Bt) do { __builtin_amdgcn_s_setprio(1); _Pragma("unroll") for (int m = 0; m < 4; ++m) _Pragma("unroll") for (int n = 0; n < 2; ++n) _Pragma("unroll") for (int k = 0; k < 2; ++k) \
        acc[ai][bj][m][n] = __builtin_amdgcn_mfma_f32_16x16x32_bf16(Bt[n][k], At[m][k], acc[ai][bj][m][n], 0, 0, 0); __builtin_amdgcn_s_setprio(0); } while (0)
#define PG8_WAIT_V(n) asm volatile("s_waitcnt vmcnt(" #n ")" ::: "memory")
#define PG8_WAIT_L(n) asm volatile("s_waitcnt lgkmcnt(" #n ")" ::: "memory")
#define PG8_BAR __builtin_amdgcn_s_barrier()
#define PG8_SCHED __builtin_amdgcn_sched_barrier(0)
    Unit cur, nxt; int ui = 0;
    if (!S.next(0, cur)) return;
    f32x4 acc[2][2][4][2];
#pragma unroll
    for (int a = 0; a < 2; ++a)
#pragma unroll
        for (int b = 0; b < 2; ++b)
#pragma unroll
            for (int m = 0; m < 4; ++m)
#pragma unroll
                for (int n = 0; n < 2; ++n) acc[a][b][m][n] = (f32x4){0.f, 0.f, 0.f, 0.f};
    bf16x8 At[4][2], B0[2][2], B1[2][2];
    const char* cA = cur.A; const char* cB = cur.B;
    S.a_ready(cur);
    if constexpr (SP2) {
        PG8_STAGE(PG8_SB(0, 0), cB, voffB); PG8_STAGE(PG8_SB(0, 1), cB + hstepB, voffB); PG8_STAGE(PG8_SA(0, 0), cA, voffA); PG8_STAGE(PG8_SA(0, 1), cA + hstepA, voffA);
        if (wr == 1) PG8_BAR;
        PG8_WAIT_V(2); PG8_BAR;
        PG8_STAGE(PG8_SB(1, 0), cB + kstep, voffB); PG8_STAGE(PG8_SA(1, 0), cA + kstep, voffA); PG8_STAGE(PG8_SB(1, 1), cB + hstepB + kstep, voffB);
        PG8_WAIT_V(6); PG8_BAR;
    } else {
        PG8_STAGE(PG8_SB(0, 0), cB, voffB); PG8_STAGE(PG8_SA(0, 0), cA, voffA); PG8_STAGE(PG8_SB(0, 1), cB + hstepB, voffB); PG8_STAGE(PG8_SA(0, 1), cA + hstepA, voffA);
        if (wr == 1) PG8_BAR;
        PG8_WAIT_V(4); PG8_BAR;
        PG8_STAGE(PG8_SB(1, 0), cB + kstep, voffB); PG8_STAGE(PG8_SA(1, 0), cA + kstep, voffA); PG8_STAGE(PG8_SB(1, 1), cB + hstepB + kstep, voffB);
        PG8_WAIT_V(6); PG8_BAR;
    }
    for (;;) {
        const bool has_next = S.next(ui + 1, nxt);
        const char* nA = has_next ? nxt.A : cA; const char* nB = has_next ? nxt.B : cB;
        for (int t = 0; t < nt; t += 2) {
            const bool last = (t == nt - 2);
            const char* a1 = cA + (size_t)(t + 1) * kstep;
            const char* a2 = last ? nA : cA + (size_t)(t + 2) * kstep; const char* b2 = last ? nB : cB + (size_t)(t + 2) * kstep;
            const char* a3 = a2 + kstep; const char* b3 = b2 + kstep;
            if (last && has_next) S.a_ready(nxt);
            if constexpr (SP2) {
            PG8_LDB(B0, 0, 0); PG8_LDB(B1, 0, 1); PG8_SCHED; PG8_LDA(At, 0, 0); PG8_STAGE(PG8_SA(1, 1), a1 + hstepA, voffA);
            PG8_WAIT_V(8); PG8_WAIT_L(0); PG8_BAR; PG8_MMA(0, 0, At, B0); PG8_MMA(0, 1, At, B1); PG8_BAR; PG8_SCHED;
            PG8_LDA(At, 0, 1); PG8_STAGE(PG8_SB(0, 0), b2, voffB); PG8_STAGE(PG8_SB(0, 1), b2 + hstepB, voffB); PG8_STAGE(PG8_SA(0, 0), a2, voffA);
            PG8_WAIT_V(8); PG8_WAIT_L(0); PG8_BAR; PG8_MMA(1, 0, At, B0); PG8_MMA(1, 1, At, B1); PG8_BAR; PG8_SCHED;
            PG8_LDB(B0, 1, 0); PG8_LDB(B1, 1, 1); PG8_SCHED; PG8_LDA(At, 1, 0); PG8_STAGE(PG8_SA(0, 1), a2 + hstepA, voffA);
            PG8_WAIT_V(8); PG8_WAIT_L(0); PG8_BAR; PG8_MMA(0, 0, At, B0); PG8_MMA(0, 1, At, B1); PG8_BAR; PG8_SCHED;
            PG8_LDA(At, 1, 1); PG8_STAGE(PG8_SB(1, 0), b3, voffB); PG8_STAGE(PG8_SB(1, 1), b3 + hstepB, voffB); PG8_STAGE(PG8_SA(1, 0), a3, voffA);
            PG8_WAIT_V(8); PG8_WAIT_L(0); PG8_BAR; PG8_MMA(1, 0, At, B0); PG8_MMA(1, 1, At, B1); PG8_BAR; PG8_SCHED;
            } else {
            PG8_LDB(B0, 0, 0); PG8_SCHED; PG8_LDA(At, 0, 0); PG8_STAGE(PG8_SA(1, 1), a1 + hstepA, voffA);
            PG8_WAIT_L(8); PG8_BAR; PG8_WAIT_L(0); PG8_MMA(0, 0, At, B0); PG8_BAR; PG8_SCHED;
            PG8_LDB(B1, 0, 1); PG8_STAGE(PG8_SB(0, 0), b2, voffB);
            PG8_BAR; PG8_WAIT_L(0); PG8_MMA(0, 1, At, B1); PG8_BAR;
            PG8_LDA(At, 0, 1); PG8_STAGE(PG8_SA(0, 0), a2, voffA);
            PG8_BAR; PG8_WAIT_L(0); PG8_MMA(1, 0, At, B0); PG8_BAR; PG8_SCHED;
            PG8_STAGE(PG8_SB(0, 1), b2 + hstepB, voffB);
            PG8_WAIT_V(6); PG8_BAR; PG8_MMA(1, 1, At, B1); PG8_BAR;
            PG8_LDB(B0, 1, 0); PG8_SCHED; PG8_LDA(At, 1, 0); PG8_STAGE(PG8_SA(0, 1), a2 + hstepA, voffA);
            PG8_WAIT_L(8); PG8_BAR; PG8_WAIT_L(0); PG8_MMA(0, 0, At, B0); PG8_BAR; PG8_SCHED;
            PG8_LDB(B1, 1, 1); PG8_STAGE(PG8_SB(1, 0), b3, voffB);
            PG8_BAR; PG8_WAIT_L(0); PG8_MMA(0, 1, At, B1); PG8_BAR;
            PG8_LDA(At, 1, 1); PG8_STAGE(PG8_SA(1, 0), a3, voffA);
            PG8_BAR; PG8_WAIT_L(0); PG8_MMA(1, 0, At, B0); PG8_BAR; PG8_SCHED;
            PG8_STAGE(PG8_SB(1, 1), b3 + hstepB, voffB);
            PG8_WAIT_V(6); PG8_BAR; PG8_MMA(1, 1, At, B1); PG8_BAR;
            }
        }
        if constexpr (ALIGN_EPI) { if (wr == 0) PG8_BAR; }
        if constexpr (!Epi::AFTER_DRAIN) { E(acc, cur, wr, wc, fr, fq); S.done(cur); }
        if (!has_next) break;
#pragma unroll
        for (int a = 0; a < 2; ++a)
#pragma unroll
            for (int b = 0; b < 2; ++b)
#pragma unroll
                for (int m = 0; m < 4; ++m)
#pragma unroll
                    for (int n = 0; n < 2; ++n) acc[a][b][m][n] = (f32x4){0.f, 0.f, 0.f, 0.f};
        cur = nxt; cA = nA; cB = nB; ++ui;
        if constexpr (ALIGN_EPI) { if (wr == 1) PG8_BAR; }
    }
    PG8_WAIT_V(0);
    if constexpr (!ALIGN_EPI) { if (wr == 0) PG8_BAR; }
    PG8_BAR;
    if constexpr (Epi::AFTER_DRAIN) { E.fused(acc, cur, wr, wc, fr, fq, lds, wid, lane); S.done(cur); }
#undef PG8_SA
#undef PG8_SB
#undef PG8_STAGE
#undef PG8_LDA
#undef PG8_LDB
#undef PG8_MMA
#undef PG8_WAIT_V
#undef PG8_WAIT_L
#undef PG8_BAR
#undef PG8_SCHED
}
}

namespace att {
typedef unsigned short bf16_t;
using bf16x8 = __attribute__((ext_vector_type(8))) short;
using s16x4  = __attribute__((ext_vector_type(4))) short;
using f32x16 = __attribute__((ext_vector_type(16))) float;
using f32x4  = __attribute__((ext_vector_type(4))) float;
using u32x4  = __attribute__((ext_vector_type(4))) unsigned;
constexpr int D = 128, NW = 8, QBLK = 32, KVBLK = 64;
constexpr float SCALE = 0.088388347648318440f;
constexpr float THR = 8.f;
constexpr int SDEPTH = 2;
constexpr size_t SHM_V = KVBLK * D * 2, SHM_K = KVBLK * D * 2, SHM_ATTN = 2 * SHM_V + 2 * SHM_K + NW * 64 * 4;
#define KSWZ(row, colB) ((row) * 256 + ((colB) ^ (((row) & 7) << 4)))
#define SBAR() __builtin_amdgcn_sched_barrier(0)
__device__ __forceinline__ int crow(int r, int hi) { return (r & 3) + 8 * (r >> 2) + 4 * hi; }
__device__ __forceinline__ unsigned cvtpk(float lo, float hi) { unsigned r; asm volatile("v_cvt_pk_bf16_f32 %0, %1, %2" : "=v"(r) : "v"(lo), "v"(hi)); return r; }
__device__ __forceinline__ bf16x8 ld8(const bf16_t* p) { return *reinterpret_cast<const bf16x8*>(p); }
__device__ __forceinline__ float b2f(short v) { return __uint_as_float(((unsigned)(unsigned short)v) << 16); }

__device__ __forceinline__ void partialSM(f32x16& p0, f32x16& p1, float& m_reg, float& mn, float& alpha) {
  constexpr float C = SCALE * 1.4426950408889634f;
  float pmax = p0[0]; for (int r = 1; r < 16; ++r) pmax = fmaxf(pmax, p0[r]); for (int r = 0; r < 16; ++r) pmax = fmaxf(pmax, p1[r]);
  { auto rr = __builtin_amdgcn_permlane32_swap(__float_as_uint(pmax), __float_as_uint(pmax), false, false);
    pmax = fmaxf(__uint_as_float(rr[0]), __uint_as_float(rr[1])); }
  if (__builtin_expect(__all(pmax - m_reg <= THR / SCALE), 1)) { mn = m_reg; alpha = 1.f; }
  else { mn = fmaxf(m_reg, pmax); alpha = __builtin_amdgcn_exp2f((m_reg - mn) * C); m_reg = mn; }
  float mnC = -mn * C;
  for (int r = 0; r < 16; ++r) p0[r] = fmaf(p0[r], C, mnC); for (int r = 0; r < 16; ++r) p1[r] = fmaf(p1[r], C, mnC);
  for (int r = 0; r < 16; ++r) p0[r] = __builtin_amdgcn_exp2f(p0[r]);
}
__device__ __forceinline__ void finishSM(f32x16& p0, f32x16& p1, float alpha, float& l_reg, bf16x8& pa0, bf16x8& pa1, bf16x8& pa2, bf16x8& pa3) {
  for (int r = 0; r < 16; ++r) p1[r] = __builtin_amdgcn_exp2f(p1[r]);
  float ps = 0; for (int r = 0; r < 16; ++r) ps += p0[r]; for (int r = 0; r < 16; ++r) ps += p1[r];
  { auto rr = __builtin_amdgcn_permlane32_swap(__float_as_uint(ps), __float_as_uint(ps), false, false);
    ps = __uint_as_float(rr[0]) + __uint_as_float(rr[1]); }
  l_reg = l_reg * alpha + ps;
#define PK4(P, BASE, OUT) do { unsigned a0 = cvtpk(P[BASE + 0], P[BASE + 1]), a1 = cvtpk(P[BASE + 2], P[BASE + 3]);   \
    unsigned b0 = cvtpk(P[BASE + 4], P[BASE + 5]), b1 = cvtpk(P[BASE + 6], P[BASE + 7]);                              \
    auto r0 = __builtin_amdgcn_permlane32_swap(a0, b0, false, false); auto r1 = __builtin_amdgcn_permlane32_swap(a1, b1, false, false); \
    u32x4 w = {r0[0], r1[0], r0[1], r1[1]}; OUT = *reinterpret_cast<bf16x8*>(&w); } while (0)
  PK4(p0, 0, pa0); PK4(p0, 8, pa1); PK4(p1, 0, pa2); PK4(p1, 8, pa3);
#undef PK4
}
__device__ __forceinline__ void qkt(f32x16& p0, f32x16& p1, const bf16_t* Ks, const bf16x8* qr, int r32, int hi) {
  p0 = f32x16{}; p1 = f32x16{};
  for (int d0 = 0; d0 < 8; ++d0) { int cb = (d0 * 16 + hi * 8) * 2;
    bf16x8 b0 = *reinterpret_cast<const bf16x8*>((const char*)Ks + KSWZ(r32, cb));
    bf16x8 b1 = *reinterpret_cast<const bf16x8*>((const char*)Ks + KSWZ(32 + r32, cb));
    p0 = __builtin_amdgcn_mfma_f32_32x32x16_bf16(b0, qr[d0], p0, 0, 0, 0);
    p1 = __builtin_amdgcn_mfma_f32_32x32x16_bf16(b1, qr[d0], p1, 0, 0, 0); }
}
__device__ __forceinline__ int v_st(int k, int c) { const int kk = (k & ~0xC) | ((k & 4) << 1) | ((k & 8) >> 1); return ((kk >> 3) * 4 + (c >> 5)) * 512 + ((kk & 7) * 32 + (c & 31)) * 2; }
__device__ __forceinline__ int v_rd_base(int lane) { return ((lane & 3) << 3) | (((lane >> 2) & 3) << 6) | (((lane >> 4) & 1) << 5) | (((lane >> 5) & 1) << 8); }
constexpr int v_rd_off(int d0, int ks, int half) { return d0 * 512 + ks * 4096 + half * 2048; }
template <int OFF> __device__ __forceinline__ s16x4 tr_read(int vb) {
  s16x4 r; asm volatile("ds_read_b64_tr_b16 %0, %1 offset:%2" : "=&v"(r) : "v"(vb), "i"(OFF) : "memory"); return r;
}
template <int D0> __device__ __forceinline__ void pv_one(f32x16& od, int vb, bf16x8 pa0, bf16x8 pa1, bf16x8 pa2, bf16x8 pa3) {
  const s16x4 l0 = tr_read<v_rd_off(D0, 0, 0)>(vb), h0 = tr_read<v_rd_off(D0, 0, 1)>(vb), l1 = tr_read<v_rd_off(D0, 1, 0)>(vb), h1 = tr_read<v_rd_off(D0, 1, 1)>(vb);
  const s16x4 l2 = tr_read<v_rd_off(D0, 2, 0)>(vb), h2 = tr_read<v_rd_off(D0, 2, 1)>(vb), l3 = tr_read<v_rd_off(D0, 3, 0)>(vb), h3 = tr_read<v_rd_off(D0, 3, 1)>(vb);
  asm volatile("s_waitcnt lgkmcnt(0)" ::: "memory"); SBAR();
#define PK(L, H) (bf16x8){L[0], L[1], L[2], L[3], H[0], H[1], H[2], H[3]}
  od = __builtin_amdgcn_mfma_f32_32x32x16_bf16(pa0, PK(l0, h0), od, 0, 0, 0);
  od = __builtin_amdgcn_mfma_f32_32x32x16_bf16(pa1, PK(l1, h1), od, 0, 0, 0);
  od = __builtin_amdgcn_mfma_f32_32x32x16_bf16(pa2, PK(l2, h2), od, 0, 0, 0);
  od = __builtin_amdgcn_mfma_f32_32x32x16_bf16(pa3, PK(l3, h3), od, 0, 0, 0);
#undef PK
}
__device__ __forceinline__ void pv_d0(f32x16* o, int vb, bf16x8 pa0, bf16x8 pa1, bf16x8 pa2, bf16x8 pa3) {
  pv_one<0>(o[0], vb, pa0, pa1, pa2, pa3); pv_one<1>(o[1], vb, pa0, pa1, pa2, pa3); pv_one<2>(o[2], vb, pa0, pa1, pa2, pa3); pv_one<3>(o[3], vb, pa0, pa1, pa2, pa3);
}

__device__ __forceinline__ void attn_unit(const bf16_t* __restrict__ Qb, int ldq, const bf16_t* __restrict__ K0, const bf16_t* __restrict__ K1, const bf16_t* __restrict__ V0, const bf16_t* __restrict__ V1,
                                          int n0, int NT, int ldk, int ldv, bf16_t* __restrict__ Ob, int ldo, const float* __restrict__ qgain, const float* __restrict__ rope_cs, char* lds, const int tid) {
  const int wid = tid >> 6, lane = tid & 63, r32 = lane & 31, hi = lane >> 5;
  bf16_t* V_lds = (bf16_t*)lds; bf16_t* K_lds = (bf16_t*)(lds + 2 * SHM_V);
  float* ws = (float*)(lds + 2 * SHM_V + 2 * SHM_K) + wid * 64; float* li_l = ws; float* al_l = ws + 32;
  float m_reg = -1e30f, l_reg = 0; f32x16 o[4] = {}; bf16x8 qr[8];
  const bf16_t* Qw = Qb + (long)(wid * QBLK + r32) * ldq + hi * 8;
#pragma unroll
  for (int d0 = 0; d0 < 8; ++d0) qr[d0] = ld8(Qw + d0 * 16);
  {
    float ss = 0.f;
#pragma unroll
    for (int d0 = 0; d0 < 8; ++d0)
#pragma unroll
      for (int j = 0; j < 8; ++j) { const float f = b2f(qr[d0][j]); ss += f * f; }
    { auto rr = __builtin_amdgcn_permlane32_swap(__float_as_uint(ss), __float_as_uint(ss), false, false); ss = __uint_as_float(rr[0]) + __uint_as_float(rr[1]); }
    const float rstd = 1.0f / sqrtf(ss * (1.0f / 128.0f) + 1e-6f);
#pragma unroll
    for (int d0 = 0; d0 < 4; ++d0) {
      const int i0 = d0 * 16 + hi * 8;
      const f32x4 ga0 = *(const f32x4*)(qgain + i0), ga1 = *(const f32x4*)(qgain + i0 + 4), gb0 = *(const f32x4*)(qgain + 64 + i0), gb1 = *(const f32x4*)(qgain + 64 + i0 + 4);
      float a[8], b[8];
#pragma unroll
      for (int j = 0; j < 8; ++j) { a[j] = b2f(qr[d0][j]) * rstd * (j < 4 ? ga0[j & 3] : ga1[j & 3]); b[j] = b2f(qr[d0 + 4][j]) * rstd * (j < 4 ? gb0[j & 3] : gb1[j & 3]); }
      if (rope_cs) {
        const float* cp = rope_cs + (long)(wid * QBLK + r32) * 64 + i0;
        const f32x4 c0 = *(const f32x4*)cp, c1 = *(const f32x4*)(cp + 4), s0 = *(const f32x4*)(cp + 2048 * 64), s1 = *(const f32x4*)(cp + 2048 * 64 + 4);
#pragma unroll
        for (int j = 0; j < 8; ++j) { const float c = j < 4 ? c0[j & 3] : c1[j & 3], s = j < 4 ? s0[j & 3] : s1[j & 3]; const float na = a[j] * c - b[j] * s, nb = b[j] * c + a[j] * s; a[j] = na; b[j] = nb; }
      }
      u32x4 wa = {cvtpk(a[0], a[1]), cvtpk(a[2], a[3]), cvtpk(a[4], a[5]), cvtpk(a[6], a[7])}, wb = {cvtpk(b[0], b[1]), cvtpk(b[2], b[3]), cvtpk(b[4], b[5]), cvtpk(b[6], b[7])};
      qr[d0] = *reinterpret_cast<bf16x8*>(&wa); qr[d0 + 4] = *reinterpret_cast<bf16x8*>(&wb);
    }
  }
  const int sr = tid >> 4, sc = (tid & 15) * 8, vst0 = v_st(sr, sc), vst1 = v_st(32 + sr, sc);
  const int vb0 = (int)(uintptr_t)V_lds + v_rd_base(lane);
  struct { bf16x8 vs0, vs1, ks0, ks1; } sr_[SDEPTH];
#define SLOAD(i, tile) do { const int tl_ = (tile); const bf16_t* kp_ = tl_ < n0 ? K0 + (long)tl_ * KVBLK * ldk : K1 + (long)(tl_ - n0) * KVBLK * ldk; \
    const bf16_t* vp_ = tl_ < n0 ? V0 + (long)tl_ * KVBLK * ldv : V1 + (long)(tl_ - n0) * KVBLK * ldv; \
    sr_[i].vs0 = ld8(vp_ + (long)sr * ldv + sc); sr_[i].vs1 = ld8(vp_ + (long)(32 + sr) * ldv + sc); \
    sr_[i].ks0 = ld8(kp_ + (long)sr * ldk + sc); sr_[i].ks1 = ld8(kp_ + (long)(32 + sr) * ldk + sc); } while (0)
#define SWRITE(b, i) do { *(bf16x8*)((char*)V_lds + (b) * SHM_V + vst0) = sr_[i].vs0;          \
    *(bf16x8*)((char*)V_lds + (b) * SHM_V + vst1) = sr_[i].vs1; int kc = sc * 2;               \
    *(bf16x8*)((char*)K_lds + (b) * SHM_K + KSWZ(sr, kc)) = sr_[i].ks0;                       \
    *(bf16x8*)((char*)K_lds + (b) * SHM_K + KSWZ(32 + sr, kc)) = sr_[i].ks1; } while (0)
#define SWAIT() asm volatile("s_waitcnt vmcnt(4)" ::: "memory")
#define RESC(a) do { if (__any((a) < 1.f)) { if (hi == 0) al_l[r32] = (a); asm volatile("s_waitcnt lgkmcnt(0)" ::: "memory"); \
    for (int d = 0; d < 4; ++d) for (int r = 0; r < 16; ++r) o[d][r] *= al_l[crow(r, hi)]; } } while (0)
  f32x16 pA0, pA1, pB0, pB1; float mnA, mnB, alA, alB; bf16x8 pa0, pa1, pa2, pa3;
  constexpr int SE = 0, SO = SDEPTH - 1;
  SLOAD(SE, 0); asm volatile("s_waitcnt vmcnt(0)" ::: "memory"); SWRITE(0, SE); __syncthreads();
  qkt(pA0, pA1, K_lds, qr, r32, hi); partialSM(pA0, pA1, m_reg, mnA, alA);
  SLOAD(SO, 1); if (2 < NT) SLOAD(SE, 2);
  SWAIT(); SWRITE(1, SO); __syncthreads();
  for (int j = 1; j + 1 < NT; j += 2) {
    SBAR(); qkt(pB0, pB1, (bf16_t*)((char*)K_lds + SHM_K), qr, r32, hi);
    finishSM(pA0, pA1, alA, l_reg, pa0, pa1, pa2, pa3); SBAR();
    SLOAD(SO, j + SDEPTH); SBAR();
    pv_d0(o, vb0, pa0, pa1, pa2, pa3); partialSM(pB0, pB1, m_reg, mnB, alB);
    __syncthreads(); SWAIT(); SWRITE(0, SE);
    RESC(alB); __syncthreads();
    SBAR(); qkt(pA0, pA1, K_lds, qr, r32, hi);
    finishSM(pB0, pB1, alB, l_reg, pa0, pa1, pa2, pa3); SBAR();
    if (j + 3 < NT) SLOAD(SE, j + 1 + SDEPTH); SBAR();
    pv_d0(o, vb0 + (int)SHM_V, pa0, pa1, pa2, pa3); partialSM(pA0, pA1, m_reg, mnA, alA);
    __syncthreads(); SWAIT(); SWRITE(1, SO);
    RESC(alA); __syncthreads();
  }
  SBAR(); qkt(pB0, pB1, (bf16_t*)((char*)K_lds + SHM_K), qr, r32, hi);
  finishSM(pA0, pA1, alA, l_reg, pa0, pa1, pa2, pa3); SBAR();
  pv_d0(o, vb0, pa0, pa1, pa2, pa3); partialSM(pB0, pB1, m_reg, mnB, alB);
  __syncthreads(); RESC(alB);
  finishSM(pB0, pB1, alB, l_reg, pa0, pa1, pa2, pa3); SBAR();
  pv_d0(o, vb0 + (int)SHM_V, pa0, pa1, pa2, pa3);
  if (hi == 0) li_l[r32] = l_reg; asm volatile("s_waitcnt lgkmcnt(0)" ::: "memory");
  float rli[16];
#pragma unroll
  for (int r = 0; r < 16; ++r) rli[r] = __builtin_amdgcn_rcpf(li_l[crow(r, hi)]);
  bf16_t* Ow = Ob + (long)(wid * QBLK) * ldo;
#pragma unroll
  for (int r = 0; r < 16; ++r) { const int orow = crow(r, hi);
#pragma unroll
    for (int d0 = 0; d0 < 4; ++d0) Ow[(long)orow * ldo + d0 * 32 + r32] = (bf16_t)(cvtpk(o[d0][r] * rli[r], 0.f) & 0xffffu); }
#undef SLOAD
#undef SWRITE
#undef SWAIT
#undef RESC
  __syncthreads();
}
#undef KSWZ
#undef SBAR
}

constexpr int NWAVES = 8;
constexpr int DM = 2048, NB = 8, SEQ = 2048, DEPTH = 4, CTXL = 256, DBR = 1024, DFF = 5632;
constexpr int ML = NB * SEQ, MC = NB * CTXL, MT = ML + MC;
constexpr int LDY = 4608, YQ = 0, YK = 1024, YV = 1280, YUX = 1536, YUG = 2560, YUF = 3584;
constexpr int LDG = 6144;
constexpr float NEPS = 1e-6f;
constexpr size_t MiB = 1u << 20;
constexpr size_t WS_CTL = 0, CTL_ZERO_BYTES = 1 * MiB;
constexpr size_t WS_MOD = 1 * MiB, WS_ROPE = 3 * MiB, WS_WLT = 4 * MiB, WS_CST = 6 * MiB, WS_DFTC = 7 * MiB, WS_DFTL = 8 * MiB;
constexpr size_t WS_W = 24 * MiB, W_LAYER = 128 * MiB, WO_W1 = 0, WO_WB = 42 * MiB, WO_WO = 54 * MiB, WO_WFI = 62 * MiB, WO_WFO = 106 * MiB;
constexpr size_t WS_X = 536 * MiB, WS_H = 680 * MiB, WS_Y1 = 752 * MiB, WS_G = 914 * MiB, WS_ACT = WS_G, WS_KN = 1130 * MiB;
constexpr size_t WS_PTL = 1139 * MiB, WS_BRS = WS_PTL, WS_PTC = 1203 * MiB, WS_ATT = 1211 * MiB, WS_REC = 1247 * MiB, WS_FOU = 1283 * MiB, WS_MG = 1319 * MiB, WS_END = 1391 * MiB;
static_assert((size_t)MT * DBR * 2 == 36 * MiB && (size_t)MT * LDY * 2 == 162 * MiB && (size_t)MT * LDG * 2 == 216 * MiB && (size_t)MT * DM * 4 == 144 * MiB, "ws map");
constexpr int CW_BAR = 4096;
constexpr int RING_BYTES = 147456;
constexpr int LDSCTL_OFF = RING_BYTES, MISC_OFF = LDSCTL_OFF + 320;
constexpr int LDS_BYTES = RING_BYTES + 1024;

#define GAS __attribute__((address_space(1)))
#define LAS __attribute__((address_space(3)))
typedef unsigned short bf16;
typedef unsigned v4u __attribute__((ext_vector_type(4)));
typedef float f32x4 __attribute__((ext_vector_type(4)));
typedef short bf16x8 __attribute__((ext_vector_type(8)));
typedef GAS unsigned gu32;
typedef GAS unsigned long long gu64;
#define RLX_AGENT __ATOMIC_RELAXED, __HIP_MEMORY_SCOPE_AGENT
#define LDS_WAIT() asm volatile("s_waitcnt lgkmcnt(0)" ::: "memory")
#define VM_WAIT() asm volatile("s_waitcnt vmcnt(0)" ::: "memory")
__device__ __forceinline__ unsigned long long rt() { return __builtin_amdgcn_s_memrealtime(); }
__device__ __forceinline__ unsigned f2bf(float f) { unsigned u = __builtin_bit_cast(unsigned, f); return (u + 0x7fffu + ((u >> 16) & 1u)) >> 16; }
__device__ __forceinline__ unsigned pk2(float lo, float hi) { return f2bf(lo) | (f2bf(hi) << 16); }

#define XB_TMO      128
#define XB_XCNT(j)  (256  + 64 * (j))
#define XB_XSUB(j)  (1280 + 64 * (j))
#define XB_XGEN(j)  (2304 + 64 * (j))
#define XB_TOP      3328
#define XB_TOPGEN   3392
#define XCD_BAR_WORDS 3456
#define XB_SPIN_CAP (1u << 18)

__device__ __forceinline__ unsigned xb_ld(unsigned* p)              { return __hip_atomic_load(p, __ATOMIC_RELAXED, __HIP_MEMORY_SCOPE_AGENT); }
__device__ __forceinline__ unsigned xb_add(unsigned* p, unsigned v) { return __hip_atomic_fetch_add(p, v, __ATOMIC_RELAXED, __HIP_MEMORY_SCOPE_AGENT); }
__device__ __forceinline__ unsigned xb_xcc_id() { return (unsigned)__builtin_amdgcn_s_getreg((3 << 11) | 20) & 0xFu; }
#define XB_SPIN(cond, bar) do { unsigned _sp = 0; while (cond) { __builtin_amdgcn_s_sleep(1); \
    if ((++_sp & 255u) == 0u) { if (xb_ld(&(bar)[XB_TMO])) break; if (_sp > XB_SPIN_CAP) { atomicAdd(&(bar)[XB_TMO], 1u); break; } } } } while (0)

struct XcdBarrier {
    unsigned* bar; unsigned x;
    volatile LAS unsigned* st;
};

__device__ __forceinline__ XcdBarrier xcd_barrier_post(unsigned* bar, volatile LAS unsigned* st) {
    XcdBarrier b; b.bar = bar; b.x = xb_xcc_id(); b.st = st;
    if (threadIdx.x == 0) (void)xb_add(&bar[XB_XCNT(b.x)], 1u);
    return b;
}
__device__ __forceinline__ void xcd_barrier_complete(unsigned* bar, unsigned x, unsigned& nloc, unsigned& nx) {
    const unsigned G = gridDim.x * gridDim.y * gridDim.z;
    unsigned sum, cnt, mine, sp = 0u;
    for (;;) {
        sum = 0u; cnt = 0u; mine = 0u;
#pragma unroll
        for (unsigned j = 0; j < 16; ++j) { const unsigned c = xb_ld(&bar[XB_XCNT(j)]); sum += c; cnt += (c > 0u) ? 1u : 0u; mine = (j == x) ? c : mine; }
        if (sum == G) break;
        __builtin_amdgcn_s_sleep(1);
        if ((++sp & 255u) == 0u) { if (xb_ld(&bar[XB_TMO])) break; if (sp > XB_SPIN_CAP) { atomicAdd(&bar[XB_TMO], 1u); break; } }
    }
    nloc = mine > 0u ? mine : 1u; nx = cnt > 0u ? cnt : 1u;
}

__device__ __forceinline__ void xcd_barrier(const XcdBarrier& b, const bool is_thread0) {
    asm volatile("s_waitcnt vmcnt(0)" ::: "memory");
    __syncthreads();
    if (is_thread0) {
        unsigned* bar = b.bar;
        __builtin_amdgcn_s_waitcnt(0);
        unsigned nloc = b.st[0], nx = b.st[1];
        if (nloc == 0u) { xcd_barrier_complete(bar, b.x, nloc, nx); b.st[0] = nloc; b.st[1] = nx; }
        const unsigned old = xb_add(&bar[XB_XSUB(b.x)], 1u);
        const unsigned gen = old / nloc;
        if (old + 1u == (gen + 1u) * nloc) {
            __builtin_amdgcn_fence(__ATOMIC_RELEASE, "agent");
            asm volatile("s_waitcnt vmcnt(0)" ::: "memory");
            const unsigned og = xb_add(&bar[XB_TOP], 1u);
            const unsigned tg = og / nx;
            if (og + 1u == (tg + 1u) * nx) xb_add(&bar[XB_TOPGEN], 1u);
            else XB_SPIN(xb_ld(&bar[XB_TOPGEN]) == tg, bar);
            __builtin_amdgcn_fence(__ATOMIC_ACQUIRE, "agent");
            xb_add(&bar[XB_XGEN(b.x)], 1u);
            asm volatile("s_waitcnt vmcnt(0)" ::: "memory");
        } else {
            XB_SPIN(xb_ld(&bar[XB_XGEN(b.x)]) == gen, bar);
            __builtin_amdgcn_fence(__ATOMIC_ACQUIRE, "agent");
            asm volatile("s_waitcnt vmcnt(0)" ::: "memory");
        }
    }
    __syncthreads();
}

using pg8::bf2f; using pg8::cvt_pk_bf16; using pg8::sigm; using pg8::bflo; using pg8::bfhi;
typedef float f32x16 __attribute__((ext_vector_type(16)));
typedef unsigned u32x2 __attribute__((ext_vector_type(2)));
__device__ __forceinline__ float dpp_f(float v, const int ctrl_sel) {
    const int x = __builtin_bit_cast(int, v); int r;
    if (ctrl_sel == 0) r = __builtin_amdgcn_mov_dpp(x, 0xB1, 0xF, 0xF, false); else if (ctrl_sel == 1) r = __builtin_amdgcn_mov_dpp(x, 0x4E, 0xF, 0xF, false);
    else if (ctrl_sel == 2) r = __builtin_amdgcn_mov_dpp(x, 0x141, 0xF, 0xF, false); else r = __builtin_amdgcn_mov_dpp(x, 0x140, 0xF, 0xF, false);
    return __builtin_bit_cast(float, r);
}
__device__ __forceinline__ float wave_sum(float v) {
    v += dpp_f(v, 0); v += dpp_f(v, 1); v += dpp_f(v, 2); v += dpp_f(v, 3);
    const int x = __builtin_bit_cast(int, v);
    const float r0 = __builtin_bit_cast(float, __builtin_amdgcn_readlane(x, 0)), r1 = __builtin_bit_cast(float, __builtin_amdgcn_readlane(x, 16));
    const float r2 = __builtin_bit_cast(float, __builtin_amdgcn_readlane(x, 32)), r3 = __builtin_bit_cast(float, __builtin_amdgcn_readlane(x, 48));
    return (r0 + r1) + (r2 + r3);
}
__device__ __forceinline__ float silu_f(float x) { return x / (1.0f + __expf(-x)); }
__device__ __forceinline__ float gelu_tanh(float x) { return x * sigm(1.5957691216057308f * (x + 0.044715f * x * x * x)); }

struct Params {
    const float *x, *c, *ctx, *c_ctx, *w_mod, *b_mod, *g_norm1, *g_norm2, *w_in, *q_gain, *k_gain, *conv_w, *conv_b, *lru_w_r, *lru_b_r, *lru_w_i, *lru_b_i, *lru_lambda,
                *w_branch, *w_gate, *b_gate, *w_out, *w_ffn_in, *w_ffn_out, *g_final;
    float* out; unsigned char* ws; int ph_lo, ph_hi;
};
typedef const __attribute__((address_space(4))) Params* KP;
__device__ __forceinline__ KP fresh_kp() { KP p = (KP)__builtin_amdgcn_kernarg_segment_ptr(); asm volatile("" : "+s"(p)); return p; }

__device__ __forceinline__ void tr_item(const float* W, int ldn, bf16* WT, int ldk, int k0, int n0, int drow0, LAS float* scr, int lane) {
#pragma unroll 8
    for (int i = 0; i < 32; ++i) { const int kk = 2 * i + (lane >> 5); scr[kk * 33 + (lane & 31)] = W[(size_t)(k0 + kk) * ldn + n0 + (lane & 31)]; }
    LDS_WAIT(); asm volatile("" ::: "memory");
    const int c = lane & 7;
#pragma unroll
    for (int j = 0; j < 4; ++j) { const int n = (lane >> 3) + 8 * j; const LAS float* s = scr + (8 * c) * 33 + n;
        v4u o; o.x = pk2(s[0 * 33], s[1 * 33]); o.y = pk2(s[2 * 33], s[3 * 33]); o.z = pk2(s[4 * 33], s[5 * 33]); o.w = pk2(s[6 * 33], s[7 * 33]);
        *(v4u*)(WT + (size_t)(drow0 + n) * ldk + k0 + 8 * c) = o; }
    LDS_WAIT(); asm volatile("" ::: "memory");
}

__device__ __forceinline__ void p0_prologue(KP P, LAS unsigned char* lds, int tid, int lane, int wave, int vcu, int G) {
    unsigned char* ws = P->ws;
    {
        LAS float* SC = (LAS float*)lds;
        LAS float* red = (LAS float*)(lds + 73728);
        for (int i = tid; i < 9 * 2048; i += 512) { const int r = i >> 11, k = i & 2047; const float v = r < 8 ? P->c[r * 2048 + k] : P->c_ctx[k]; SC[i] = silu_f(v); }
        __syncthreads();
        float* MOD = (float*)(ws + WS_MOD);
        for (int unit = vcu; unit < 4 * 192; unit += G) {
            const int l = unit / 192, n0 = (unit % 192) * 64;
            const float* wp = P->w_mod + ((size_t)l * 2048 + wave * 256) * 12288 + n0 + lane;
            float acc[9];
#pragma unroll
            for (int r = 0; r < 9; ++r) acc[r] = 0.f;
            for (int k8 = 0; k8 < 256; k8 += 8) {
                float wv[8];
#pragma unroll
                for (int j = 0; j < 8; ++j) wv[j] = wp[(size_t)(k8 + j) * 12288];
#pragma unroll
                for (int j = 0; j < 8; ++j)
#pragma unroll
                    for (int r = 0; r < 9; ++r) acc[r] += SC[r * 2048 + wave * 256 + k8 + j] * wv[j];
            }
#pragma unroll
            for (int r = 0; r < 9; ++r) red[(wave * 9 + r) * 64 + lane] = acc[r];
            __syncthreads();
            for (int i = tid; i < 9 * 64; i += 512) { const int r = i >> 6, ln = i & 63; float s = 0.f;
#pragma unroll
                for (int w = 0; w < 8; ++w) s += red[(w * 9 + r) * 64 + ln];
                MOD[((size_t)l * 9 + r) * 12288 + n0 + ln] = s + P->b_mod[l * 12288 + n0 + ln]; }
            __syncthreads();
        }
    }
    {
        LAS float* scr = (LAS float*)(lds + wave * 16384);
        const int gw = vcu * NWAVES + wave, NGW = G * NWAVES;
        constexpr int PER_L = 32768, NIT = 4 * PER_L + 512;
        for (int it = gw; it < NIT; it += NGW) {
            if (it < 4 * PER_L) {
                const int l = it / PER_L; int r = it % PER_L;
                unsigned char* wl = ws + WS_W + (size_t)l * W_LAYER;
                if (r < 4608) { const int kb = r / 144, nb = r % 144; tr_item(P->w_in + (size_t)l * 2048 * 4608, 4608, (bf16*)(wl + WO_W1), 2048, kb * 64, nb * 32, nb * 32, scr, lane); continue; } r -= 4608;
                if (r < 6144) { const int kb = r / 192, nb = r % 192; tr_item(P->w_gate + (size_t)l * 2048 * 6144, 6144, (bf16*)(wl + WO_W1), 2048, kb * 64, nb * 32, 4608 + nb * 32, scr, lane); continue; } r -= 6144;
                if (r < 3072) { const int br = r / 1024, rr = r % 1024, kb = rr / 64, nb = rr % 64;
                    tr_item(P->w_branch + ((size_t)l * 3 + br) * 1024 * 2048, 2048, (bf16*)(wl + WO_WB) + (size_t)br * 2048 * 1024, 1024, kb * 64, nb * 32, nb * 32, scr, lane); continue; } r -= 3072;
                if (r < 2048) { const int kb = r / 64, nb = r % 64; tr_item(P->w_out + (size_t)l * 2048 * 2048, 2048, (bf16*)(wl + WO_WO), 2048, kb * 64, nb * 32, nb * 32, scr, lane); continue; } r -= 2048;
                if (r < 11264) { const int kb = r / 352, nb = r % 352, n0 = nb * 32, half = n0 / 5632, j = n0 % 5632, pn = j / 128, jj = j % 128;
                    tr_item(P->w_ffn_in + (size_t)l * 2048 * 11264, 11264, (bf16*)(wl + WO_WFI), 2048, kb * 64, n0, pn * 256 + half * 128 + jj, scr, lane); continue; } r -= 11264;
                { const int kb = r / 64, nb = r % 64; tr_item(P->w_ffn_out + (size_t)l * 5632 * 2048, 2048, (bf16*)(wl + WO_WFO), 5632, kb * 64, nb * 32, nb * 32, scr, lane); }
            } else {
                const int r = it - 4 * PER_L, mat = r >> 1, nb = r & 1, gate = mat & 1, ldn = mat >> 1;
                const float* W = (gate ? P->lru_w_i : P->lru_w_r) + (size_t)ldn * 4096;
                tr_item(W, 64, (bf16*)(ws + WS_WLT) + (size_t)mat * 4096, 64, 0, nb * 32, nb * 32, scr, lane);
            }
        }
    }
    {
        const int gid = vcu * 512 + tid, NT = G * 512;
        float* ROPE = (float*)(ws + WS_ROPE);
        for (int i = gid; i < 2048 * 64; i += NT) { const int t = i >> 6, j = i & 63; const float pos = (float)(j < 32 ? (t >> 6) : (t & 63));
            const float inv = exp2f(-(float)(j & 31) * (13.287712379549449f / 32.0f)); const float ang = pos * inv; ROPE[i] = cosf(ang); ROPE[2048 * 64 + i] = sinf(ang); }
        bf16* CST = (bf16*)(ws + WS_CST);
        for (int i = gid; i < 256 * 128; i += NT) { const int col = i >> 7, cc = i & 127, s = col >> 7, m = col & 127; const float a = (float)((m * cc) & 127) * (2.0f / 128.0f);
            CST[i] = (bf16)f2bf(s ? sinpif(a) : cospif(a)); }
        bf16* DFTC = (bf16*)(ws + WS_DFTC);
        for (int i = gid; i < 256 * 512; i += NT) { const int k = i >> 9, cc = i & 511, s = cc >> 8, t = cc & 255; const float a = (float)((k * t) & 255) * (2.0f / 256.0f);
            DFTC[i] = (bf16)f2bf(s ? -sinpif(a) : cospif(a)); }
        bf16* DFTL = (bf16*)(ws + WS_DFTL);
        for (int i = gid; i < 2048 * 4096; i += NT) { const int k = i >> 12, cc = i & 4095, s = cc >> 11, t = cc & 2047; const float a = (float)((k * t) & 2047) * (2.0f / 2048.0f);
            DFTL[i] = (bf16)f2bf(s ? -sinpif(a) : cospif(a)); }
    }
}

__device__ __forceinline__ void norm_rows(KP P, int l, int which, int nrows, int lane, int wave, int vcu, int G) {
    unsigned char* ws = P->ws; float* X = (float*)(ws + WS_X); bf16* H = (bf16*)(ws + WS_H); const float* MOD = (const float*)(ws + WS_MOD);
    const float* gn = (which ? P->g_norm2 : P->g_norm1) + l * 2048;
    const bool first = (l == 0 && which == 0);
    const int gw = vcu * NWAVES + wave, NGW = G * NWAVES;
    for (int m = gw; m < nrows; m += NGW) {
        const float* src = first ? (m < ML ? P->x + (size_t)m * DM : P->ctx + (size_t)(m - ML) * DM) : X + (size_t)m * DM;
        const int rsel = m < ML ? (m >> 11) : 8;
        const float* mv = MOD + ((size_t)l * 9 + rsel) * 12288 + (which ? 3 * 2048 : 0);
        f32x4 v[8]; float ss = 0.f;
#pragma unroll
        for (int j = 0; j < 8; ++j) { v[j] = *(const f32x4*)(src + (j * 64 + lane) * 4); ss += (v[j].x * v[j].x + v[j].y * v[j].y) + (v[j].z * v[j].z + v[j].w * v[j].w); }
        const float rstd = 1.0f / sqrtf(wave_sum(ss) * (1.0f / DM) + NEPS);
#pragma unroll
        for (int j = 0; j < 8; ++j) { const int col = (j * 64 + lane) * 4;
            if (first) *(f32x4*)(X + (size_t)m * DM + col) = v[j];
            const f32x4 g = *(const f32x4*)(gn + col), sh = *(const f32x4*)(mv + col), sc = *(const f32x4*)(mv + 2048 + col);
            const f32x4 o = v[j] * rstd * g * (sc + 1.0f) + sh;
            u32x2 w; w.x = cvt_pk_bf16(o.x, o.y); w.y = cvt_pk_bf16(o.z, o.w);
            *(u32x2*)(H + (size_t)m * DM + col) = w; }
    }
}
__device__ __forceinline__ void final_norm(KP P, int lane, int wave, int vcu, int G) {
    const float* X = (const float*)(P->ws + WS_X);
    const int gw = vcu * NWAVES + wave, NGW = G * NWAVES;
    for (int m = gw; m < ML; m += NGW) {
        const float* src = X + (size_t)m * DM; f32x4 v[8]; float ss = 0.f;
#pragma unroll
        for (int j = 0; j < 8; ++j) { v[j] = *(const f32x4*)(src + (j * 64 + lane) * 4); ss += (v[j].x * v[j].x + v[j].y * v[j].y) + (v[j].z * v[j].z + v[j].w * v[j].w); }
        const float rstd = 1.0f / sqrtf(wave_sum(ss) * (1.0f / DM) + NEPS);
#pragma unroll
        for (int j = 0; j < 8; ++j) { const int col = (j * 64 + lane) * 4; *(f32x4*)(P->out + (size_t)m * DM + col) = v[j] * rstd * *(const f32x4*)(P->g_final + col); }
    }
}

__device__ __forceinline__ void f1_units(KP P, bool last, LAS unsigned char* lds, int tid, int lane, int wave, int vcu, int G) {
    unsigned char* ws = P->ws; const bf16* Y1 = (const bf16*)(ws + WS_Y1); bf16* PTL = (bf16*)(ws + WS_PTL); bf16* PTC = (bf16*)(ws + WS_PTC);
    { const v4u* src = (const v4u*)(ws + WS_CST);
      for (int i = tid; i < 256 * 16; i += 512) { const int row = i >> 4, ch = i & 15; *(LAS v4u*)(lds + row * 272 + ch * 16) = src[i]; } }
    __syncthreads();
    const int r = lane & 31, h = lane >> 5;
    const int gw = vcu * NWAVES + wave, NGW = G * NWAVES;
    const int nunits = (last ? ML : MT) / 32 * 8;
    for (int wu = gw; wu < nunits; wu += NGW) {
        const int tt = wu >> 3, g = wu & 7, m0 = tt * 32;
        const bf16* ap = Y1 + (size_t)(m0 + r) * LDY + YUF + g * 128 + h * 8;
        bf16x8 Af[8];
#pragma unroll
        for (int kk = 0; kk < 8; ++kk) Af[kk] = *(const bf16x8*)(ap + kk * 16);
        bf16* base; int rs, ss;
        if (m0 < ML) { const int b = m0 >> 11, t0 = m0 & 2047; base = PTL + (size_t)((b * 8 + g) * 128) * 4096 + t0; rs = 4096; ss = 2048; }
        else { const int mc = m0 - ML, b = mc >> 8, t0 = mc & 255; base = PTC + (size_t)((b * 8 + g) * 128) * 512 + t0; rs = 512; ss = 256; }
#pragma unroll 1
        for (int ct = 0; ct < 8; ++ct) {
            f32x16 acc = {};
#pragma unroll
            for (int kk = 0; kk < 8; ++kk) { const bf16x8 Bf = *(const LAS bf16x8*)(lds + (ct * 32 + r) * 272 + (kk * 16 + h * 8) * 2); acc = __builtin_amdgcn_mfma_f32_32x32x16_bf16(Af[kk], Bf, acc, 0, 0, 0); }
            const int s = ct >> 2, m = (ct & 3) * 32 + r;
            bf16* dp = base + (size_t)m * rs + s * ss + 4 * h;
#pragma unroll
            for (int q4 = 0; q4 < 4; ++q4) { u32x2 w; w.x = cvt_pk_bf16(acc[4 * q4], acc[4 * q4 + 1]); w.y = cvt_pk_bf16(acc[4 * q4 + 2], acc[4 * q4 + 3]); *(u32x2*)(dp + 8 * q4) = w; }
        }
    }
}
__device__ __forceinline__ void knorm_units(KP P, int l, int lane, int wave, int vcu, int G) {
    unsigned char* ws = P->ws; const bf16* Y1 = (const bf16*)(ws + WS_Y1); bf16* KN = (bf16*)(ws + WS_KN); const float* ROPE = (const float*)(ws + WS_ROPE);
    const float g1 = P->k_gain[l * 128 + lane], g2 = P->k_gain[l * 128 + 64 + lane];
    const int gw = vcu * NWAVES + wave, NGW = G * NWAVES;
    for (int it = gw; it < MT * 2; it += NGW) {
        const int m = it >> 1, kvh = it & 1;
        const bf16* kp = Y1 + (size_t)m * LDY + YK + kvh * 128;
        const float k1 = bf2f(kp[lane]), k2 = bf2f(kp[64 + lane]);
        const float rstd = 1.0f / sqrtf(wave_sum(k1 * k1 + k2 * k2) * (1.0f / 128.0f) + NEPS);
        float a = k1 * rstd * g1, b = k2 * rstd * g2;
        if (m < ML) { const int t = m & 2047; const float c = ROPE[t * 64 + lane], s = ROPE[2048 * 64 + t * 64 + lane]; const float na = a * c - b * s, nb = b * c + a * s; a = na; b = nb; }
        bf16* op = KN + (size_t)m * 256 + kvh * 128;
        op[lane] = (bf16)(cvt_pk_bf16(a, 0.f) & 0xffffu); op[64 + lane] = (bf16)(cvt_pk_bf16(b, 0.f) & 0xffffu);
    }
}
__device__ __forceinline__ void lru_unit(KP P, int l, int b, int nb, int hc, LAS unsigned char* lds, int lane, int wave) {
    unsigned char* ws = P->ws; const bf16* Y1 = (const bf16*)(ws + WS_Y1); bf16* REC = (bf16*)(ws + WS_REC);
    const int j = lane & 31, hi = lane >> 5;
    LAS float* uS = (LAS float*)(lds + wave * 8704);
    typedef float f32x2 __attribute__((ext_vector_type(2)));
    LAS f32x2* SUM = (LAS f32x2*)(lds + 69632);
    const int chin = nb * 64 + lane, cho = nb * 64 + hc * 32 + j;
    const float cw0 = P->conv_w[(l * 4 + 0) * 1024 + chin], cw1 = P->conv_w[(l * 4 + 1) * 1024 + chin], cw2 = P->conv_w[(l * 4 + 2) * 1024 + chin], cw3 = P->conv_w[(l * 4 + 3) * 1024 + chin];
    const float cb = P->conv_b[l * 1024 + chin];
    const float brf = P->lru_b_r[(l * 2 + 0) * 1024 + cho], bif = P->lru_b_i[(l * 2 + 0) * 1024 + cho], brb = P->lru_b_r[(l * 2 + 1) * 1024 + cho], bib = P->lru_b_i[(l * 2 + 1) * 1024 + cho];
    const float spf = 8.0f * 1.4426950408889634f * log1pf(__expf(-P->lru_lambda[(l * 2 + 0) * 1024 + cho])), spb = 8.0f * 1.4426950408889634f * log1pf(__expf(-P->lru_lambda[(l * 2 + 1) * 1024 + cho]));
    bf16x8 Bf[4][4];
    { const bf16* WLT = (const bf16*)(ws + WS_WLT);
#pragma unroll
      for (int tl = 0; tl < 4; ++tl) { const int mat = (((l * 2 + (tl >> 1)) * 16 + nb) * 2 + (tl & 1));
#pragma unroll
        for (int kk = 0; kk < 4; ++kk) Bf[tl][kk] = *(const bf16x8*)(WLT + (size_t)mat * 4096 + (hc * 32 + j) * 64 + kk * 16 + hi * 8); } }
    const int arow = ((j >> 2) & 1) * 16 + (j & 3) + 4 * (j >> 3);
#pragma unroll 1
    for (int pass = 0; pass < 2; ++pass) {
#pragma unroll 1
        for (int step = 0; step < 9; ++step) {
            const int q = step * 8 + wave;
            int rowbase, L, T0;
            if (q < 8) { rowbase = ML + b * 256; L = 256; T0 = 32 * q; } else { rowbase = b * 2048; L = 2048; T0 = 32 * (q - 8); }
            { const bf16* xp = Y1 + (size_t)rowbase * LDY + YUX + chin;
              float xin[35];
#pragma unroll
              for (int i = 0; i < 35; ++i) { const int t = T0 - 2 + i; xin[i] = (t >= 0 && t < L) ? bf2f(xp[(size_t)t * LDY]) : 0.f; }
#pragma unroll
              for (int i = 0; i < 32; ++i) uS[i * 68 + lane] = cb + cw0 * xin[i] + cw1 * xin[i + 1] + cw2 * xin[i + 2] + cw3 * xin[i + 3]; }
            LDS_WAIT(); asm volatile("" ::: "memory");
            f32x16 acc[4];
#pragma unroll
            for (int tl = 0; tl < 4; ++tl) acc[tl] = (f32x16){};
#pragma unroll
            for (int kk = 0; kk < 4; ++kk) {
                const f32x4 a0 = *(const LAS f32x4*)(uS + arow * 68 + kk * 16 + hi * 8), a1 = *(const LAS f32x4*)(uS + arow * 68 + kk * 16 + hi * 8 + 4);
                v4u aw; aw.x = cvt_pk_bf16(a0.x, a0.y); aw.y = cvt_pk_bf16(a0.z, a0.w); aw.z = cvt_pk_bf16(a1.x, a1.y); aw.w = cvt_pk_bf16(a1.z, a1.w);
                const bf16x8 Af = __builtin_bit_cast(bf16x8, aw);
#pragma unroll
                for (int tl = 0; tl < 4; ++tl) acc[tl] = __builtin_amdgcn_mfma_f32_32x32x16_bf16(Af, Bf[tl][kk], acc[tl], 0, 0, 0);
            }
            float af[16], xf[16], ab[16], xb[16];
#pragma unroll
            for (int r = 0; r < 16; ++r) {
                const float u = uS[(hi * 16 + r) * 68 + hc * 32 + j];
                const float rf = sigm(acc[0][r] + brf), gf = sigm(acc[1][r] + bif), rb = sigm(acc[2][r] + brb), gb = sigm(acc[3][r] + bib);
                af[r] = __builtin_amdgcn_exp2f(-rf * spf); ab[r] = __builtin_amdgcn_exp2f(-rb * spb);
                xf[r] = __builtin_sqrtf(fmaxf(1.0f - af[r] * af[r], 0.f)) * gf * u; xb[r] = __builtin_sqrtf(fmaxf(1.0f - ab[r] * ab[r], 0.f)) * gb * u;
            }
            const int blk = 2 * q + hi;
            if (pass == 0) {
                float A = 1.f, Hs = 0.f;
#pragma unroll
                for (int r = 0; r < 16; ++r) { Hs = af[r] * Hs + xf[r]; A *= af[r]; }
                SUM[(blk * 2 + 0) * 32 + j] = (f32x2){A, Hs};
                A = 1.f; Hs = 0.f;
#pragma unroll
                for (int r = 15; r >= 0; --r) { Hs = ab[r] * Hs + xb[r]; A *= ab[r]; }
                SUM[(blk * 2 + 1) * 32 + j] = (f32x2){A, Hs};
            } else {
                float hf = SUM[(blk * 2 + 0) * 32 + j].x, hb = SUM[(blk * 2 + 1) * 32 + j].x;
                float y[16];
#pragma unroll
                for (int r = 0; r < 16; ++r) { hf = af[r] * hf + xf[r]; y[r] = hf; }
#pragma unroll
                for (int r = 15; r >= 0; --r) { hb = ab[r] * hb + xb[r]; y[r] += hb; }
                const size_t row0 = (size_t)rowbase + T0 + hi * 16;
#pragma unroll
                for (int r = 0; r < 16; ++r) { const float ug = bf2f(Y1[(row0 + r) * LDY + YUG + cho]); REC[(row0 + r) * 1024 + cho] = (bf16)(cvt_pk_bf16(y[r] * gelu_tanh(ug), 0.f) & 0xffffu); }
            }
            LDS_WAIT(); asm volatile("" ::: "memory");
        }
        if (pass == 0) {
            __syncthreads();
            if (wave == 0) {
                float hcar = 0.f;
                for (int it = 0; it < 144; ++it) { const int B = hi == 0 ? it : (it < 16 ? 15 - it : 159 - it);
                    const f32x2 sv = SUM[(B * 2 + hi) * 32 + j]; SUM[(B * 2 + hi) * 32 + j].x = hcar; hcar = sv.x * hcar + sv.y; }
            }
            __syncthreads();
        }
    }
    __syncthreads();
}

struct MapAB { const char* A; const char* B; size_t astep, bstep;
    __device__ __forceinline__ void operator()(pg8::Unit& u) const { u.A = A + (size_t)u.pm * astep; u.B = B + (size_t)u.pn * bstep; } };
struct MapBr { const char* A; const char* B;
    __device__ __forceinline__ void operator()(pg8::Unit& u) const { u.A = A + (size_t)u.aux * (36 * MiB) + (size_t)u.pm * (256 * 1024 * 2); u.B = B + (size_t)u.aux * (2048 * 1024 * 2) + (size_t)u.pn * (256 * 1024 * 2); } };

__global__ void __launch_bounds__(NWAVES * 64, 2) fwd_kernel(Params Pv) {
    extern __shared__ __attribute__((aligned(16))) unsigned char lds_raw[];
    LAS unsigned char* lds = (LAS unsigned char*)lds_raw;
    volatile LAS unsigned* MISC = (volatile LAS unsigned*)(lds + MISC_OFF);
    const int wave0 = __builtin_amdgcn_readfirstlane((int)threadIdx.x >> 6);
#define FRESH_TID() const KP P = fresh_kp(); (void)P; int wave = wave0; asm volatile("" : "+s"(wave)); int lane; asm volatile("v_mbcnt_lo_u32_b32 %0, -1, 0\n\tv_mbcnt_hi_u32_b32 %0, -1, %0" : "=v"(lane)); const int tid = (wave << 6) | lane; (void)tid
    const int G = gridDim.x; int vcu; { const int bx = blockIdx.x; vcu = (G % 8 == 0) ? (bx % 8) * (G / 8) + bx / 8 : bx; }
    unsigned char* ws = fresh_kp()->ws;
    gu32* ctl = (gu32*)(ws + WS_CTL);
    for (int u = (int)threadIdx.x; u < (LDS_BYTES - LDSCTL_OFF) / 4; u += NWAVES * 64) ((LAS unsigned*)(lds + LDSCTL_OFF))[u] = 0u;
    __syncthreads();
    XcdBarrier bar = xcd_barrier_post((unsigned*)(ctl + CW_BAR), MISC + 8);
#define GRID_BAR() do { XcdBarrier b2_ = bar; asm volatile("" : "+s"(b2_.bar), "+s"(b2_.x)); { FRESH_TID(); xcd_barrier(b2_, tid == 0); } } while (0)

#define H ((bf16*)(ws + WS_H))
#define Y1 ((bf16*)(ws + WS_Y1))
#define Gt ((bf16*)(ws + WS_G))
#define ACT ((bf16*)(ws + WS_ACT))
#define KN ((bf16*)(ws + WS_KN))
#define ATT ((bf16*)(ws + WS_ATT))
#define FOU ((bf16*)(ws + WS_FOU))
#define MG ((bf16*)(ws + WS_MG))
#define X ((float*)(ws + WS_X))
#define MOD ((const float*)(ws + WS_MOD))
#define ROPE ((const float*)(ws + WS_ROPE))

    const int ph_lo = fresh_kp()->ph_lo, ph_hi = fresh_kp()->ph_hi;
#define IN(k) (ph_lo <= (k) && (k) < ph_hi)
#define SEAM(k) do { if (IN(k) && IN((k) + 1)) GRID_BAR(); } while (0)
    if (IN(0)) { FRESH_TID(); p0_prologue(P, lds, tid, lane, wave, vcu, G); }
    SEAM(0);

#pragma unroll 1
    for (int l = 0; l < DEPTH; ++l) {
        const bool last = (l == DEPTH - 1);
        const int nMt = last ? 64 : 72;
        const unsigned char* wl = ws + WS_W + (size_t)l * W_LAYER;
        const int pb = 1 + 9 * l;
        if (IN(pb + 0)) { FRESH_TID(); norm_rows(P, l, 0, MT, lane, wave, vcu, G); }
        SEAM(pb + 0);
        if (IN(pb + 1)) {
            pg8::TileOrder<MapAB> S; S.map = MapAB{(const char*)H, (const char*)(wl + WO_W1), (size_t)256 * 2048 * 2, (size_t)256 * 2048 * 2}; S.init(72, 42, G, (int)blockIdx.x);
            pg8::EpiG1 E{Y1, Gt, fresh_kp()->b_gate + l * 6144};
            { FRESH_TID(); pg8::gemm_phase<pg8::EpiG1, pg8::TileOrder<MapAB>, true, true>(lds, pg8::Gemm{2048, 2048, 2048}, S, E, tid); }
        }
        SEAM(pb + 1);
        if (IN(pb + 2)) {
        { FRESH_TID(); f1_units(P, last, lds, tid, lane, wave, vcu, G); }
        { FRESH_TID(); knorm_units(P, l, lane, wave, vcu, G); }
        __syncthreads();
        { FRESH_TID(); for (int u = vcu; u < 256; u += G) lru_unit(P, l, u >> 5, (u >> 1) & 15, u & 1, lds, lane, wave); }
        }
        SEAM(pb + 2);
        if (IN(pb + 3)) {
            const int nun = last ? 512 : 576;
            { FRESH_TID();
            for (int U = vcu; U < nun; U += G) {
                const bf16 *Qb, *K0, *K1, *V0, *V1; bf16* Ob; int n0, NT; const float* rope;
                if (U < 512) { const int bh = U >> 3, qb = U & 7, b = bh >> 3, h = bh & 7, kvh = h >> 2; const size_t r0 = (size_t)b * 2048, rc = (size_t)ML + b * 256;
                    Qb = Y1 + (r0 + qb * 256) * LDY + YQ + h * 128; K0 = KN + r0 * 256 + kvh * 128; K1 = KN + rc * 256 + kvh * 128;
                    V0 = Y1 + r0 * LDY + YV + kvh * 128; V1 = Y1 + rc * LDY + YV + kvh * 128; n0 = 32; NT = 36; Ob = ATT + (r0 + qb * 256) * 1024 + h * 128; rope = ROPE + (size_t)qb * 256 * 64; }
                else { const int uc = U - 512, b = uc >> 3, h = uc & 7, kvh = h >> 2; const size_t rc = (size_t)ML + b * 256;
                    Qb = Y1 + rc * LDY + YQ + h * 128; K0 = KN + rc * 256 + kvh * 128; K1 = K0; V0 = Y1 + rc * LDY + YV + kvh * 128; V1 = V0; n0 = 4; NT = 4; Ob = ATT + rc * 1024 + h * 128; rope = nullptr; }
                att::attn_unit(Qb, LDY, K0, K1, V0, V1, n0, NT, 256, LDY, Ob, 1024, P->q_gain + l * 128, rope, (char*)lds_raw, tid);
            }
            }
            __syncthreads();
            {
                pg8::TileOrder<MapAB> S; S.map = MapAB{(const char*)(ws + WS_DFTL), (const char*)(ws + WS_PTL), (size_t)256 * 4096 * 2, (size_t)256 * 4096 * 2}; S.init(8, 32, G, (int)blockIdx.x);
                pg8::EpiF2 E{FOU, 2048, 0, 0.001953125f};
                { FRESH_TID(); pg8::gemm_phase<pg8::EpiF2, pg8::TileOrder<MapAB>, true, true>(lds, pg8::Gemm{4096, 4096, 4096}, S, E, tid); }
            }
            if (!last) {
                pg8::TileOrder<MapAB> S; S.map = MapAB{(const char*)(ws + WS_DFTC), (const char*)(ws + WS_PTC), (size_t)256 * 512 * 2, (size_t)256 * 512 * 2}; S.init(1, 32, G, (int)blockIdx.x);
                pg8::EpiF2 E{FOU, 256, ML, 0.005524271728019903f};
                { FRESH_TID(); pg8::gemm_phase<pg8::EpiF2, pg8::TileOrder<MapAB>, true, true>(lds, pg8::Gemm{512, 512, 512}, S, E, tid); }
            }
        }
        SEAM(pb + 3);
        if (IN(pb + 4)) {
            pg8::TileOrder<MapBr> S; S.map = MapBr{(const char*)ATT, (const char*)(wl + WO_WB)}; S.init(nMt, 8, G, (int)blockIdx.x, 3);
            pg8::EpiBr E{Gt, MG, (float*)(ws + WS_BRS) + (size_t)blockIdx.x * 65536};
            { FRESH_TID(); pg8::gemm_phase<pg8::EpiBr, pg8::TileOrder<MapBr>, true, true>(lds, pg8::Gemm{1024, 1024, 1024}, S, E, tid); }
        }
        SEAM(pb + 4);
        if (IN(pb + 5)) {
            pg8::TileOrder<MapAB> S; S.map = MapAB{(const char*)MG, (const char*)(wl + WO_WO), (size_t)256 * 2048 * 2, (size_t)256 * 2048 * 2}; S.init(nMt, 8, G, (int)blockIdx.x);
            pg8::EpiRes E{X, MOD + (size_t)l * 9 * 12288 + 2 * 2048};
            { FRESH_TID(); pg8::gemm_phase<pg8::EpiRes, pg8::TileOrder<MapAB>, true, true>(lds, pg8::Gemm{2048, 2048, 2048}, S, E, tid); }
        }
        SEAM(pb + 5);
        if (IN(pb + 6)) { FRESH_TID(); norm_rows(P, l, 1, nMt * 256, lane, wave, vcu, G); }
        SEAM(pb + 6);
        if (IN(pb + 7)) {
            pg8::TileOrder<MapAB> S; S.map = MapAB{(const char*)H, (const char*)(wl + WO_WFI), (size_t)256 * 2048 * 2, (size_t)256 * 2048 * 2}; S.init(nMt, 44, G, (int)blockIdx.x);
            pg8::EpiSwi E{ACT};
            { FRESH_TID(); pg8::gemm_phase<pg8::EpiSwi, pg8::TileOrder<MapAB>, true, true>(lds, pg8::Gemm{2048, 2048, 2048}, S, E, tid); }
        }
        SEAM(pb + 7);
        if (IN(pb + 8)) {
            pg8::TileOrder<MapAB> S; S.map = MapAB{(const char*)ACT, (const char*)(wl + WO_WFO), (size_t)256 * 5632 * 2, (size_t)256 * 5632 * 2}; S.init(nMt, 8, G, (int)blockIdx.x);
            pg8::EpiRes E{X, MOD + (size_t)l * 9 * 12288 + 5 * 2048};
            { FRESH_TID(); pg8::gemm_phase<pg8::EpiRes, pg8::TileOrder<MapAB>, true, true>(lds, pg8::Gemm{5632, 5632, 5632}, S, E, tid); }
        }
        SEAM(pb + 8);
    }
    if (IN(37)) { FRESH_TID(); final_norm(P, lane, wave, vcu, G); }
#undef IN
#undef SEAM
#undef GRID_BAR
#undef H
#undef Y1
#undef Gt
#undef ACT
#undef KN
#undef ATT
#undef FOU
#undef MG
#undef X
#undef MOD
#undef ROPE
}

extern "C" void kernel_launch(void* const* d_in, const int* in_sizes, int n_in, void* d_out, int out_size, void* d_ws, size_t ws_size, hipStream_t stream) {
    static int grid = 0;
    if (grid == 0) {
        if (n_in != 25 || out_size != ML * DM || ws_size < WS_END) { fprintf(stderr, "kernel_launch: unexpected shapes (n_in %d out %d ws %zu, need %zu)\n", n_in, out_size, ws_size, (size_t)WS_END); grid = -1; return; }
        int dev = 0, cus = 0, per_cu = 0;
        if (hipGetDevice(&dev) != hipSuccess || hipDeviceGetAttribute(&cus, hipDeviceAttributeMultiprocessorCount, dev) != hipSuccess) { grid = -1; return; }
        if (hipFuncSetAttribute((const void*)fwd_kernel, hipFuncAttributeMaxDynamicSharedMemorySize, LDS_BYTES) != hipSuccess) { fprintf(stderr, "kernel_launch: hipFuncSetAttribute failed\n"); grid = -1; return; }
        if (hipOccupancyMaxActiveBlocksPerMultiprocessor(&per_cu, (const void*)fwd_kernel, NWAVES * 64, LDS_BYTES) != hipSuccess || per_cu < 1) fprintf(stderr, "kernel_launch: occupancy query reports %d\n", per_cu);
        (void)hipGetLastError();
        grid = cus > 256 ? 256 : cus;
    }
    if (grid < 0) return;
    if (hipMemsetAsync((char*)d_ws + WS_CTL, 0, CTL_ZERO_BYTES, stream) != hipSuccess) return;
    Params p{};
    const float** pf = (const float**)&p;
    for (int i = 0; i < 25; ++i) pf[i] = (const float*)d_in[i];
    p.out = (float*)d_out; p.ws = (unsigned char*)d_ws;
#ifndef MK_CUT_EVERY
#define MK_CUT_EVERY 0
#endif
    constexpr int NPH = 38;
    for (int lo = 0; lo < NPH;) {
        const int hi = MK_CUT_EVERY ? lo + 1 : NPH;
        p.ph_lo = lo; p.ph_hi = hi;
        if (lo > 0 && hipMemsetAsync((char*)d_ws + WS_CTL, 0, CTL_ZERO_BYTES, stream) != hipSuccess) return;
        hipLaunchKernelGGL(fwd_kernel, dim3(grid), dim3(NWAVES * 64), LDS_BYTES, stream, p);
        const hipError_t le = hipPeekAtLastError();
        if (le != hipSuccess) { fprintf(stderr, "kernel_launch: launch failed: %s\n", hipGetErrorName(le)); return; }
        lo = hi;
    }
}
```

```cpp
#include <hip/hip_runtime.h>
#include <cstdio>
#include <cstdint>
#ifndef PROBE_MASK
#define PROBE_MASK 0
#endif

namespace pg8 {
#define PG8_LAS __attribute__((address_space(3)))
typedef unsigned short bf16_t;
typedef short bf16x8 __attribute__((ext_vector_type(8)));
typedef float f32x4 __attribute__((ext_vector_type(4)));
typedef float f32x2 __attribute__((ext_vector_type(2)));
typedef unsigned u32x4 __attribute__((ext_vector_type(4)));
typedef unsigned u32x2 __attribute__((ext_vector_type(2)));
typedef int i32x4 __attribute__((ext_vector_type(4)));
constexpr int BM = 256, BK = 64, HALF = 128, HTB = HALF * BK * 2  , STAGE_BYTES = 8 * HTB, NXCD = 8, WGM = 4;

__host__ __device__ __forceinline__ int lds_byte(int r, int c) { const int st = (r >> 4) * 2 + (c >> 5), rr = r & 15, cc = c & 31, ob = rr * 64 + cc * 2; return st * 1024 + (ob ^ (((ob >> 9) & 1) << 5)); }
__host__ __device__ __forceinline__ void stage_rc(int b, int& R, int& C) { const int st = b / 1024, sb = b % 1024, swz = sb ^ (((sb >> 9) & 1) << 5); R = (st >> 1) * 16 + swz / 64; C = (st & 1) * 32 + (swz % 64) / 2; }
__host__ __device__ __forceinline__ int perm32(int rho) { const int n = rho >> 4, i = rho & 15; return 8 * (i >> 2) + 4 * n + (i & 3); }

struct Unit { int pm, pn, aux, dupv; const char* A; const char* B; };
struct Gemm { int K, lda, ldb; };

template <class Map> struct TileOrder {
    int nM, nN, nwg, G, c, rep, dup; Map map;
    __device__ __forceinline__ void init(int nM_, int nN_, int G_, int c_, int rep_ = 1, int dup_ = 1) { nM = nM_; nN = nN_; nwg = nM * nN; G = G_; c = c_; rep = rep_; dup = dup_; }
    __device__ __forceinline__ bool next(int i, Unit& u) const {
        const int round = i / rep, kb = i - round * rep;
#if PROBE_MASK
        const long L = (long)round * G + c; if (L >= (long)nwg * dup) return false;
        int wgid = (int)(L % nwg); u.dupv = L >= nwg;
#else
        const long L = (long)round * G + c; if (L >= nwg) return false;
        int wgid = (int)L; u.dupv = 0;
#endif
        { const int q = nwg / NXCD, r = nwg % NXCD, xcd = wgid % NXCD, off = wgid / NXCD; wgid = (xcd < r ? xcd * (q + 1) : r * (q + 1) + (xcd - r) * q) + off; }
        const int nig = WGM * nN, gid = wgid / nig, fm = gid * WGM, gsz = (nM - fm) < WGM ? (nM - fm) : WGM;
        u.pm = fm + ((wgid % nig) % gsz); u.pn = (wgid % nig) / gsz; u.aux = kb; map(u); return true;
    }
    __device__ __forceinline__ void a_ready(const Unit&) const {}
    __device__ __forceinline__ void done(const Unit&) const {}
};

typedef float f32x2_cv __attribute__((ext_vector_type(2))); typedef __bf16 bf16x2_cv __attribute__((ext_vector_type(2)));
__device__ __forceinline__ unsigned cvt_pk_bf16(float lo, float hi) { const f32x2_cv v = {lo, hi}; const bf16x2_cv b = __builtin_convertvector(v, bf16x2_cv); return __builtin_bit_cast(unsigned, b); }
__device__ __forceinline__ float bf2f(unsigned short v) { return __uint_as_float((unsigned)v << 16); }
__device__ __forceinline__ float bflo(unsigned w) { return __uint_as_float(w << 16); }
__device__ __forceinline__ float bfhi(unsigned w) { return __uint_as_float(w & 0xffff0000u); }
__device__ __forceinline__ unsigned pk_u8x4(float a, float b, float c, float d, float sc) {
    const unsigned fa = __float_as_uint(fmaf(a, sc, 12582912.0f)), fb = __float_as_uint(fmaf(b, sc, 12582912.0f)), fc = __float_as_uint(fmaf(c, sc, 12582912.0f)), fd = __float_as_uint(fmaf(d, sc, 12582912.0f));
    const unsigned p01 = __builtin_amdgcn_perm(fb, fa, 0x0c0c0400u), p23 = __builtin_amdgcn_perm(fd, fc, 0x0c0c0400u);
    return __builtin_amdgcn_perm(p23, p01, 0x05040100u);
}
__device__ __forceinline__ float sigm(float x) { return __builtin_amdgcn_rcpf(1.0f + __builtin_amdgcn_exp2f(-1.4426950408889634f * x)); }


template <bool GATE, bool QI = GATE> struct EpiG1T {
    static constexpr bool PERM = true, AFTER_DRAIN = false, KEEP = false;
    bf16_t* Y1; bf16_t* G; const float* bgate; const float* sH; const unsigned* cmax;
    __device__ __forceinline__ void operator()(const f32x4 (&acc)[2][2][4][2], const Unit& u, int wr, int wc, int fr, int fq) const {
        asm volatile("" : "+v"(fr), "+v"(fq));
        const int row0 = u.pm * BM + wr * 64 + fr; constexpr bool gate = GATE;
        bf16_t* base = gate ? G : Y1; const int ldc = gate ? 6144 : 4608; const int colt = gate ? (u.pn - 18) * BM : u.pn * BM;
        const int col0 = colt + wc * 32 + 8 * fq;
        f32x4 bv[2][2], cs[2][2]; float rs[2][4];
#pragma unroll
        for (int bj = 0; bj < 2; ++bj)
#pragma unroll
            for (int n = 0; n < 2; ++n) { bv[bj][n] = gate ? *(const f32x4*)(bgate + col0 + bj * HALF + 4 * n) : (f32x4){0.f, 0.f, 0.f, 0.f};
                const u32x4 cm = QI ? *(const u32x4*)(cmax + (gate ? 0 : 6144) + col0 + bj * HALF + 4 * n) : (u32x4){0u, 0u, 0u, 0u};
                cs[bj][n] = (f32x4){__uint_as_float(cm.x), __uint_as_float(cm.y), __uint_as_float(cm.z), __uint_as_float(cm.w)} * (gate ? -1.4426950408889634f / 127.0f : 1.0f / 127.0f);
                if (gate) bv[bj][n] = bv[bj][n] * (-1.4426950408889634f); }
#pragma unroll
        for (int ai = 0; ai < 2; ++ai)
#pragma unroll
            for (int m = 0; m < 4; ++m) rs[ai][m] = QI ? sH[row0 + ai * HALF + m * 16] : 0.f;
#pragma unroll
        for (int ai = 0; ai < 2; ++ai)
#pragma unroll
            for (int m = 0; m < 4; ++m) { bf16_t* rowp = base + (size_t)(row0 + ai * HALF + m * 16) * ldc + col0;
#pragma unroll
                for (int bj = 0; bj < 2; ++bj) { f32x4 v0 = acc[ai][bj][m][0] + bv[bj][0], v1 = acc[ai][bj][m][1] + bv[bj][1];
                    if (gate) {
                        const i32x4 a0 = __builtin_bit_cast(i32x4, acc[ai][bj][m][0]), a1 = __builtin_bit_cast(i32x4, acc[ai][bj][m][1]);
                        const f32x4 f0 = {(float)a0[0], (float)a0[1], (float)a0[2], (float)a0[3]}, f1 = {(float)a1[0], (float)a1[1], (float)a1[2], (float)a1[3]};
                        v0 = f0 * rs[ai][m] * cs[bj][0] + bv[bj][0]; v1 = f1 * rs[ai][m] * cs[bj][1] + bv[bj][1];
                        v0 = (f32x4){__builtin_amdgcn_exp2f(v0[0]), __builtin_amdgcn_exp2f(v0[1]), __builtin_amdgcn_exp2f(v0[2]), __builtin_amdgcn_exp2f(v0[3])} + 1.0f; v1 = (f32x4){__builtin_amdgcn_exp2f(v1[0]), __builtin_amdgcn_exp2f(v1[1]), __builtin_amdgcn_exp2f(v1[2]), __builtin_amdgcn_exp2f(v1[3])} + 1.0f; }
                    if (QI && !gate) { const i32x4 a0 = __builtin_bit_cast(i32x4, acc[ai][bj][m][0]), a1 = __builtin_bit_cast(i32x4, acc[ai][bj][m][1]);
                        v0 = (f32x4){(float)a0[0], (float)a0[1], (float)a0[2], (float)a0[3]} * rs[ai][m] * cs[bj][0]; v1 = (f32x4){(float)a1[0], (float)a1[1], (float)a1[2], (float)a1[3]} * rs[ai][m] * cs[bj][1]; }
                    if (gate) {
                        const f32x4 g0 = {__builtin_amdgcn_rcpf(v0[0]), __builtin_amdgcn_rcpf(v0[1]), __builtin_amdgcn_rcpf(v0[2]), __builtin_amdgcn_rcpf(v0[3])}, g1 = {__builtin_amdgcn_rcpf(v1[0]), __builtin_amdgcn_rcpf(v1[1]), __builtin_amdgcn_rcpf(v1[2]), __builtin_amdgcn_rcpf(v1[3])};
                        u32x2 w8; w8.x = pk_u8x4(fmaxf(g0[0], 0.00393f), fmaxf(g0[1], 0.00393f), fmaxf(g0[2], 0.00393f), fmaxf(g0[3], 0.00393f), 255.0f);
                        w8.y = pk_u8x4(fmaxf(g1[0], 0.00393f), fmaxf(g1[1], 0.00393f), fmaxf(g1[2], 0.00393f), fmaxf(g1[3], 0.00393f), 255.0f);
                        *(u32x2*)((unsigned char*)G + (size_t)(row0 + ai * HALF + m * 16) * 6144 + col0 + bj * HALF) = w8;
                    } else {
                    u32x4 w; w.x = cvt_pk_bf16(v0[0], v0[1]); w.y = cvt_pk_bf16(v0[2], v0[3]); w.z = cvt_pk_bf16(v1[0], v1[1]); w.w = cvt_pk_bf16(v1[2], v1[3]);
                    *(u32x4*)(rowp + bj * HALF) = w; } } }
    }
};
struct EpiF2 {
    static constexpr bool PERM = true, AFTER_DRAIN = false, KEEP = false;
    bf16_t* FOU; int rows_per_b, row_off, mirror; float scale; int r4;
    __device__ __forceinline__ void operator()(const f32x4 (&acc)[2][2][4][2], const Unit& u, int wr, int wc, int fr, int fq) const {
        asm volatile("" : "+v"(fr), "+v"(fq));
        const int b = u.pn >> 2, q = u.pn & 3;
        const int k0 = (r4 ? 0 : u.pm * BM) + wr * 64 + fr, col0 = q * BM + wc * 32 + 8 * fq;
        bf16_t* base = FOU + (size_t)(row_off + b * rows_per_b) * 1024 + col0;
#pragma unroll
        for (int ai = 0; ai < 2; ++ai)
#pragma unroll
            for (int m = 0; m < 4; ++m) { const int kk = r4 ? u.pm + 4 * (k0 + ai * HALF + m * 16) : k0 + ai * HALF + m * 16; bf16_t* rowp = base + (size_t)kk * 1024; bf16_t* rowm = base + (size_t)(rows_per_b - kk) * 1024;
#pragma unroll
                for (int bj = 0; bj < 2; ++bj) { const f32x4 v0 = acc[ai][bj][m][0] * scale, v1 = acc[ai][bj][m][1] * scale;
                    u32x4 w; w.x = cvt_pk_bf16(v0[0], v0[1]); w.y = cvt_pk_bf16(v0[2], v0[3]); w.z = cvt_pk_bf16(v1[0], v1[1]); w.w = cvt_pk_bf16(v1[2], v1[3]);
                    *(u32x4*)(rowp + bj * HALF) = w; if (mirror && kk > 0) *(u32x4*)(rowm + bj * HALF) = w; } }
    }
};
struct EpiBr {
    static constexpr bool PERM = true, AFTER_DRAIN = false, KEEP = true;
    const bf16_t* G; bf16_t* MG;
    __device__ __forceinline__ void operator()(f32x4 (&acc)[2][2][4][2], const Unit& u, int wr, int wc, int fr, int fq) const {
        asm volatile("" : "+v"(fr), "+v"(fq));
        const int kb = u.aux, row0 = u.pm * BM + wr * 64 + fr, col0 = u.pn * BM + wc * 32 + 8 * fq;
        const unsigned char* G8 = (const unsigned char*)G;
#define BR_U8(w) (f32x4){(float)((w) & 0xffu), (float)(((w) >> 8) & 0xffu), (float)(((w) >> 16) & 0xffu), (float)((w) >> 24)}
        const __amdgpu_buffer_rsrc_t rsG = __builtin_amdgcn_make_buffer_rsrc((void*)(((unsigned long long)(unsigned)__builtin_amdgcn_readfirstlane((int)(unsigned)((unsigned long long)G8 >> 32)) << 32) | (unsigned long long)(unsigned)__builtin_amdgcn_readfirstlane((int)(unsigned)(unsigned long long)G8)), (short)0, (int)((size_t)18432 * 6144), 0x00020000);
        const int voff = row0 * 6144 + kb * 2048 + col0;
#define BR_LD(ai, m, bj, extra) __builtin_bit_cast(u32x2, __builtin_amdgcn_raw_buffer_load_b64(rsG, voff, ((ai) * HALF + (m) * 16) * 6144 + (bj) * HALF + (extra), 0))
        u32x2 gw[2][4][2];
#pragma unroll
        for (int ai = 0; ai < 2; ++ai)
#pragma unroll
            for (int m = 0; m < 4; ++m)
#pragma unroll
                for (int bj = 0; bj < 2; ++bj) gw[ai][m][bj] = BR_LD(ai, m, bj, 0);
        if (kb < 2) {
            u32x2 hw[2][4][2];
#pragma unroll
            for (int ai = 0; ai < 2; ++ai)
#pragma unroll
                for (int m = 0; m < 4; ++m)
#pragma unroll
                    for (int bj = 0; bj < 2; ++bj) hw[ai][m][bj] = BR_LD(ai, m, bj, 2048);
            asm volatile("" ::: "memory");
#pragma unroll
            for (int ai = 0; ai < 2; ++ai)
#pragma unroll
                for (int m = 0; m < 4; ++m)
#pragma unroll
                    for (int bj = 0; bj < 2; ++bj) {
                        asm volatile("" : "+v"(gw[ai][m][bj].x), "+v"(gw[ai][m][bj].y), "+v"(hw[ai][m][bj].x), "+v"(hw[ai][m][bj].y));
                        const f32x4 n0 = BR_U8(gw[ai][m][bj].x), n1 = BR_U8(gw[ai][m][bj].y), d0 = BR_U8(hw[ai][m][bj].x), d1 = BR_U8(hw[ai][m][bj].y);
                        const f32x4 s0 = n0 * (f32x4){__builtin_amdgcn_rcpf(d0[0]), __builtin_amdgcn_rcpf(d0[1]), __builtin_amdgcn_rcpf(d0[2]), __builtin_amdgcn_rcpf(d0[3])};
                        const f32x4 s1 = n1 * (f32x4){__builtin_amdgcn_rcpf(d1[0]), __builtin_amdgcn_rcpf(d1[1]), __builtin_amdgcn_rcpf(d1[2]), __builtin_amdgcn_rcpf(d1[3])};
                        acc[ai][bj][m][0] = acc[ai][bj][m][0] * s0; acc[ai][bj][m][1] = acc[ai][bj][m][1] * s1;
                        asm volatile("" : "+v"(acc[ai][bj][m][0]), "+v"(acc[ai][bj][m][1])); }
        } else {
            asm volatile("" ::: "memory");
#pragma unroll
            for (int ai = 0; ai < 2; ++ai)
#pragma unroll
                for (int m = 0; m < 4; ++m)
#pragma unroll
                    for (int bj = 0; bj < 2; ++bj) { asm volatile("" : "+v"(gw[ai][m][bj].x), "+v"(gw[ai][m][bj].y));
                        const f32x4 v0 = acc[ai][bj][m][0] * (BR_U8(gw[ai][m][bj].x) * (1.0f / 255.0f)), v1 = acc[ai][bj][m][1] * (BR_U8(gw[ai][m][bj].y) * (1.0f / 255.0f));
                        u32x4 w; w.x = cvt_pk_bf16(v0[0], v0[1]); w.y = cvt_pk_bf16(v0[2], v0[3]); w.z = cvt_pk_bf16(v1[0], v1[1]); w.w = cvt_pk_bf16(v1[2], v1[3]);
                        *(u32x4*)(MG + (size_t)(row0 + ai * HALF + m * 16) * 2048 + col0 + bj * HALF) = w; }
        }
        asm volatile("" ::: "memory");
#undef BR_U8
#undef BR_LD
    }
};
struct EpiRes {
    static constexpr bool PERM = true, AFTER_DRAIN = false, KEEP = false;
    bf16_t* X; const float* gv; bf16_t* Xdup;
    __device__ __forceinline__ void operator()(const f32x4 (&acc)[2][2][4][2], const Unit& u, int wr, int wc, int fr, int fq) const {
        asm volatile("" : "+v"(fr), "+v"(fq));
        const int rsel = u.pm < 64 ? (u.pm >> 3) : 8; const float* gr = gv + (size_t)rsel * 12288;
        const int row0 = u.pm * BM + wr * 64 + fr, col0 = u.pn * BM + wc * 32 + 8 * fq;
        f32x4 gvv[2][2];
#pragma unroll
        for (int bj = 0; bj < 2; ++bj)
#pragma unroll
            for (int n = 0; n < 2; ++n) gvv[bj][n] = *(const f32x4*)(gr + col0 + bj * HALF + n * 4);
        u32x4 xw[2][4][2];
#pragma unroll
        for (int ai = 0; ai < 2; ++ai)
#pragma unroll
            for (int m = 0; m < 4; ++m)
#pragma unroll
                for (int bj = 0; bj < 2; ++bj) xw[ai][m][bj] = *(const u32x4*)(X + (size_t)(row0 + ai * HALF + m * 16) * 2048 + col0 + bj * HALF);
#pragma unroll
        for (int ai = 0; ai < 2; ++ai)
#pragma unroll
            for (int m = 0; m < 4; ++m) { bf16_t* rowp = X + (size_t)(row0 + ai * HALF + m * 16) * 2048 + col0;
#pragma unroll
                for (int bj = 0; bj < 2; ++bj) { bf16_t* p = rowp + bj * HALF; bf16_t* pw = PROBE_MASK ? (u.dupv ? Xdup + (p - X) : p) : p;
                    const u32x4 x = xw[ai][m][bj];
                    const f32x4 v0 = (f32x4){bflo(x.x), bfhi(x.x), bflo(x.y), bfhi(x.y)} + gvv[bj][0] * acc[ai][bj][m][0];
                    const f32x4 v1 = (f32x4){bflo(x.z), bfhi(x.z), bflo(x.w), bfhi(x.w)} + gvv[bj][1] * acc[ai][bj][m][1];
                    u32x4 w; w.x = cvt_pk_bf16(v0[0], v0[1]); w.y = cvt_pk_bf16(v0[2], v0[3]); w.z = cvt_pk_bf16(v1[0], v1[1]); w.w = cvt_pk_bf16(v1[2], v1[3]);
                    *(u32x4*)pw = w; } }
    }
};
struct EpiResSlab {
    static constexpr bool PERM = false, AFTER_DRAIN = false, KEEP = false;
    float* SL; const float* gv;
    __device__ __forceinline__ void operator()(const f32x4 (&acc)[2][2][4][2], const Unit& u, int wr, int wc, int fr, int fq) const {
        asm volatile("" : "+v"(fr), "+v"(fq));
        const float* gr = gv + (size_t)8 * 12288;
        const int row0 = (u.pm - 64) * BM + wr * 64 + fr, col0 = u.pn * BM + wc * 32 + 4 * fq;
        float* base = SL + (size_t)u.aux * 2048 * 2048;
        f32x4 gvv[2][2];
#pragma unroll
        for (int bj = 0; bj < 2; ++bj)
#pragma unroll
            for (int n = 0; n < 2; ++n) gvv[bj][n] = *(const f32x4*)(gr + col0 + bj * HALF + n * 16);
#pragma unroll
        for (int ai = 0; ai < 2; ++ai)
#pragma unroll
            for (int m = 0; m < 4; ++m) { float* rowp = base + (size_t)(row0 + ai * HALF + m * 16) * 2048 + col0;
#pragma unroll
                for (int bj = 0; bj < 2; ++bj)
#pragma unroll
                    for (int n = 0; n < 2; ++n) *(f32x4*)(rowp + bj * HALF + n * 16) = gvv[bj][n] * acc[ai][bj][m][n]; }
    }
};
struct QuarterOrder {
    int G, c; const char* A; const char* B; size_t astep, bstep, kbytes;
    __device__ __forceinline__ bool next(int i, Unit& u) const {
        const int L = i * G + c; if (L >= 256) return false;
        u.pm = 64 + (L >> 5); u.pn = (L >> 2) & 7; u.aux = L & 3; u.dupv = 0;
        u.A = A + (size_t)u.pm * astep + (size_t)u.aux * kbytes; u.B = B + (size_t)u.pn * bstep + (size_t)u.aux * kbytes; return true;
    }
    __device__ __forceinline__ void a_ready(const Unit&) const {}
    __device__ __forceinline__ void done(const Unit&) const {}
};
struct EpiSwi {
    static constexpr bool PERM = true, AFTER_DRAIN = false, KEEP = false;
    bf16_t* ACT;
    __device__ __forceinline__ void operator()(const f32x4 (&acc)[2][2][4][2], const Unit& u, int wr, int wc, int fr, int fq) const {
        asm volatile("" : "+v"(fr), "+v"(fq));
        const int row0 = u.pm * BM + wr * 64 + fr, col0 = u.pn * HALF + wc * 32 + 8 * fq;
#pragma unroll
        for (int ai = 0; ai < 2; ++ai)
#pragma unroll
            for (int m = 0; m < 4; ++m) { bf16_t* rowp = ACT + (size_t)(row0 + ai * HALF + m * 16) * 5632 + col0;
                f32x4 o[2];
#pragma unroll
                for (int n = 0; n < 2; ++n) { const f32x4 g = acc[ai][0][m][n], up = acc[ai][1][m][n];
                    o[n] = (f32x4){g[0] * sigm(g[0]) * up[0], g[1] * sigm(g[1]) * up[1], g[2] * sigm(g[2]) * up[2], g[3] * sigm(g[3]) * up[3]}; }
                u32x4 w; w.x = cvt_pk_bf16(o[0][0], o[0][1]); w.y = cvt_pk_bf16(o[0][2], o[0][3]); w.z = cvt_pk_bf16(o[1][0], o[1][1]); w.w = cvt_pk_bf16(o[1][2], o[1][3]);
                *(u32x4*)rowp = w; }
    }
};

template <class Epi, class Sched, bool ALIGN_EPI = false, bool SP2 = false, int QM = 0>
__device__ __forceinline__ void gemm_phase(PG8_LAS unsigned char* lds, const Gemm g, const Sched& S, const Epi& E, const int tid) {
    { unsigned l32_ = (unsigned)(unsigned long long)lds; asm volatile("" : "+s"(l32_)); lds = (PG8_LAS unsigned char*)(unsigned long long)l32_; }
    const int wid = __builtin_amdgcn_readfirstlane(tid >> 6), lane = tid & 63, wr = wid >> 2, wc = wid & 3, fr = lane & 15, fq = lane >> 4;
    const int K = g.K, nt = K / BK;
    unsigned voffA, voffB;
    { int R, C; stage_rc(tid * 16, R, C); const int Rb = Epi::PERM ? ((R & ~31) + perm32(R & 31)) : R;
        voffA = (unsigned)(R * g.lda + C) * 2u; voffB = (unsigned)(Rb * g.ldb + C) * 2u; }
    const size_t rstepA = (size_t)64 * g.lda * 2, rstepB = (size_t)64 * g.ldb * 2;
    const size_t kstep = (size_t)(BK * 2);
    const size_t hstepA = (size_t)HALF * g.lda * 2, hstepB = (size_t)HALF * g.ldb * 2;
    const unsigned ldsw = (unsigned)wid * 1024u;
    const int aoff = lds_byte(wr * 64 + fr, fq * 8), boff = lds_byte(wc * 32 + fr, fq * 8);
#define PG8_SA(b, h) (((b) * 2 + (h)) * HTB)
#define PG8_SB(b, h) ((4 + (b) * 2 + (h)) * HTB)
#define PG8_STAGE(bufoff, gbase, voff) do { _Pragma("unroll") for (int _i = 0; _i < 2; ++_i) \
        __builtin_amdgcn_global_load_lds((const unsigned*)((const char*)(gbase) + (size_t)_i * rstep_##voff + (voff)), (PG8_LAS unsigned*)(lds + (bufoff) + ldsw + _i * 8192), 16, 0, 0); } while (0)
#define rstep_voffA rstepA
#define rstep_voffB rstepB
#define PG8_LDA(dst, b, h) do { _Pragma("unroll") for (int m = 0; m < 4; ++m) _Pragma("unroll") for (int k = 0; k < 2; ++k) dst[m][k] = *(const PG8_LAS bf16x8*)(lds + PG8_SA(b, h) + aoff + m * 2048 + k * 1024); } while (0)
#define PG8_LDB(dst, b, h) do { _Pragma("unroll") for (int n = 0; n < 2; ++n) _Pragma("unroll") for (int k = 0; k < 2; ++k) dst[n][k] = *(const PG8_LAS bf16x8*)(lds + PG8_SB(b, h) + boff + n * 2048 + k * 1024); } while (0)
#define PG8_CAT(x, y) __builtin_shufflevector(__builtin_bit_cast(i32x4, x), __builtin_bit_cast(i32x4, y), 0, 1, 2, 3, 4, 5, 6, 7)
#define PG8_MMA(ai, bj, At, Bt) do { __builtin_amdgcn_s_setprio(1); \
        if constexpr (QM == 1) { _Pragma("unroll") for (int m = 0; m < 4; ++m) _Pragma("unroll") for (int n = 0; n < 2; ++n) \
            acc[ai][bj][m][n] = __builtin_amdgcn_mfma_scale_f32_16x16x128_f8f6f4(PG8_CAT(Bt[n][0], Bt[n][1]), PG8_CAT(At[m][0], At[m][1]), acc[ai][bj][m][n], 0, 0, 0, 0x7f7f7f7f, 0, 0x7f7f7f7f); } \
        else if constexpr (QM == 2) { _Pragma("unroll") for (int m = 0; m < 4; ++m) _Pragma("unroll") for (int n = 0; n < 2; ++n) _Pragma("unroll") for (int k = 0; k < 2; ++k) \
            acc[ai][bj][m][n] = __builtin_bit_cast(f32x4, __builtin_amdgcn_mfma_i32_16x16x64_i8(__builtin_bit_cast(i32x4, Bt[n][k]), __builtin_bit_cast(i32x4, At[m][k]), __builtin_bit_cast(i32x4, acc[ai][bj][m][n]), 0, 0, 0)); } \
        else { _Pragma("unroll") for (int m = 0; m < 4; ++m) _Pragma("unroll") for (int n = 0; n < 2; ++n) _Pragma("unroll") for (int k = 0; k < 2; ++k) \
            acc[ai][bj][m][n] = __builtin_amdgcn_mfma_f32_16x16x32_bf16(Bt[n][k], At[m][k], acc[ai][bj][m][n], 0, 0, 0); } \
        __builtin_amdgcn_s_setprio(0); } while (0)
#define PG8_WAIT_V(n) asm volatile("s_waitcnt vmcnt(" #n ")" ::: "memory")
#define PG8_WAIT_L(n) asm volatile("s_waitcnt lgkmcnt(" #n ")" ::: "memory")
#define PG8_BAR __builtin_amdgcn_s_barrier()
#define PG8_SCHED __builtin_amdgcn_sched_barrier(0)
    Unit cur, nxt; int ui = 0;
    if (!S.next(0, cur)) return;
    f32x4 acc[2][2][4][2];
#pragma unroll
    for (int a = 0; a < 2; ++a)
#pragma unroll
        for (int b = 0; b < 2; ++b)
#pragma unroll
            for (int m = 0; m < 4; ++m)
#pragma unroll
                for (int n = 0; n < 2; ++n) acc[a][b][m][n] = (f32x4){0.f, 0.f, 0.f, 0.f};
    bf16x8 At[4][2], B0[2][2], B1[2][2];
    const char* cA = cur.A; const char* cB = cur.B;
    S.a_ready(cur);
    if constexpr (SP2) {
        PG8_STAGE(PG8_SB(0, 0), cB, voffB); PG8_STAGE(PG8_SB(0, 1), cB + hstepB, voffB); PG8_STAGE(PG8_SA(0, 0), cA, voffA); PG8_STAGE(PG8_SA(0, 1), cA + hstepA, voffA);
        if (wr == 1) PG8_BAR;
        PG8_WAIT_V(2); PG8_BAR;
        PG8_STAGE(PG8_SB(1, 0), cB + kstep, voffB); PG8_STAGE(PG8_SA(1, 0), cA + kstep, voffA); PG8_STAGE(PG8_SB(1, 1), cB + hstepB + kstep, voffB);
        PG8_WAIT_V(6); PG8_BAR;
    } else {
        PG8_STAGE(PG8_SB(0, 0), cB, voffB); PG8_STAGE(PG8_SA(0, 0), cA, voffA); PG8_STAGE(PG8_SB(0, 1), cB + hstepB, voffB); PG8_STAGE(PG8_SA(0, 1), cA + hstepA, voffA);
        if (wr == 1) PG8_BAR;
        PG8_WAIT_V(4); PG8_BAR;
        PG8_STAGE(PG8_SB(1, 0), cB + kstep, voffB); PG8_STAGE(PG8_SA(1, 0), cA + kstep, voffA); PG8_STAGE(PG8_SB(1, 1), cB + hstepB + kstep, voffB);
        PG8_WAIT_V(6); PG8_BAR;
    }
    for (;;) {
        const bool has_next = S.next(ui + 1, nxt);
        const char* nA = has_next ? nxt.A : cA; const char* nB = has_next ? nxt.B : cB;
        for (int t = 0; t < nt; t += 2) {
            const bool last = (t == nt - 2);
            const char* a1 = cA + (size_t)(t + 1) * kstep;
            const char* a2 = last ? nA : cA + (size_t)(t + 2) * kstep; const char* b2 = last ? nB : cB + (size_t)(t + 2) * kstep;
            const char* a3 = a2 + kstep; const char* b3 = b2 + kstep;
            if (last && has_next) S.a_ready(nxt);
            if constexpr (SP2) {
            PG8_LDB(B0, 0, 0); PG8_LDB(B1, 0, 1); PG8_SCHED; PG8_LDA(At, 0, 0); PG8_STAGE(PG8_SA(1, 1), a1 + hstepA, voffA);
            PG8_WAIT_V(8); PG8_WAIT_L(0); PG8_BAR; PG8_MMA(0, 0, At, B0); PG8_MMA(0, 1, At, B1); PG8_BAR; PG8_SCHED;
            PG8_LDA(At, 0, 1); PG8_STAGE(PG8_SB(0, 0), b2, voffB); PG8_STAGE(PG8_SB(0, 1), b2 + hstepB, voffB); PG8_STAGE(PG8_SA(0, 0), a2, voffA);
            PG8_WAIT_V(8); PG8_WAIT_L(0); PG8_BAR; PG8_MMA(1, 0, At, B0); PG8_MMA(1, 1, At, B1); PG8_BAR; PG8_SCHED;
            PG8_LDB(B0, 1, 0); PG8_LDB(B1, 1, 1); PG8_SCHED; PG8_LDA(At, 1, 0); PG8_STAGE(PG8_SA(0, 1), a2 + hstepA, voffA);
            PG8_WAIT_V(8); PG8_WAIT_L(0); PG8_BAR; PG8_MMA(0, 0, At, B0); PG8_MMA(0, 1, At, B1); PG8_BAR; PG8_SCHED;
            PG8_LDA(At, 1, 1); PG8_STAGE(PG8_SB(1, 0), b3, voffB); PG8_STAGE(PG8_SB(1, 1), b3 + hstepB, voffB); PG8_STAGE(PG8_SA(1, 0), a3, voffA);
            PG8_WAIT_V(8); PG8_WAIT_L(0); PG8_BAR; PG8_MMA(1, 0, At, B0); PG8_MMA(1, 1, At, B1); PG8_BAR; PG8_SCHED;
            } else {
            PG8_LDB(B0, 0, 0); PG8_SCHED; PG8_LDA(At, 0, 0); PG8_STAGE(PG8_SA(1, 1), a1 + hstepA, voffA);
            PG8_WAIT_L(8); PG8_BAR; PG8_WAIT_L(0); PG8_MMA(0, 0, At, B0); PG8_BAR; PG8_SCHED;
            PG8_LDB(B1, 0, 1); PG8_STAGE(PG8_SB(0, 0), b2, voffB);
            PG8_BAR; PG8_WAIT_L(0); PG8_MMA(0, 1, At, B1); PG8_BAR;
            PG8_LDA(At, 0, 1); PG8_STAGE(PG8_SA(0, 0), a2, voffA);
            PG8_BAR; PG8_WAIT_L(0); PG8_MMA(1, 0, At, B0); PG8_BAR; PG8_SCHED;
            PG8_STAGE(PG8_SB(0, 1), b2 + hstepB, voffB);
            PG8_WAIT_V(6); PG8_BAR; PG8_MMA(1, 1, At, B1); PG8_BAR;
            PG8_LDB(B0, 1, 0); PG8_SCHED; PG8_LDA(At, 1, 0); PG8_STAGE(PG8_SA(0, 1), a2 + hstepA, voffA);
            PG8_WAIT_L(8); PG8_BAR; PG8_WAIT_L(0); PG8_MMA(0, 0, At, B0); PG8_BAR; PG8_SCHED;
            PG8_LDB(B1, 1, 1); PG8_STAGE(PG8_SB(1, 0), b3, voffB);
            PG8_BAR; PG8_WAIT_L(0); PG8_MMA(0, 1, At, B1); PG8_BAR;
            PG8_LDA(At, 1, 1); PG8_STAGE(PG8_SA(1, 0), a3, voffA);
            PG8_BAR; PG8_WAIT_L(0); PG8_MMA(1, 0, At, B0); PG8_BAR; PG8_SCHED;
            PG8_STAGE(PG8_SB(1, 1), b3 + hstepB, voffB);
            PG8_WAIT_V(6); PG8_BAR; PG8_MMA(1, 1, At, B1); PG8_BAR;
            }
        }
        if constexpr (ALIGN_EPI) { if (wr == 0) PG8_BAR; }
        if constexpr (!Epi::AFTER_DRAIN) { int l2_; asm volatile("v_mbcnt_lo_u32_b32 %0, -1, 0\n\tv_mbcnt_hi_u32_b32 %0, -1, %0" : "=v"(l2_)); E(acc, cur, wr, wc, l2_ & 15, l2_ >> 4); S.done(cur); }
        if (!has_next) break;
        if (!(Epi::KEEP && cur.aux < 2)) {
#pragma unroll
        for (int a = 0; a < 2; ++a)
#pragma unroll
            for (int b = 0; b < 2; ++b)
#pragma unroll
                for (int m = 0; m < 4; ++m)
#pragma unroll
                    for (int n = 0; n < 2; ++n) acc[a][b][m][n] = (f32x4){0.f, 0.f, 0.f, 0.f};
        }
        cur = nxt; cA = nA; cB = nB; ++ui;
        if constexpr (ALIGN_EPI) { if (wr == 1) PG8_BAR; }
    }
    PG8_WAIT_V(0);
    if constexpr (!ALIGN_EPI) { if (wr == 0) PG8_BAR; }
    PG8_BAR;
    if constexpr (Epi::AFTER_DRAIN) { E.fused(acc, cur, wr, wc, fr, fq, lds, wid, lane); S.done(cur); }
#undef PG8_SA
#undef PG8_SB
#undef PG8_STAGE
#undef rstep_voffA
#undef rstep_voffB
#undef PG8_LDA
#undef PG8_LDB
#undef PG8_MMA
#undef PG8_CAT
#undef PG8_WAIT_V
#undef PG8_WAIT_L
#undef PG8_BAR
#undef PG8_SCHED
}
}

namespace att {
typedef unsigned short bf16_t;
using bf16x8 = __attribute__((ext_vector_type(8))) short;
using s16x4  = __attribute__((ext_vector_type(4))) short;
using f32x16 = __attribute__((ext_vector_type(16))) float;
using f32x4  = __attribute__((ext_vector_type(4))) float;
using u32x4  = __attribute__((ext_vector_type(4))) unsigned;
constexpr int D = 128, NW = 8, QBLK = 32, KVBLK = 64;
constexpr float SCALE = 0.088388347648318440f;
constexpr float THR = 8.f;
constexpr int SDEPTH = 2;
constexpr size_t SHM_V = KVBLK * D * 2, SHM_K = KVBLK * D * 2, SHM_ATTN = 2 * SHM_V + 2 * SHM_K + NW * 64 * 4;
#define KSWZ(row, colB) ((row) * 256 + ((colB) ^ (((row) & 7) << 4)))
#define SBAR() __builtin_amdgcn_sched_barrier(0)
__device__ __forceinline__ int crow(int r, int hi) { return (r & 3) + 8 * (r >> 2) + 4 * hi; }
__device__ __forceinline__ unsigned cvtpk(float lo, float hi) { unsigned r; asm volatile("v_cvt_pk_bf16_f32 %0, %1, %2" : "=v"(r) : "v"(lo), "v"(hi)); return r; }
__device__ __forceinline__ bf16x8 ld8(const bf16_t* p) { return *reinterpret_cast<const bf16x8*>(p); }
__device__ __forceinline__ float b2f(short v) { return __uint_as_float(((unsigned)(unsigned short)v) << 16); }

__device__ __forceinline__ void partialSM(f32x16& p0, f32x16& p1, float& m_reg, float& mn, float& alpha) {
  constexpr float C = SCALE * 1.4426950408889634f;
  float pmax = p0[0]; for (int r = 1; r < 16; ++r) pmax = fmaxf(pmax, p0[r]); for (int r = 0; r < 16; ++r) pmax = fmaxf(pmax, p1[r]);
  { auto rr = __builtin_amdgcn_permlane32_swap(__float_as_uint(pmax), __float_as_uint(pmax), false, false);
    pmax = fmaxf(__uint_as_float(rr[0]), __uint_as_float(rr[1])); }
  if (__builtin_expect(__all(pmax - m_reg <= THR / SCALE), 1)) { mn = m_reg; alpha = 1.f; }
  else { mn = fmaxf(m_reg, pmax); alpha = __builtin_amdgcn_exp2f((m_reg - mn) * C); m_reg = mn; }
  float mnC = -mn * C;
  for (int r = 0; r < 16; ++r) p0[r] = fmaf(p0[r], C, mnC); for (int r = 0; r < 16; ++r) p1[r] = fmaf(p1[r], C, mnC);
  for (int r = 0; r < 16; ++r) p0[r] = __builtin_amdgcn_exp2f(p0[r]);
}
__device__ __forceinline__ void finishSM(f32x16& p0, f32x16& p1, float alpha, float& l_reg, bf16x8& pa0, bf16x8& pa1, bf16x8& pa2, bf16x8& pa3) {
  for (int r = 0; r < 16; ++r) p1[r] = __builtin_amdgcn_exp2f(p1[r]);
  float ps = 0; for (int r = 0; r < 16; ++r) ps += p0[r]; for (int r = 0; r < 16; ++r) ps += p1[r];
  { auto rr = __builtin_amdgcn_permlane32_swap(__float_as_uint(ps), __float_as_uint(ps), false, false);
    ps = __uint_as_float(rr[0]) + __uint_as_float(rr[1]); }
  l_reg = l_reg * alpha + ps;
#define PK4(P, BASE, OUT) do { unsigned a0 = cvtpk(P[BASE + 0], P[BASE + 1]), a1 = cvtpk(P[BASE + 2], P[BASE + 3]);   \
    unsigned b0 = cvtpk(P[BASE + 4], P[BASE + 5]), b1 = cvtpk(P[BASE + 6], P[BASE + 7]);                              \
    auto r0 = __builtin_amdgcn_permlane32_swap(a0, b0, false, false); auto r1 = __builtin_amdgcn_permlane32_swap(a1, b1, false, false); \
    u32x4 w = {r0[0], r1[0], r0[1], r1[1]}; OUT = *reinterpret_cast<bf16x8*>(&w); } while (0)
  PK4(p0, 0, pa0); PK4(p0, 8, pa1); PK4(p1, 0, pa2); PK4(p1, 8, pa3);
#undef PK4
}
__device__ __forceinline__ void qkt(f32x16& p0, f32x16& p1, const bf16_t* Ks, const bf16x8* qr, int r32, int hi) {
  p0 = f32x16{}; p1 = f32x16{};
  for (int d0 = 0; d0 < 8; ++d0) { int cb = (d0 * 16 + hi * 8) * 2;
    bf16x8 b0 = *reinterpret_cast<const bf16x8*>((const char*)Ks + KSWZ(r32, cb));
    bf16x8 b1 = *reinterpret_cast<const bf16x8*>((const char*)Ks + KSWZ(32 + r32, cb));
    p0 = __builtin_amdgcn_mfma_f32_32x32x16_bf16(b0, qr[d0], p0, 0, 0, 0);
    p1 = __builtin_amdgcn_mfma_f32_32x32x16_bf16(b1, qr[d0], p1, 0, 0, 0); }
}
__device__ __forceinline__ int v_st(int k, int c) { const int kk = (k & ~0xC) | ((k & 4) << 1) | ((k & 8) >> 1); return ((kk >> 3) * 4 + (c >> 5)) * 512 + ((kk & 7) * 32 + (c & 31)) * 2; }
__device__ __forceinline__ int v_rd_base(int lane) { return ((lane & 3) << 3) | (((lane >> 2) & 3) << 6) | (((lane >> 4) & 1) << 5) | (((lane >> 5) & 1) << 8); }
constexpr int v_rd_off(int d0, int ks, int half) { return d0 * 512 + ks * 4096 + half * 2048; }
template <int OFF> __device__ __forceinline__ s16x4 tr_read(int vb) {
  s16x4 r; asm volatile("ds_read_b64_tr_b16 %0, %1 offset:%2" : "=&v"(r) : "v"(vb), "i"(OFF) : "memory"); return r;
}
template <int D0> __device__ __forceinline__ void pv_one(f32x16& od, int vb, bf16x8 pa0, bf16x8 pa1, bf16x8 pa2, bf16x8 pa3) {
  const s16x4 l0 = tr_read<v_rd_off(D0, 0, 0)>(vb), h0 = tr_read<v_rd_off(D0, 0, 1)>(vb), l1 = tr_read<v_rd_off(D0, 1, 0)>(vb), h1 = tr_read<v_rd_off(D0, 1, 1)>(vb);
  const s16x4 l2 = tr_read<v_rd_off(D0, 2, 0)>(vb), h2 = tr_read<v_rd_off(D0, 2, 1)>(vb), l3 = tr_read<v_rd_off(D0, 3, 0)>(vb), h3 = tr_read<v_rd_off(D0, 3, 1)>(vb);
  asm volatile("s_waitcnt lgkmcnt(0)" ::: "memory"); SBAR();
#define PK(L, H) (bf16x8){L[0], L[1], L[2], L[3], H[0], H[1], H[2], H[3]}
  od = __builtin_amdgcn_mfma_f32_32x32x16_bf16(pa0, PK(l0, h0), od, 0, 0, 0);
  od = __builtin_amdgcn_mfma_f32_32x32x16_bf16(pa1, PK(l1, h1), od, 0, 0, 0);
  od = __builtin_amdgcn_mfma_f32_32x32x16_bf16(pa2, PK(l2, h2), od, 0, 0, 0);
  od = __builtin_amdgcn_mfma_f32_32x32x16_bf16(pa3, PK(l3, h3), od, 0, 0, 0);
#undef PK
}
__device__ __forceinline__ void pv_d0(f32x16* o, int vb, bf16x8 pa0, bf16x8 pa1, bf16x8 pa2, bf16x8 pa3) {
  pv_one<0>(o[0], vb, pa0, pa1, pa2, pa3); pv_one<1>(o[1], vb, pa0, pa1, pa2, pa3); pv_one<2>(o[2], vb, pa0, pa1, pa2, pa3); pv_one<3>(o[3], vb, pa0, pa1, pa2, pa3);
}

__device__ __forceinline__ void attn_unit(const bf16_t* __restrict__ Qb, int ldq, const bf16_t* __restrict__ K0, const bf16_t* __restrict__ K1, const bf16_t* __restrict__ V0, const bf16_t* __restrict__ V1,
                                          int n0, int NT, int ldk, int ldv, bf16_t* __restrict__ Ob, int ldo, const float* __restrict__ qgain, const float* __restrict__ rope_cs, char* lds, int tid) {
  asm volatile("" : "+v"(tid));
  const int wid = tid >> 6, lane = tid & 63, r32 = lane & 31, hi = lane >> 5;
  bf16_t* V_lds = (bf16_t*)lds; bf16_t* K_lds = (bf16_t*)(lds + 2 * SHM_V);
  float* ws = (float*)(lds + 2 * SHM_V + 2 * SHM_K) + wid * 64; float* li_l = ws; float* al_l = ws + 32;
  float m_reg = -1e30f, l_reg = 0; f32x16 o[4] = {}; bf16x8 qr[8];
  const bf16_t* Qw = Qb + (long)(wid * QBLK + r32) * ldq + hi * 8;
#pragma unroll
  for (int d0 = 0; d0 < 8; ++d0) qr[d0] = ld8(Qw + d0 * 16);
  {
    float ss = 0.f;
#pragma unroll
    for (int d0 = 0; d0 < 8; ++d0)
#pragma unroll
      for (int j = 0; j < 8; ++j) { const float f = b2f(qr[d0][j]); ss += f * f; }
    { auto rr = __builtin_amdgcn_permlane32_swap(__float_as_uint(ss), __float_as_uint(ss), false, false); ss = __uint_as_float(rr[0]) + __uint_as_float(rr[1]); }
    const float rstd = 1.0f / sqrtf(ss * (1.0f / 128.0f) + 1e-6f);
#pragma unroll
    for (int d0 = 0; d0 < 4; ++d0) {
      const int i0 = d0 * 16 + hi * 8;
      const f32x4 ga0 = *(const f32x4*)(qgain + i0), ga1 = *(const f32x4*)(qgain + i0 + 4), gb0 = *(const f32x4*)(qgain + 64 + i0), gb1 = *(const f32x4*)(qgain + 64 + i0 + 4);
      float a[8], b[8];
#pragma unroll
      for (int j = 0; j < 8; ++j) { a[j] = b2f(qr[d0][j]) * rstd * (j < 4 ? ga0[j & 3] : ga1[j & 3]); b[j] = b2f(qr[d0 + 4][j]) * rstd * (j < 4 ? gb0[j & 3] : gb1[j & 3]); }
      if (rope_cs) {
        const float* cp = rope_cs + (long)(wid * QBLK + r32) * 64 + i0;
        const f32x4 c0 = *(const f32x4*)cp, c1 = *(const f32x4*)(cp + 4), s0 = *(const f32x4*)(cp + 2048 * 64), s1 = *(const f32x4*)(cp + 2048 * 64 + 4);
#pragma unroll
        for (int j = 0; j < 8; ++j) { const float c = j < 4 ? c0[j & 3] : c1[j & 3], s = j < 4 ? s0[j & 3] : s1[j & 3]; const float na = a[j] * c - b[j] * s, nb = b[j] * c + a[j] * s; a[j] = na; b[j] = nb; }
      }
      u32x4 wa = {cvtpk(a[0], a[1]), cvtpk(a[2], a[3]), cvtpk(a[4], a[5]), cvtpk(a[6], a[7])}, wb = {cvtpk(b[0], b[1]), cvtpk(b[2], b[3]), cvtpk(b[4], b[5]), cvtpk(b[6], b[7])};
      qr[d0] = *reinterpret_cast<bf16x8*>(&wa); qr[d0 + 4] = *reinterpret_cast<bf16x8*>(&wb);
    }
  }
  const int sr = tid >> 4, sc = (tid & 15) * 8, vst0 = v_st(sr, sc), vst1 = v_st(32 + sr, sc);
  const int vb0 = (int)(uintptr_t)V_lds + v_rd_base(lane);
  struct { bf16x8 vs0, vs1, ks0, ks1; } sr_[SDEPTH];
#define SLOAD(i, tile) do { const int tl_ = (tile); const bf16_t* kp_ = tl_ < n0 ? K0 + (long)tl_ * KVBLK * ldk : K1 + (long)(tl_ - n0) * KVBLK * ldk; \
    const bf16_t* vp_ = tl_ < n0 ? V0 + (long)tl_ * KVBLK * ldv : V1 + (long)(tl_ - n0) * KVBLK * ldv; \
    sr_[i].vs0 = ld8(vp_ + (long)sr * ldv + sc); sr_[i].vs1 = ld8(vp_ + (long)(32 + sr) * ldv + sc); \
    sr_[i].ks0 = ld8(kp_ + (long)sr * ldk + sc); sr_[i].ks1 = ld8(kp_ + (long)(32 + sr) * ldk + sc); } while (0)
#define SWRITE(b, i) do { *(bf16x8*)((char*)V_lds + (b) * SHM_V + vst0) = sr_[i].vs0;          \
    *(bf16x8*)((char*)V_lds + (b) * SHM_V + vst1) = sr_[i].vs1; int kc = sc * 2;               \
    *(bf16x8*)((char*)K_lds + (b) * SHM_K + KSWZ(sr, kc)) = sr_[i].ks0;                       \
    *(bf16x8*)((char*)K_lds + (b) * SHM_K + KSWZ(32 + sr, kc)) = sr_[i].ks1; } while (0)
#define SWAIT() asm volatile("s_waitcnt vmcnt(4)" ::: "memory")
#define RESC(a) do { if (__any((a) < 1.f)) { if (hi == 0) al_l[r32] = (a); asm volatile("s_waitcnt lgkmcnt(0)" ::: "memory"); \
    for (int d = 0; d < 4; ++d) for (int r = 0; r < 16; ++r) o[d][r] *= al_l[crow(r, hi)]; } } while (0)
  f32x16 pA0, pA1, pB0, pB1; float mnA, mnB, alA, alB; bf16x8 pa0, pa1, pa2, pa3;
  constexpr int SE = 0, SO = SDEPTH - 1;
  SLOAD(SE, 0); asm volatile("s_waitcnt vmcnt(0)" ::: "memory"); SWRITE(0, SE); __syncthreads();
  qkt(pA0, pA1, K_lds, qr, r32, hi); partialSM(pA0, pA1, m_reg, mnA, alA);
  SLOAD(SO, 1); if (2 < NT) SLOAD(SE, 2);
  SWAIT(); SWRITE(1, SO); __syncthreads();
  for (int j = 1; j + 1 < NT; j += 2) {
    SBAR(); qkt(pB0, pB1, (bf16_t*)((char*)K_lds + SHM_K), qr, r32, hi);
    finishSM(pA0, pA1, alA, l_reg, pa0, pa1, pa2, pa3); SBAR();
    SLOAD(SO, j + SDEPTH); SBAR();
    pv_d0(o, vb0, pa0, pa1, pa2, pa3); partialSM(pB0, pB1, m_reg, mnB, alB);
    __syncthreads(); SWAIT(); SWRITE(0, SE);
    RESC(alB); __syncthreads();
    SBAR(); qkt(pA0, pA1, K_lds, qr, r32, hi);
    finishSM(pB0, pB1, alB, l_reg, pa0, pa1, pa2, pa3); SBAR();
    if (j + 3 < NT) SLOAD(SE, j + 1 + SDEPTH); SBAR();
    pv_d0(o, vb0 + (int)SHM_V, pa0, pa1, pa2, pa3); partialSM(pA0, pA1, m_reg, mnA, alA);
    __syncthreads(); SWAIT(); SWRITE(1, SO);
    RESC(alA); __syncthreads();
  }
  SBAR(); qkt(pB0, pB1, (bf16_t*)((char*)K_lds + SHM_K), qr, r32, hi);
  finishSM(pA0, pA1, alA, l_reg, pa0, pa1, pa2, pa3); SBAR();
  pv_d0(o, vb0, pa0, pa1, pa2, pa3); partialSM(pB0, pB1, m_reg, mnB, alB);
  __syncthreads(); RESC(alB);
  finishSM(pB0, pB1, alB, l_reg, pa0, pa1, pa2, pa3); SBAR();
  pv_d0(o, vb0 + (int)SHM_V, pa0, pa1, pa2, pa3);
  if (hi == 0) li_l[r32] = l_reg; asm volatile("s_waitcnt lgkmcnt(0)" ::: "memory");
  float rli[16];
#pragma unroll
  for (int r = 0; r < 16; ++r) rli[r] = __builtin_amdgcn_rcpf(li_l[crow(r, hi)]);
  bf16_t* Ow = Ob + (long)(wid * QBLK) * ldo;
  {
    char* stg = lds + SHM_ATTN + wid * 8704;
#pragma unroll
    for (int r = 0; r < 16; ++r) { const int orow = crow(r, hi);
#pragma unroll
      for (int d0 = 0; d0 < 4; ++d0) *(bf16_t*)(stg + orow * 272 + (d0 * 32 + r32) * 2) = (bf16_t)(cvtpk(o[d0][r] * rli[r], 0.f) & 0xffffu); }
    asm volatile("s_waitcnt lgkmcnt(0)" ::: "memory");
#pragma unroll
    for (int i = 0; i < 8; ++i) { const int row = i * 4 + (lane >> 4), ch = lane & 15; const u32x4 v = *(const u32x4*)(stg + row * 272 + ch * 16); *(u32x4*)(Ow + (long)row * ldo + ch * 8) = v; }
  }
#undef SLOAD
#undef SWRITE
#undef SWAIT
#undef RESC
  __syncthreads();
}
#undef KSWZ
#undef SBAR
}

constexpr int NWAVES = 8;
constexpr int DM = 2048, NB = 8, SEQ = 2048, DEPTH = 4, CTXL = 256, DBR = 1024, DFF = 5632;
constexpr int ML = NB * SEQ, MC = NB * CTXL, MT = ML + MC;
constexpr int LDY = 4608, YQ = 0, YK = 1024, YV = 1280, YUX = 1536, YUG = 2560, YUF = 3584;
constexpr int LDG = 6144;
constexpr float NEPS = 1e-6f;
constexpr size_t MiB = 1u << 20;
constexpr size_t WS_CTL = 0, CTL_ZERO_BYTES = 1 * MiB;
constexpr size_t WS_MOD = 1 * MiB, WS_ROPE = 3 * MiB, WS_WLT = 4 * MiB, WS_CST = 6 * MiB, WS_SPT = 6 * MiB + 131072, WS_DFTC = 7 * MiB, WS_DFTL = 8 * MiB, WS_TW = 9 * MiB;
constexpr size_t WS_W = 24 * MiB, W_LAYER = 128 * MiB, WO_W1 = 0, WO_W8 = (size_t)4608 * 2048 * 2  , WO_WB = 42 * MiB, WO_WO = 54 * MiB, WO_WFI = 62 * MiB, WO_WFO = 106 * MiB;
constexpr size_t WS_X = 536 * MiB, WS_H = 680 * MiB, WS_Y1 = 752 * MiB, WS_G = 914 * MiB, WS_ACT = WS_G, WS_KN = 1130 * MiB;
constexpr size_t WS_PTL = 1139 * MiB, WS_BRS = WS_PTL, WS_PTC = 1203 * MiB, WS_ATT = 1211 * MiB, WS_REC = 1247 * MiB, WS_FOU = 1283 * MiB, WS_MG = 1319 * MiB, WS_SLAB = 1391 * MiB, WS_WBR = 1455 * MiB, WS_END = 1471 * MiB;
static_assert((size_t)MT * DBR * 2 == 36 * MiB && (size_t)MT * LDY * 2 == 162 * MiB && (size_t)MT * LDG * 2 == 216 * MiB && (size_t)MT * DM * 4 == 144 * MiB, "ws map");
constexpr int CMAX_L = 6144 + 1280;
constexpr size_t WS_CMAX = 256 * 1024  , WS_SH = 512 * 1024  ;
constexpr size_t WS_H8 = WS_MG;
constexpr int CW_BAR = 4096;
constexpr int RING_BYTES = 147456;
constexpr int LDSCTL_OFF = RING_BYTES, MISC_OFF = LDSCTL_OFF + 320;
constexpr int LDS_BYTES = RING_BYTES + 1024;

#define GAS __attribute__((address_space(1)))
#define LAS __attribute__((address_space(3)))
typedef unsigned short bf16;
typedef unsigned v4u __attribute__((ext_vector_type(4)));
typedef float f32x4 __attribute__((ext_vector_type(4)));
typedef short bf16x8 __attribute__((ext_vector_type(8)));
typedef GAS unsigned gu32;
typedef GAS unsigned long long gu64;
#define RLX_AGENT __ATOMIC_RELAXED, __HIP_MEMORY_SCOPE_AGENT
#define LDS_WAIT() asm volatile("s_waitcnt lgkmcnt(0)" ::: "memory")
#define VM_WAIT() asm volatile("s_waitcnt vmcnt(0)" ::: "memory")
__device__ __forceinline__ unsigned long long rt() { return __builtin_amdgcn_s_memrealtime(); }
__device__ __forceinline__ unsigned f2bf(float f) { unsigned u = __builtin_bit_cast(unsigned, f); return (u + 0x7fffu + ((u >> 16) & 1u)) >> 16; }
__device__ __forceinline__ unsigned pk2(float lo, float hi) { return f2bf(lo) | (f2bf(hi) << 16); }

#define XB_TMO      128
#define XB_XCNT(j)  (256  + 64 * (j))
#define XB_XSUB(j)  (1280 + 64 * (j))
#define XB_XGEN(j)  (2304 + 64 * (j))
#define XB_TOP      3328
#define XB_TOPGEN   3392
#define XCD_BAR_WORDS 3456
#define XB_SPIN_CAP (1u << 18)

__device__ __forceinline__ unsigned xb_ld(unsigned* p)              { return __hip_atomic_load(p, __ATOMIC_RELAXED, __HIP_MEMORY_SCOPE_AGENT); }
__device__ __forceinline__ unsigned xb_add(unsigned* p, unsigned v) { return __hip_atomic_fetch_add(p, v, __ATOMIC_RELAXED, __HIP_MEMORY_SCOPE_AGENT); }
__device__ __forceinline__ unsigned xb_xcc_id() { return (unsigned)__builtin_amdgcn_s_getreg((3 << 11) | 20) & 0xFu; }
#define XB_SPIN(cond, bar) do { unsigned _sp = 0; while (cond) { __builtin_amdgcn_s_sleep(1); \
    if ((++_sp & 255u) == 0u) { if (xb_ld(&(bar)[XB_TMO])) break; if (_sp > XB_SPIN_CAP) { atomicAdd(&(bar)[XB_TMO], 1u); break; } } } } while (0)

struct XcdBarrier {
    unsigned* bar; unsigned x;
    volatile LAS unsigned* st;
};

__device__ __forceinline__ XcdBarrier xcd_barrier_post(unsigned* bar, volatile LAS unsigned* st) {
    XcdBarrier b; b.bar = bar; b.x = xb_xcc_id(); b.st = st;
    if (threadIdx.x == 0) (void)xb_add(&bar[XB_XCNT(b.x)], 1u);
    return b;
}
__device__ __forceinline__ void xcd_barrier_complete(unsigned* bar, unsigned x, unsigned& nloc, unsigned& nx) {
    const unsigned G = gridDim.x * gridDim.y * gridDim.z;
    unsigned sum, cnt, mine, sp = 0u;
    for (;;) {
        sum = 0u; cnt = 0u; mine = 0u;
#pragma unroll
        for (unsigned j = 0; j < 16; ++j) { const unsigned c = xb_ld(&bar[XB_XCNT(j)]); sum += c; cnt += (c > 0u) ? 1u : 0u; mine = (j == x) ? c : mine; }
        if (sum == G) break;
        __builtin_amdgcn_s_sleep(1);
        if ((++sp & 255u) == 0u) { if (xb_ld(&bar[XB_TMO])) break; if (sp > XB_SPIN_CAP) { atomicAdd(&bar[XB_TMO], 1u); break; } }
    }
    nloc = mine > 0u ? mine : 1u; nx = cnt > 0u ? cnt : 1u;
}

__device__ __forceinline__ void xcd_barrier(const XcdBarrier& b, const bool is_thread0) {
    asm volatile("s_waitcnt vmcnt(0)" ::: "memory");
    __syncthreads();
    if (is_thread0) {
        unsigned* bar = b.bar;
        __builtin_amdgcn_s_waitcnt(0);
        unsigned nloc = b.st[0], nx = b.st[1];
        if (nloc == 0u) { xcd_barrier_complete(bar, b.x, nloc, nx); b.st[0] = nloc; b.st[1] = nx; }
        const unsigned old = xb_add(&bar[XB_XSUB(b.x)], 1u);
        const unsigned gen = old / nloc;
        if (old + 1u == (gen + 1u) * nloc) {
            __builtin_amdgcn_fence(__ATOMIC_RELEASE, "agent");
            asm volatile("s_waitcnt vmcnt(0)" ::: "memory");
            const unsigned og = xb_add(&bar[XB_TOP], 1u);
            const unsigned tg = og / nx;
            if (og + 1u == (tg + 1u) * nx) xb_add(&bar[XB_TOPGEN], 1u);
            else XB_SPIN(xb_ld(&bar[XB_TOPGEN]) == tg, bar);
            __builtin_amdgcn_fence(__ATOMIC_ACQUIRE, "agent");
            xb_add(&bar[XB_XGEN(b.x)], 1u);
            asm volatile("s_waitcnt vmcnt(0)" ::: "memory");
        } else {
            XB_SPIN(xb_ld(&bar[XB_XGEN(b.x)]) == gen, bar);
            __builtin_amdgcn_fence(__ATOMIC_ACQUIRE, "agent");
            asm volatile("s_waitcnt vmcnt(0)" ::: "memory");
        }
    }
    __syncthreads();
}

using pg8::bf2f; using pg8::cvt_pk_bf16; using pg8::sigm; using pg8::bflo; using pg8::bfhi;
typedef float f32x16 __attribute__((ext_vector_type(16)));
typedef unsigned u32x2 __attribute__((ext_vector_type(2)));
__device__ __forceinline__ float dpp_f(float v, const int ctrl_sel) {
    const int x = __builtin_bit_cast(int, v); int r;
    if (ctrl_sel == 0) r = __builtin_amdgcn_mov_dpp(x, 0xB1, 0xF, 0xF, false); else if (ctrl_sel == 1) r = __builtin_amdgcn_mov_dpp(x, 0x4E, 0xF, 0xF, false);
    else if (ctrl_sel == 2) r = __builtin_amdgcn_mov_dpp(x, 0x141, 0xF, 0xF, false); else r = __builtin_amdgcn_mov_dpp(x, 0x140, 0xF, 0xF, false);
    return __builtin_bit_cast(float, r);
}
__device__ __forceinline__ float wave_max(float v) {
    v = fmaxf(v, dpp_f(v, 0)); v = fmaxf(v, dpp_f(v, 1)); v = fmaxf(v, dpp_f(v, 2)); v = fmaxf(v, dpp_f(v, 3));
    const int x = __builtin_bit_cast(int, v);
    const float r0 = __builtin_bit_cast(float, __builtin_amdgcn_readlane(x, 0)), r1 = __builtin_bit_cast(float, __builtin_amdgcn_readlane(x, 16));
    const float r2 = __builtin_bit_cast(float, __builtin_amdgcn_readlane(x, 32)), r3 = __builtin_bit_cast(float, __builtin_amdgcn_readlane(x, 48));
    return fmaxf(fmaxf(r0, r1), fmaxf(r2, r3));
}
__device__ __forceinline__ unsigned pack_i8x4(float a, float b, float c, float d, float inv) {
    const unsigned fa = __float_as_uint(fmaf(a, inv, 12582912.0f)), fb = __float_as_uint(fmaf(b, inv, 12582912.0f)), fc = __float_as_uint(fmaf(c, inv, 12582912.0f)), fd = __float_as_uint(fmaf(d, inv, 12582912.0f));
    const unsigned p01 = __builtin_amdgcn_perm(fb, fa, 0x0c0c0400u), p23 = __builtin_amdgcn_perm(fd, fc, 0x0c0c0400u);
    return __builtin_amdgcn_perm(p23, p01, 0x05040100u);
}
__device__ __forceinline__ float wave_sum(float v) {
    v += dpp_f(v, 0); v += dpp_f(v, 1); v += dpp_f(v, 2); v += dpp_f(v, 3);
    const int x = __builtin_bit_cast(int, v);
    const float r0 = __builtin_bit_cast(float, __builtin_amdgcn_readlane(x, 0)), r1 = __builtin_bit_cast(float, __builtin_amdgcn_readlane(x, 16));
    const float r2 = __builtin_bit_cast(float, __builtin_amdgcn_readlane(x, 32)), r3 = __builtin_bit_cast(float, __builtin_amdgcn_readlane(x, 48));
    return (r0 + r1) + (r2 + r3);
}
__device__ __forceinline__ float silu_f(float x) { return x / (1.0f + __expf(-x)); }
__device__ __forceinline__ float gelu_tanh(float x) { return x * sigm(1.5957691216057308f * (x + 0.044715f * x * x * x)); }

struct Params {
    const float *x, *c, *ctx, *c_ctx, *w_mod, *b_mod, *g_norm1, *g_norm2, *w_in, *q_gain, *k_gain, *conv_w, *conv_b, *lru_w_r, *lru_b_r, *lru_w_i, *lru_b_i, *lru_lambda,
                *w_branch, *w_gate, *b_gate, *w_out, *w_ffn_in, *w_ffn_out, *g_final;
    float* out; unsigned char* ws; int ph_lo, ph_hi;
};
typedef const __attribute__((address_space(4))) Params* KP;
__device__ __forceinline__ KP fresh_kp() { KP p = (KP)__builtin_amdgcn_kernarg_segment_ptr(); asm volatile("" : "+s"(p)); return p; }

__device__ __forceinline__ void tr_item(const float* W, int ldn, bf16* WT, int ldk, int k0, int n0, int drow0, LAS float* scr, int lane, bool rev = false) {
#pragma unroll 8
    for (int i = 0; i < 32; ++i) { const int kk = 2 * i + (lane >> 5); const int ks = k0 + kk, sr = rev ? ((ks & ~127) | ((128 - (ks & 127)) & 127)) : ks;
        scr[kk * 33 + (lane & 31)] = W[(size_t)sr * ldn + n0 + (lane & 31)]; }
    LDS_WAIT(); asm volatile("" ::: "memory");
    const int c = lane & 7;
#pragma unroll
    for (int j = 0; j < 4; ++j) { const int n = (lane >> 3) + 8 * j; const LAS float* s = scr + (8 * c) * 33 + n;
        v4u o; o.x = pk2(s[0 * 33], s[1 * 33]); o.y = pk2(s[2 * 33], s[3 * 33]); o.z = pk2(s[4 * 33], s[5 * 33]); o.w = pk2(s[6 * 33], s[7 * 33]);
        *(v4u*)(WT + (size_t)(drow0 + n) * ldk + k0 + 8 * c) = o; }
    LDS_WAIT(); asm volatile("" ::: "memory");
}

__device__ __forceinline__ void p0_prologue(KP P, LAS unsigned char* lds, int tid, int lane, int wave, int vcu, int G, int dupA, int dupB, int dupC) {
    unsigned char* ws = P->ws;
    {
        LAS float* SC = (LAS float*)lds;
        LAS float* red = (LAS float*)(lds + 73728);
        for (int i = tid; i < 9 * 2048; i += 512) { const int r = i >> 11, k = i & 2047; const float v = r < 8 ? P->c[r * 2048 + k] : P->c_ctx[k]; SC[i] = silu_f(v); }
        __syncthreads();
        float* MOD = (float*)(ws + WS_MOD);
        for (int unit_ = vcu; unit_ < 4 * 192 * dupA; unit_ += G) { const int unit = unit_ % 768;
            const int l = unit / 192, n0 = (unit % 192) * 64;
            const float* wp = P->w_mod + ((size_t)l * 2048 + wave * 256) * 12288 + n0 + lane;
            float acc[9];
#pragma unroll
            for (int r = 0; r < 9; ++r) acc[r] = 0.f;
            for (int k8 = 0; k8 < 256; k8 += 32) {
                float wv[32];
#pragma unroll
                for (int j = 0; j < 32; ++j) wv[j] = wp[(size_t)(k8 + j) * 12288];
#pragma unroll
                for (int j = 0; j < 32; ++j)
#pragma unroll
                    for (int r = 0; r < 9; ++r) acc[r] += SC[r * 2048 + wave * 256 + k8 + j] * wv[j];
            }
#pragma unroll
            for (int r = 0; r < 9; ++r) red[(wave * 9 + r) * 64 + lane] = acc[r];
            __syncthreads();
            for (int i = tid; i < 9 * 64; i += 512) { const int r = i >> 6, ln = i & 63; float s = 0.f;
#pragma unroll
                for (int w = 0; w < 8; ++w) s += red[(w * 9 + r) * 64 + ln];
                MOD[((size_t)l * 9 + r) * 12288 + n0 + ln] = s + P->b_mod[l * 12288 + n0 + ln]; }
            __syncthreads();
        }
    }
    {
        LAS float* scr = (LAS float*)(lds + wave * 16384);
        const int gw = vcu * NWAVES + wave, NGW = G * NWAVES;
        constexpr int PER_L = 32768 + 1024, NIT = 4 * PER_L + 512;
        for (int it_ = gw; it_ < NIT * dupB; it_ += NGW) { const int it = it_ % NIT;
            if (it < 4 * PER_L) {
                const int l = it / PER_L; int r = it % PER_L;
                unsigned char* wl = ws + WS_W + (size_t)l * W_LAYER;
                if (r < 4608) { const int kb = r / 144, nb = r % 144; if (nb < 40) continue;
                    tr_item(P->w_in + (size_t)l * 2048 * 4608, 4608, (bf16*)(wl + WO_W1), 2048, kb * 64, nb * 32, nb * 32, scr, lane); continue; } r -= 4608;
                if (r < 6144) { const int kb = r / 192, nb = r % 192; continue; }        r -= 6144;
                if (r < 3072) { const int br = r / 1024, rr = r % 1024, kb = rr / 64, nb = rr % 64;
                    tr_item(P->w_branch + ((size_t)l * 3 + br) * 1024 * 2048, 2048, (bf16*)(wl + WO_WB) + (size_t)br * 2048 * 1024, 1024, kb * 64, nb * 32, nb * 32, scr, lane); continue; } r -= 3072;
                if (r < 2048) { const int kb = r / 64, nb = r % 64; tr_item(P->w_out + (size_t)l * 2048 * 2048, 2048, (bf16*)(wl + WO_WO), 2048, kb * 64, nb * 32, nb * 32, scr, lane); continue; } r -= 2048;
                if (r < 11264) { const int kb = r / 352, nb = r % 352, n0 = nb * 32, half = n0 / 5632, j = n0 % 5632, pn = j / 128, jj = j % 128;
                    tr_item(P->w_ffn_in + (size_t)l * 2048 * 11264, 11264, (bf16*)(wl + WO_WFI), 2048, kb * 64, n0, pn * 256 + half * 128 + jj, scr, lane); continue; } r -= 11264;
                if (r < 5632) { const int kb = r / 64, nb = r % 64; tr_item(P->w_ffn_out + (size_t)l * 5632 * 2048, 2048, (bf16*)(wl + WO_WFO), 5632, kb * 64, nb * 32, nb * 32, scr, lane); continue; } r -= 5632;
                { const int kb = r / 64, nb = r % 64; tr_item(P->w_branch + ((size_t)l * 3 + 2) * 1024 * 2048, 2048, (bf16*)(ws + WS_WBR + (size_t)l * 4 * MiB), 1024, kb * 64, nb * 32, nb * 32, scr, lane, true); }
            } else {
                const int r = it - 4 * PER_L, mat = r >> 1, nb = r & 1, gate = mat & 1, ldn = mat >> 1;
                const float* W = (gate ? P->lru_w_i : P->lru_w_r) + (size_t)ldn * 4096;
                tr_item(W, 64, (bf16*)(ws + WS_WLT) + (size_t)mat * 4096, 64, 0, nb * 32, nb * 32, scr, lane);
            }
        }
    }
    {
        __syncthreads();
        LAS float* scr = (LAS float*)(lds + wave * 16384);
        LAS float* red = (LAS float*)(lds + 131072);
        unsigned* CM = (unsigned*)(ws + WS_CMAX);
        const int c = lane & 15, rg = lane >> 4;
        for (int it = vcu; it < 4 * (384 + 80); it += G) {
            const int l = it / 464, r = it % 464; const bool gatew = r < 384; const int n0 = (gatew ? r : r - 384) * 16;
            const float* W = gatew ? P->w_gate + (size_t)l * 2048 * 6144 : P->w_in + (size_t)l * 2048 * 4608; const int ldn = gatew ? 6144 : 4608;
            unsigned char* W8 = ws + WS_W + (size_t)l * W_LAYER + (gatew ? WO_W8 : WO_W1);
            const int cidx = l * CMAX_L + (gatew ? 0 : 6144) + n0;
            float r_[64];
#pragma unroll
            for (int i = 0; i < 64; ++i) r_[i] = W[(size_t)(wave * 256 + 4 * i + rg) * ldn + n0 + c];
            float mx = 0.f;
#pragma unroll
            for (int i = 0; i < 64; ++i) mx = fmaxf(mx, fabsf(r_[i]));
            red[wave * 64 + lane] = mx;
            __syncthreads();
            float m = 0.f;
#pragma unroll
            for (int w = 0; w < 8; ++w)
#pragma unroll
                for (int g4 = 0; g4 < 4; ++g4) m = fmaxf(m, red[w * 64 + g4 * 16 + c]);
            m = fmaxf(m, 1e-30f); const float inv = 127.0f / m;
            if (wave == 0 && rg == 0) CM[cidx + c] = __float_as_uint(m);
#pragma unroll
            for (int h = 0; h < 2; ++h) {
#pragma unroll
                for (int i = 0; i < 32; ++i) scr[(4 * i + rg) * 17 + c] = r_[32 * h + i];
                LDS_WAIT(); asm volatile("" ::: "memory");
                const LAS float* sp = scr + (32 * rg) * 17 + c;
                v4u o0, o1;
                o0.x = pack_i8x4(sp[0 * 17], sp[1 * 17], sp[2 * 17], sp[3 * 17], inv); o0.y = pack_i8x4(sp[4 * 17], sp[5 * 17], sp[6 * 17], sp[7 * 17], inv);
                o0.z = pack_i8x4(sp[8 * 17], sp[9 * 17], sp[10 * 17], sp[11 * 17], inv); o0.w = pack_i8x4(sp[12 * 17], sp[13 * 17], sp[14 * 17], sp[15 * 17], inv);
                o1.x = pack_i8x4(sp[16 * 17], sp[17 * 17], sp[18 * 17], sp[19 * 17], inv); o1.y = pack_i8x4(sp[20 * 17], sp[21 * 17], sp[22 * 17], sp[23 * 17], inv);
                o1.z = pack_i8x4(sp[24 * 17], sp[25 * 17], sp[26 * 17], sp[27 * 17], inv); o1.w = pack_i8x4(sp[28 * 17], sp[29 * 17], sp[30 * 17], sp[31 * 17], inv);
                unsigned char* dp = W8 + (size_t)(n0 + c) * 2048 + wave * 256 + 128 * h + 32 * rg;
                *(v4u*)dp = o0; *(v4u*)(dp + 16) = o1;
                LDS_WAIT(); asm volatile("" ::: "memory");
            }
            __syncthreads();
        }
    }
    {
        const int gid = vcu * 512 + tid, NT = G * 512;
        float* ROPE = (float*)(ws + WS_ROPE);
        for (int i = gid; i < 2048 * 64; i += NT) { const int t = i >> 6, j = i & 63; const float pos = (float)(j < 32 ? (t >> 6) : (t & 63));
            const float inv = exp2f(-(float)(j & 31) * (13.287712379549449f / 32.0f)); const float ang = pos * inv; ROPE[i] = cosf(ang); ROPE[2048 * 64 + i] = sinf(ang); }
        float* SPT = (float*)(ws + WS_SPT);
        for (int i = gid; i < 4 * 2 * 1024; i += NT) SPT[i] = 8.0f * 1.4426950408889634f * log1pf(__expf(-P->lru_lambda[i]));
        bf16* CST = (bf16*)(ws + WS_CST);
        for (int i = gid; i < 256 * 128; i += NT) { const int col = i >> 7, cc = i & 127, s = col >> 7, m = col & 127; const float a = (float)((m * cc) & 127) * (2.0f / 128.0f);
            CST[i] = (bf16)f2bf(s ? sinpif(a) : cospif(a)); }
        bf16* DFTC = (bf16*)(ws + WS_DFTC);
        for (int i = gid; i < 256 * 512; i += NT) { const int k = i >> 9, cc = i & 511, s = cc >> 8, t = cc & 255; const float a = (float)((k * t) & 255) * (2.0f / 256.0f);
            DFTC[i] = (bf16)f2bf(s ? -sinpif(a) : cospif(a)); }
        bf16* DFTN = (bf16*)(ws + WS_DFTL);
        for (int i_ = gid; i_ < 256 * 1024 * dupC; i_ += NT) { const int i = i_ & (256 * 1024 - 1); const int k2 = i >> 10, cc = i & 1023, s = cc >> 9, t2 = cc & 511; const float a = (float)((k2 * t2) & 511) * (2.0f / 512.0f);
            DFTN[i] = (bf16)f2bf(s ? sinpif(a) : cospif(a)); }
        float* TW = (float*)(ws + WS_TW);
        for (int i = gid; i < 3 * 512; i += NT) { const int k1 = i / 512 + 1, t2 = i % 512; const float a = (float)(k1 * t2) * (2.0f / 2048.0f); TW[2 * i] = cospif(a); TW[2 * i + 1] = sinpif(a); }
    }
}

__device__ __forceinline__ void norm_rows(KP P, int l, int which, int nrows, bool slab, int lane, int wave, int vcu, int G, int dup) {
    unsigned char* ws = P->ws; bf16* X = (bf16*)(ws + WS_X); bf16* H = (bf16*)(ws + WS_H); const float* MOD = (const float*)(ws + WS_MOD);
    const float* gn = (which ? P->g_norm2 : P->g_norm1) + l * 2048;
    const bool first = (l == 0 && which == 0);
    const int gw = vcu * NWAVES + wave, NGW = G * NWAVES;
    f32x4 gq[8];
#pragma unroll
    for (int j = 0; j < 8; ++j) gq[j] = *(const f32x4*)(gn + ((j >> 1) * 64 + lane) * 8 + (j & 1) * 4);
    for (int m_ = gw; m_ < nrows * dup; m_ += NGW) { const int m = m_ % nrows;
        const int rsel = m < ML ? (m >> 11) : 8;
        const float* mv = MOD + ((size_t)l * 9 + rsel) * 12288 + (which ? 3 * 2048 : 0);
        f32x4 v[8], shq[8], scq[8]; float ss = 0.f;
        if (first) { const float* src = m < ML ? P->x + (size_t)m * DM : P->ctx + (size_t)(m - ML) * DM;
#pragma unroll
            for (int j = 0; j < 8; ++j) v[j] = *(const f32x4*)(src + ((j >> 1) * 64 + lane) * 8 + (j & 1) * 4);
        } else { const bf16* src = X + (size_t)m * DM;
            v4u xw[4];
#pragma unroll
            for (int jj = 0; jj < 4; ++jj) xw[jj] = *(const v4u*)(src + (jj * 64 + lane) * 8);
#pragma unroll
            for (int jj = 0; jj < 4; ++jj) { v[2 * jj] = (f32x4){bflo(xw[jj].x), bfhi(xw[jj].x), bflo(xw[jj].y), bfhi(xw[jj].y)}; v[2 * jj + 1] = (f32x4){bflo(xw[jj].z), bfhi(xw[jj].z), bflo(xw[jj].w), bfhi(xw[jj].w)}; }
        }
#pragma unroll
        for (int j = 0; j < 8; ++j) { const int col = ((j >> 1) * 64 + lane) * 8 + (j & 1) * 4; shq[j] = *(const f32x4*)(mv + col); scq[j] = *(const f32x4*)(mv + 2048 + col); }
        asm volatile("" ::: "memory");
#pragma unroll
        for (int j = 0; j < 8; ++j) ss += (v[j].x * v[j].x + v[j].y * v[j].y) + (v[j].z * v[j].z + v[j].w * v[j].w);
        const bool addslab = slab && m >= ML && m_ < nrows;
        if (addslab) { const float* SL = (const float*)(ws + WS_SLAB) + (size_t)(m - ML) * DM; ss = 0.f;
#pragma unroll
            for (int j = 0; j < 8; ++j) { const int col = ((j >> 1) * 64 + lane) * 8 + (j & 1) * 4;
                v[j] = (((v[j] + *(const f32x4*)(SL + col)) + *(const f32x4*)(SL + (size_t)2048 * 2048 + col)) + *(const f32x4*)(SL + (size_t)2 * 2048 * 2048 + col)) + *(const f32x4*)(SL + (size_t)3 * 2048 * 2048 + col);
                ss += (v[j].x * v[j].x + v[j].y * v[j].y) + (v[j].z * v[j].z + v[j].w * v[j].w); } }
        const float rstd = 1.0f / sqrtf(wave_sum(ss) * (1.0f / DM) + NEPS);
        f32x4 oq[8]; float amax = 0.f;
#pragma unroll
        for (int jj = 0; jj < 4; ++jj) { const int col = (jj * 64 + lane) * 8;
            if (first || addslab) { v4u xo; xo.x = cvt_pk_bf16(v[2 * jj].x, v[2 * jj].y); xo.y = cvt_pk_bf16(v[2 * jj].z, v[2 * jj].w); xo.z = cvt_pk_bf16(v[2 * jj + 1].x, v[2 * jj + 1].y); xo.w = cvt_pk_bf16(v[2 * jj + 1].z, v[2 * jj + 1].w);
                *(v4u*)(X + (size_t)m * DM + col) = xo; }
            const f32x4 o0 = v[2 * jj] * rstd * gq[2 * jj] * (scq[2 * jj] + 1.0f) + shq[2 * jj], o1 = v[2 * jj + 1] * rstd * gq[2 * jj + 1] * (scq[2 * jj + 1] + 1.0f) + shq[2 * jj + 1];
            v4u w; w.x = cvt_pk_bf16(o0.x, o0.y); w.y = cvt_pk_bf16(o0.z, o0.w); w.z = cvt_pk_bf16(o1.x, o1.y); w.w = cvt_pk_bf16(o1.z, o1.w);
            *(v4u*)(H + (size_t)m * DM + col) = w;
            oq[2 * jj] = o0; oq[2 * jj + 1] = o1;
            amax = fmaxf(amax, fmaxf(fmaxf(fmaxf(fabsf(o0.x), fabsf(o0.y)), fmaxf(fabsf(o0.z), fabsf(o0.w))), fmaxf(fmaxf(fabsf(o1.x), fabsf(o1.y)), fmaxf(fabsf(o1.z), fabsf(o1.w))))); }
        if (!which) {
            const float rmax = fmaxf(wave_max(amax), 1e-20f); const float inv = 127.0f / rmax;
#pragma unroll
            for (int jj = 0; jj < 4; ++jj) { u32x2 w8; w8.x = pack_i8x4(oq[2 * jj].x, oq[2 * jj].y, oq[2 * jj].z, oq[2 * jj].w, inv); w8.y = pack_i8x4(oq[2 * jj + 1].x, oq[2 * jj + 1].y, oq[2 * jj + 1].z, oq[2 * jj + 1].w, inv);
                *(u32x2*)(ws + WS_H8 + (size_t)m * DM + (jj * 64 + lane) * 8) = w8; }
            if (lane == 0) ((float*)(ws + WS_SH))[m] = rmax * (1.0f / 127.0f);
        }
    }
}
__device__ __forceinline__ void final_norm(KP P, int lane, int wave, int vcu, int G) {
    const bf16* X = (const bf16*)(P->ws + WS_X);
    const int gw = vcu * NWAVES + wave, NGW = G * NWAVES;
    for (int m = gw; m < ML; m += NGW) {
        const bf16* src = X + (size_t)m * DM; f32x4 v[8]; float ss = 0.f;
#pragma unroll
        for (int jj = 0; jj < 4; ++jj) { const v4u xw = *(const v4u*)(src + (jj * 64 + lane) * 8);
            v[2 * jj] = (f32x4){bflo(xw.x), bfhi(xw.x), bflo(xw.y), bfhi(xw.y)}; v[2 * jj + 1] = (f32x4){bflo(xw.z), bfhi(xw.z), bflo(xw.w), bfhi(xw.w)}; }
#pragma unroll
        for (int j = 0; j < 8; ++j) ss += (v[j].x * v[j].x + v[j].y * v[j].y) + (v[j].z * v[j].z + v[j].w * v[j].w);
        const float rstd = 1.0f / sqrtf(wave_sum(ss) * (1.0f / DM) + NEPS);
#pragma unroll
        for (int j = 0; j < 8; ++j) { const int col = ((j >> 1) * 64 + lane) * 8 + (j & 1) * 4; *(f32x4*)(P->out + (size_t)m * DM + col) = v[j] * rstd * *(const f32x4*)(P->g_final + col); }
    }
}

__device__ __forceinline__ void f1_units(KP P, bool last, LAS unsigned char* lds, int tid, int lane, int wave, int vcu, int G, int dup) {
    unsigned char* ws = P->ws; const bf16* Y1 = (const bf16*)(ws + WS_Y1); bf16* PTN = (bf16*)(ws + WS_PTL); bf16* PTC = (bf16*)(ws + WS_PTC);
    { const v4u* src = (const v4u*)(ws + WS_CST);
      for (int i = tid; i < 256 * 16; i += 512) { const int row = i >> 4, ch = i & 15; v4u t_ = src[i]; asm volatile("" : "+v"(t_)); *(LAS v4u*)(lds + row * 272 + ch * 16) = t_; } }
    __syncthreads();
    const int r = lane & 31, h = lane >> 5;
    const int gw = vcu * NWAVES + wave, NGW = G * NWAVES;
    const float* TW = (const float*)(ws + WS_TW);
    for (int wu_ = gw; wu_ < 4096 * dup; wu_ += NGW) {
        const int wu = wu_ & 4095; const int b = wu >> 9, tb = (wu >> 3) & 63, g = wu & 7;
        const bf16* ap = Y1 + (size_t)(b * 2048 + 512 * (r >> 3) + 8 * tb + (r & 7)) * LDY + YUF + g * 128 + h * 8;
        bf16x8 Af[8];
#pragma unroll
        for (int kk = 0; kk < 8; ++kk) Af[kk] = *(const bf16x8*)(ap + kk * 16);
        float twc[3][4], tws[3][4];
#pragma unroll
        for (int k1 = 0; k1 < 3; ++k1) { const f32x4 w0 = *(const f32x4*)(TW + 2 * (k1 * 512 + 8 * tb + 4 * h)), w1 = *(const f32x4*)(TW + 2 * (k1 * 512 + 8 * tb + 4 * h) + 4);
            twc[k1][0] = w0.x; tws[k1][0] = w0.y; twc[k1][1] = w0.z; tws[k1][1] = w0.w; twc[k1][2] = w1.x; tws[k1][2] = w1.y; twc[k1][3] = w1.z; tws[k1][3] = w1.w; }
#pragma unroll 1
        for (int cp = 0; cp < 4; ++cp) {
            f32x16 ac = {}, as = {};
#pragma unroll
            for (int kk = 0; kk < 8; ++kk) { const bf16x8 Bc = *(const LAS bf16x8*)(lds + (cp * 32 + r) * 272 + (kk * 16 + h * 8) * 2), Bs = *(const LAS bf16x8*)(lds + ((cp + 4) * 32 + r) * 272 + (kk * 16 + h * 8) * 2);
                ac = __builtin_amdgcn_mfma_f32_32x32x16_bf16(Af[kk], Bc, ac, 0, 0, 0); as = __builtin_amdgcn_mfma_f32_32x32x16_bf16(Af[kk], Bs, as, 0, 0, 0); }
            float ore[4][4], oim[4][4];
#pragma unroll
            for (int i = 0; i < 4; ++i) {
                const float z0r = ac[i], z1r = ac[4 + i], z2r = ac[8 + i], z3r = ac[12 + i], z0i = -as[i], z1i = -as[4 + i], z2i = -as[8 + i], z3i = -as[12 + i];
                const float ar = z0r + z2r, ai = z0i + z2i, br = z1r + z3r, bi = z1i + z3i, cr = z0r - z2r, ci = z0i - z2i, dr = z1r - z3r, di = z1i - z3i;
                ore[0][i] = ar + br; oim[0][i] = ai + bi;
                { const float wr = cr + di, wi = ci - dr; ore[1][i] = wr * twc[0][i] + wi * tws[0][i]; oim[1][i] = wi * twc[0][i] - wr * tws[0][i]; }
                { const float wr = ar - br, wi = ai - bi; ore[2][i] = wr * twc[1][i] + wi * tws[1][i]; oim[2][i] = wi * twc[1][i] - wr * tws[1][i]; }
                { const float wr = cr - di, wi = ci + dr; ore[3][i] = wr * twc[2][i] + wi * tws[2][i]; oim[3][i] = wi * twc[2][i] - wr * tws[2][i]; }
            }
            const int m = cp * 32 + r;
            bf16* dp = PTN + ((size_t)((b * 8 + g) * 128 + m)) * 1024 + 8 * tb + 4 * h;
#pragma unroll
            for (int k1 = 0; k1 < 4; ++k1) { u32x2 w; w.x = cvt_pk_bf16(ore[k1][0], ore[k1][1]); w.y = cvt_pk_bf16(ore[k1][2], ore[k1][3]); *(u32x2*)(dp + (size_t)k1 * 8192 * 1024) = w;
                u32x2 v; v.x = cvt_pk_bf16(oim[k1][0], oim[k1][1]); v.y = cvt_pk_bf16(oim[k1][2], oim[k1][3]); *(u32x2*)(dp + (size_t)k1 * 8192 * 1024 + 512) = v; }
        }
    }
    if (!last) {
    for (int wu_ = gw; wu_ < 512 * dup; wu_ += NGW) {
        const int wu = wu_ & 511; const int tt = 512 + (wu >> 3), g = wu & 7, m0 = tt * 32;
        const bf16* ap = Y1 + (size_t)(m0 + r) * LDY + YUF + g * 128 + h * 8;
        bf16x8 Af[8];
#pragma unroll
        for (int kk = 0; kk < 8; ++kk) Af[kk] = *(const bf16x8*)(ap + kk * 16);
        const int mc = m0 - ML, b = mc >> 8, t0 = mc & 255; bf16* base = PTC + (size_t)((b * 8 + g) * 128) * 512 + t0;
#pragma unroll 1
        for (int ct = 0; ct < 8; ++ct) {
            f32x16 acc = {};
#pragma unroll
            for (int kk = 0; kk < 8; ++kk) { const bf16x8 Bf = *(const LAS bf16x8*)(lds + (ct * 32 + r) * 272 + (kk * 16 + h * 8) * 2); acc = __builtin_amdgcn_mfma_f32_32x32x16_bf16(Af[kk], Bf, acc, 0, 0, 0); }
            const int s = ct >> 2, m = (ct & 3) * 32 + r;
            bf16* dp = base + (size_t)m * 512 + s * 256 + 4 * h;
#pragma unroll
            for (int q4 = 0; q4 < 4; ++q4) { u32x2 w; w.x = cvt_pk_bf16(acc[4 * q4], acc[4 * q4 + 1]); w.y = cvt_pk_bf16(acc[4 * q4 + 2], acc[4 * q4 + 3]); *(u32x2*)(dp + 8 * q4) = w; }
        }
    }
    }
}
__device__ __forceinline__ void knorm_units(KP P, int l, int lane, int wave, int vcu, int G, int dup) {
    unsigned char* ws = P->ws; const bf16* Y1 = (const bf16*)(ws + WS_Y1); bf16* KN = (bf16*)(ws + WS_KN); const float* ROPE = (const float*)(ws + WS_ROPE);
    const float g1 = P->k_gain[l * 128 + lane], g2 = P->k_gain[l * 128 + 64 + lane];
    const int gw = vcu * NWAVES + wave, NGW = G * NWAVES;
    for (int it0 = gw; it0 < MT * 2 * dup; it0 += 3 * NGW) {
        float k1[3], k2[3]; int mm[3], hh[3];
#pragma unroll
        for (int q = 0; q < 3; ++q) { const int it_ = it0 + q * NGW; const int it = (it_ < MT * 2 * dup ? it_ : gw) % (MT * 2); mm[q] = it >> 1; hh[q] = it & 1;
            const bf16* kp = Y1 + (size_t)mm[q] * LDY + YK + hh[q] * 128; k1[q] = bf2f(kp[lane]); k2[q] = bf2f(kp[64 + lane]); }
#pragma unroll
        for (int q = 0; q < 3; ++q) { if (it0 + q * NGW >= MT * 2 * dup) break;
            const int m = mm[q];
            const float rstd = 1.0f / sqrtf(wave_sum(k1[q] * k1[q] + k2[q] * k2[q]) * (1.0f / 128.0f) + NEPS);
            float a = k1[q] * rstd * g1, b = k2[q] * rstd * g2;
            if (m < ML) { const int t = m & 2047; const float c = ROPE[t * 64 + lane], s = ROPE[2048 * 64 + t * 64 + lane]; const float na = a * c - b * s, nb = b * c + a * s; a = na; b = nb; }
            bf16* op = KN + (size_t)m * 256 + hh[q] * 128;
            op[lane] = (bf16)(cvt_pk_bf16(a, 0.f) & 0xffffu); op[64 + lane] = (bf16)(cvt_pk_bf16(b, 0.f) & 0xffffu); }
    }
}
template <int D>
__device__ __forceinline__ void lru_sweep(const int b, const int nb, const int hc, LAS unsigned char* lds, const int lane, const int wave,
                                          const void* pY, const void* pR, const void* pF,
                                          const float cw0, const float cw1, const float cw2, const float cw3, const float cb, const float br, const float bi, const float sp) {
    const int j = lane & 31, hi = lane >> 5;
#define LRU_UNI(p_) ((void*)(((unsigned long long)(unsigned)__builtin_amdgcn_readfirstlane((int)(unsigned)((unsigned long long)(p_) >> 32)) << 32) | (unsigned long long)(unsigned)__builtin_amdgcn_readfirstlane((int)(unsigned)(unsigned long long)(p_))))
    const __amdgpu_buffer_rsrc_t rsY = __builtin_amdgcn_make_buffer_rsrc(LRU_UNI(pY), (short)0, (int)((size_t)MT * LDY * 2), 0x00020000);
    const __amdgpu_buffer_rsrc_t rsR = __builtin_amdgcn_make_buffer_rsrc(LRU_UNI(pR), (short)0, (int)((size_t)MT * 1024 * 2), 0x00020000);
    const __amdgpu_buffer_rsrc_t rsF = __builtin_amdgcn_make_buffer_rsrc(LRU_UNI(pF), (short)0, (int)((size_t)MT * 1024 * 2), 0x00020000);
#undef LRU_UNI
    LAS bf16* uS = (LAS bf16*)(lds + wave * 4608);
    LAS unsigned char* BL = lds + 36864;
    typedef float f32x2 __attribute__((ext_vector_type(2)));
    LAS f32x2* SUMS = (LAS f32x2*)(lds + 55296);
    const int chin = nb * 64 + lane, cho = nb * 64 + hc * 32 + j;
    constexpr float L2E = 1.4426950408889634f;
    const int arow = ((j >> 2) & 1) * 16 + (j & 3) + 4 * (j >> 3);
    const int voX = (YUX + chin) * 2, voG = (hi * 16 * LDY + YUG + cho) * 2, voR = (hi * 16 * 1024 + cho) * 2, voF = (hi * 16 * 1024 + cho) * 2;
#define LRU_GEOM(s_) const int q_ = (s_) * 8 + wave; const bool isc_ = q_ < 8; const int rowbase = isc_ ? ML + b * 256 : b * 2048, Lq = isc_ ? 256 : 2048, T0 = isc_ ? 32 * q_ : 32 * (q_ - 8)
#define LRU_ROWOFF(row_) ({ int rr_ = (row_); rr_ = rr_ < 0 ? 0 : (rr_ > MT - 1 ? MT - 1 : rr_); __builtin_amdgcn_readfirstlane(rr_ * (LDY * 2)); })
#define LRU_XLOAD(dst, s_) do { LRU_GEOM(s_); const int r0_ = rowbase + T0 - 2; \
        _Pragma("unroll") for (int i = 0; i < 35; ++i) dst[i] = __builtin_amdgcn_raw_buffer_load_b16(rsY, voX, LRU_ROWOFF(r0_ + i), 0); } while (0)
#define LRU_STEP(si_) (D == 0 ? (si_) : ((si_) == 0 ? 0 : 9 - (si_)))
    unsigned short xr[35];
    LRU_XLOAD(xr, LRU_STEP(0));
    float cstep = 0.f; int buf = 0;
#pragma unroll 1
    for (int si = 0; si < 9; ++si) {
        const int step = LRU_STEP(si);
        LRU_GEOM(step);
        {
          float xin[35];
#pragma unroll
          for (int i = 0; i < 35; ++i) { const int t = T0 - 2 + i; xin[i] = (t >= 0 && t < Lq) ? bf2f(xr[i]) : 0.f; }
#pragma unroll
          for (int i = 0; i < 32; ++i) uS[i * 72 + lane] = (bf16)(cvt_pk_bf16(cb + cw0 * xin[i] + cw1 * xin[i + 1] + cw2 * xin[i + 2] + cw3 * xin[i + 3], 0.f) & 0xffffu); }
        if (si < 8) { LRU_XLOAD(xr, LRU_STEP(si + 1)); }
        unsigned short hfv[16]; unsigned short ugr[16];
        if (D == 1) { const int r0 = rowbase + T0;
#pragma unroll
            for (int r = 0; r < 16; ++r) hfv[r] = __builtin_amdgcn_raw_buffer_load_b16(rsF, voF, __builtin_amdgcn_readfirstlane((r0 + r) * 2048), 0);
#pragma unroll
            for (int r = 0; r < 16; ++r) ugr[r] = __builtin_amdgcn_raw_buffer_load_b16(rsY, voG, __builtin_amdgcn_readfirstlane((r0 + r) * (LDY * 2)), 0); }
        asm volatile("" ::: "memory");
        LDS_WAIT(); asm volatile("" ::: "memory");
        f32x16 acc[2];
#pragma unroll
        for (int tl = 0; tl < 2; ++tl) acc[tl] = (f32x16){};
#pragma unroll
        for (int kk = 0; kk < 4; ++kk) {
            const bf16x8 Af = *(const LAS bf16x8*)(uS + arow * 72 + kk * 16 + hi * 8);
#pragma unroll
            for (int tl = 0; tl < 2; ++tl) acc[tl] = __builtin_amdgcn_mfma_f32_32x32x16_bf16(Af, *(const LAS bf16x8*)(BL + ((2 * D + tl) * 32 + j) * 144 + (kk * 16 + hi * 8) * 2), acc[tl], 0, 0, 0);
        }
        float yl[16], cp[16];
#define LRU_GATES(r0_, r1_, a0_, a1_, x0_, x1_) \
            const f32x2 u_ = {bf2f(uS[(hi * 16 + (r0_)) * 72 + hc * 32 + j]), bf2f(uS[(hi * 16 + (r1_)) * 72 + hc * 32 + j])}; \
            f32x2 e0_ = (f32x2){acc[0][r0_], acc[0][r1_]} * (-L2E) + br, e1_ = (f32x2){acc[1][r0_], acc[1][r1_]} * (-L2E) + bi; \
            e0_ = (f32x2){__builtin_amdgcn_exp2f(e0_.x), __builtin_amdgcn_exp2f(e0_.y)} + 1.0f; e1_ = (f32x2){__builtin_amdgcn_exp2f(e1_.x), __builtin_amdgcn_exp2f(e1_.y)} + 1.0f; \
            const f32x2 p_ = e0_ * e1_; const f32x2 ip_ = {__builtin_amdgcn_rcpf(p_.x), __builtin_amdgcn_rcpf(p_.y)}; \
            const f32x2 rg_ = ip_ * e1_, ig_ = ip_ * e0_, la_ = rg_ * (-sp); \
            const f32x2 av_ = {__builtin_amdgcn_exp2f(la_.x), __builtin_amdgcn_exp2f(la_.y)}; \
            f32x2 s_ = 1.0f - av_ * av_; s_ = (f32x2){__builtin_amdgcn_sqrtf(fmaxf(s_.x, 0.f)), __builtin_amdgcn_sqrtf(fmaxf(s_.y, 0.f))}; \
            const f32x2 xv_ = s_ * ig_ * u_; const float a0_ = av_.x, a1_ = av_.y, x0_ = xv_.x, x1_ = xv_.y
        float A = 1.f, Hs = 0.f;
        if (D == 0) {
#pragma unroll
            for (int r = 0; r < 16; r += 2) { LRU_GATES(r, r + 1, a0, a1, x0, x1);
                Hs = a0 * Hs + x0; A *= a0; yl[r] = Hs; cp[r] = A; Hs = a1 * Hs + x1; A *= a1; yl[r + 1] = Hs; cp[r + 1] = A; }
        } else {
#pragma unroll
            for (int r = 14; r >= 0; r -= 2) { LRU_GATES(r + 1, r, a0, a1, x0, x1);
                Hs = a0 * Hs + x0; A *= a0; yl[r + 1] = Hs; cp[r + 1] = A; Hs = a1 * Hs + x1; A *= a1; yl[r] = Hs; cp[r] = A; }
        }
#undef LRU_GATES
        const int myb = 2 * wave + hi;
        SUMS[(buf * 16 + myb) * 32 + j] = (f32x2){A, Hs};
        asm volatile("s_waitcnt lgkmcnt(0)" ::: "memory"); __builtin_amdgcn_s_barrier(); asm volatile("" ::: "memory");
        float c = cstep, cin = 0.f;
#pragma unroll
        for (int bq = 0; bq < 16; ++bq) { const int bb = D == 0 ? bq : 15 - bq; const f32x2 sv = SUMS[(buf * 16 + bb) * 32 + j]; cin = (bb == myb) ? c : cin; c = sv.x * c + sv.y; }
        cstep = c; buf ^= 1;
        const int r0 = rowbase + T0;
        if (D == 0) {
#pragma unroll
            for (int r = 0; r < 16; ++r) __builtin_amdgcn_raw_buffer_store_b16((unsigned short)(cvt_pk_bf16(yl[r] + cp[r] * cin, 0.f) & 0xffffu), rsF, voF, __builtin_amdgcn_readfirstlane((r0 + r) * 2048), 0);
        } else {
#pragma unroll
            for (int r = 0; r < 16; ++r) { const float y = bf2f(hfv[r]) + (yl[r] + cp[r] * cin); const float ug = bf2f(ugr[r]);
                __builtin_amdgcn_raw_buffer_store_b16((unsigned short)(cvt_pk_bf16(y * gelu_tanh(ug), 0.f) & 0xffffu), rsR, voR, __builtin_amdgcn_readfirstlane((r0 + r) * 2048), 0); }
        }
        LDS_WAIT(); asm volatile("" ::: "memory");
    }
#undef LRU_GEOM
#undef LRU_XLOAD
#undef LRU_ROWOFF
#undef LRU_STEP
}
__device__ __forceinline__ void lru_unit(KP P, int l, int b, int nb, int hc, LAS unsigned char* lds, int lane, int wave) {
    unsigned char* ws = P->ws; const bf16* Y1 = (const bf16*)(ws + WS_Y1); bf16* REC = (bf16*)(ws + WS_REC);
    const int j = lane & 31;
    LAS unsigned char* BL = lds + 36864;
    const int chin = nb * 64 + lane, cho = nb * 64 + hc * 32 + j;
    const float cw0 = P->conv_w[(l * 4 + 0) * 1024 + chin], cw1 = P->conv_w[(l * 4 + 1) * 1024 + chin], cw2 = P->conv_w[(l * 4 + 2) * 1024 + chin], cw3 = P->conv_w[(l * 4 + 3) * 1024 + chin];
    const float cb = P->conv_b[l * 1024 + chin];
    constexpr float L2E = 1.4426950408889634f;
    const float brf = -L2E * P->lru_b_r[(l * 2 + 0) * 1024 + cho], bif = -L2E * P->lru_b_i[(l * 2 + 0) * 1024 + cho], brb = -L2E * P->lru_b_r[(l * 2 + 1) * 1024 + cho], bib = -L2E * P->lru_b_i[(l * 2 + 1) * 1024 + cho];
    const float spf = ((const float*)(ws + WS_SPT))[(l * 2 + 0) * 1024 + cho], spb = ((const float*)(ws + WS_SPT))[(l * 2 + 1) * 1024 + cho];
    {
        const bf16* WLT = (const bf16*)(ws + WS_WLT); const int tid_ = wave * 64 + lane;
#pragma unroll
        for (int rep = 0; rep < 2; ++rep) { const int c16 = tid_ + rep * 512, row = c16 >> 3, ch = c16 & 7, tl = row >> 5, col = row & 31;
            const int mat = (((l * 2 + (tl >> 1)) * 16 + nb) * 2 + (tl & 1));
            v4u t_ = *(const v4u*)(WLT + (size_t)mat * 4096 + (hc * 32 + col) * 64 + ch * 8); asm volatile("" : "+v"(t_));
            *(LAS v4u*)(BL + row * 144 + ch * 16) = t_; }
        __syncthreads();
    }
    lru_sweep<0>(b, nb, hc, lds, lane, wave, (const void*)Y1, (const void*)REC, (const void*)(ws + WS_H), cw0, cw1, cw2, cw3, cb, brf, bif, spf);
    asm volatile("s_waitcnt vmcnt(0)" ::: "memory"); __syncthreads();
    lru_sweep<1>(b, nb, hc, lds, lane, wave, (const void*)Y1, (const void*)REC, (const void*)(ws + WS_H), cw0, cw1, cw2, cw3, cb, brb, bib, spb);
    __syncthreads();
}

struct MapAB { const char* A; const char* B; size_t astep, bstep; int pm0, pn0;
    __device__ __forceinline__ void operator()(pg8::Unit& u) const { u.pm += pm0; u.pn += pn0; u.A = A + (size_t)u.pm * astep; u.B = B + (size_t)u.pn * bstep; } };
struct MapBr { const char* A; const char* B; const char* BR;
    __device__ __forceinline__ void operator()(pg8::Unit& u) const { u.A = A + (size_t)u.aux * (36 * MiB) + (size_t)u.pm * (256 * 1024 * 2);
        const bool mir = u.aux == 2 && u.pm < 64 && (u.pm & 7) >= 4;
        u.B = (mir ? BR : B + (size_t)u.aux * (2048 * 1024 * 2)) + (size_t)u.pn * (256 * 1024 * 2); } };
__device__ __forceinline__ void nyquist_rows(unsigned char* ws, int lane, int wave, int vcu, int G) {
    const bf16* PTN = (const bf16*)(ws + WS_PTL); bf16* FOU = (bf16*)(ws + WS_FOU);
    const int gw = vcu * NWAVES + wave, NGW = G * NWAVES;
    for (int r = gw; r < 8192; r += NGW) {
        const v4u w = *(const v4u*)(PTN + (size_t)r * 1024 + lane * 8);
        float s = (bflo(w.x) - bfhi(w.x)) + (bflo(w.y) - bfhi(w.y)) + (bflo(w.z) - bfhi(w.z)) + (bflo(w.w) - bfhi(w.w));
        s = wave_sum(s) * 0.001953125f;
        if (lane == 0) FOU[(size_t)((r >> 10) * 2048 + 1024) * 1024 + (r & 1023)] = (bf16)(cvt_pk_bf16(s, 0.f) & 0xffffu);
    }
}
struct MapF2 { const char* A; const char* B;
    __device__ __forceinline__ void operator()(pg8::Unit& u) const { u.A = A; u.B = B + (size_t)u.pm * ((size_t)8192 * 1024 * 2) + (size_t)u.pn * (256 * 1024 * 2); } };

__global__ void __launch_bounds__(NWAVES * 64, 2) fwd_kernel(Params Pv) {
    extern __shared__ __attribute__((aligned(16))) unsigned char lds_raw[];
    LAS unsigned char* lds = (LAS unsigned char*)lds_raw;
    volatile LAS unsigned* MISC = (volatile LAS unsigned*)(lds + MISC_OFF);
    const int wave0 = __builtin_amdgcn_readfirstlane((int)threadIdx.x >> 6);
#define FRESH_TID() const KP P = fresh_kp(); (void)P; int wave = wave0; asm volatile("" : "+s"(wave)); int lane; asm volatile("v_mbcnt_lo_u32_b32 %0, -1, 0\n\tv_mbcnt_hi_u32_b32 %0, -1, %0" : "=v"(lane)); const int tid = (wave << 6) | lane; (void)tid
    const int G = gridDim.x; int vcu; { const int bx = blockIdx.x; vcu = (G % 8 == 0) ? (bx % 8) * (G / 8) + bx / 8 : bx; }
    unsigned char* ws = fresh_kp()->ws;
    gu32* ctl = (gu32*)(ws + WS_CTL);
    for (int u = (int)threadIdx.x; u < (LDS_BYTES - LDSCTL_OFF) / 4; u += NWAVES * 64) ((LAS unsigned*)(lds + LDSCTL_OFF))[u] = 0u;
    __syncthreads();
    XcdBarrier bar = xcd_barrier_post((unsigned*)(ctl + CW_BAR), MISC + 8);
#define GRID_BAR() do { XcdBarrier b2_ = bar; asm volatile("" : "+s"(b2_.bar), "+s"(b2_.x)); { FRESH_TID(); xcd_barrier(b2_, tid == 0); } } while (0)

#define H ((bf16*)(ws + WS_H))
#define Y1 ((bf16*)(ws + WS_Y1))
#define Gt ((bf16*)(ws + WS_G))
#define ACT ((bf16*)(ws + WS_ACT))
#define KN ((bf16*)(ws + WS_KN))
#define ATT ((bf16*)(ws + WS_ATT))
#define FOU ((bf16*)(ws + WS_FOU))
#define MG ((bf16*)(ws + WS_MG))
#define X ((bf16*)(ws + WS_X))
#define MOD ((const float*)(ws + WS_MOD))
#define ROPE ((const float*)(ws + WS_ROPE))

    const int ph_lo = fresh_kp()->ph_lo, ph_hi = fresh_kp()->ph_hi;
#define DUP(bit) ((((PROBE_MASK) >> (bit)) & 1) + 1)
#define IN(k) (ph_lo <= (k) && (k) < ph_hi)
#define SEAM(k) do { if (IN(k) && IN((k) + 1)) { GRID_BAR(); if (DUP(14) > 1) GRID_BAR(); } } while (0)
    if (IN(0)) { FRESH_TID(); p0_prologue(P, lds, tid, lane, wave, vcu, G, DUP(8), DUP(9), DUP(10)); }
    SEAM(0);

#pragma unroll 1
    for (int l = 0; l < DEPTH; ++l) {
        const bool last = (l == DEPTH - 1);
        const int nMt = last ? 64 : 72;
        const unsigned char* wl = ws + WS_W + (size_t)l * W_LAYER;
        const int pb = 1 + 9 * l;
        if (IN(pb + 0)) { FRESH_TID(); norm_rows(P, l, 0, MT, l > 0, lane, wave, vcu, G, DUP(11)); }
        SEAM(pb + 0);
        if (IN(pb + 1)) {
            pg8::EpiG1T<false> E{Y1, Gt, fresh_kp()->b_gate + l * 6144, (const float*)(ws + WS_SH), (const unsigned*)(ws + WS_CMAX) + l * CMAX_L};
            pg8::EpiG1T<true> EG{Y1, Gt, fresh_kp()->b_gate + l * 6144, (const float*)(ws + WS_SH), (const unsigned*)(ws + WS_CMAX) + l * CMAX_L};
            pg8::EpiG1T<false, true> EQ{Y1, Gt, fresh_kp()->b_gate + l * 6144, (const float*)(ws + WS_SH), (const unsigned*)(ws + WS_CMAX) + l * CMAX_L};
            const int bx = (int)blockIdx.x;
            if (!last) {
                pg8::TileOrder<MapAB> S; S.map = MapAB{(const char*)H, (const char*)(wl + WO_W1), (size_t)256 * 2048 * 2, (size_t)256 * 2048 * 2, 0, 5}; S.init(72, 13, G, bx, 1, DUP(1));
                { FRESH_TID(); pg8::gemm_phase<pg8::EpiG1T<false>, pg8::TileOrder<MapAB>, true, true>(lds, pg8::Gemm{2048, 2048, 2048}, S, E, tid); }
            } else {
                pg8::TileOrder<MapAB> S; S.map = MapAB{(const char*)H, (const char*)(wl + WO_W1), (size_t)256 * 2048 * 2, (size_t)256 * 2048 * 2, 0, 5}; S.init(64, 13, G, bx, 1, DUP(1));
                { FRESH_TID(); pg8::gemm_phase<pg8::EpiG1T<false>, pg8::TileOrder<MapAB>, true, true>(lds, pg8::Gemm{2048, 2048, 2048}, S, E, tid); }
                pg8::TileOrder<MapAB> S2; S2.map = MapAB{(const char*)H, (const char*)(wl + WO_W1), (size_t)256 * 2048 * 2, (size_t)256 * 2048 * 2, 64, 5}; S2.init(8, 5, G, (bx + G / 2) % G, 1, 1);
                { FRESH_TID(); pg8::gemm_phase<pg8::EpiG1T<false>, pg8::TileOrder<MapAB>, true, true>(lds, pg8::Gemm{2048, 2048, 2048}, S2, E, tid); }
            }
            {
                pg8::TileOrder<MapAB> SQ; SQ.map = MapAB{(const char*)(ws + WS_H8), (const char*)(wl + WO_W1), (size_t)256 * 2048, (size_t)256 * 2048, 0, 0};
                SQ.init(72, 5, G, G == 256 ? (bx + 96) % G : bx, 1, 1);
                { FRESH_TID(); pg8::gemm_phase<pg8::EpiG1T<false, true>, pg8::TileOrder<MapAB>, true, true, 2>(lds, pg8::Gemm{1024, 1024, 1024}, SQ, EQ, tid); }
            }
            {
                pg8::TileOrder<MapAB> S8; S8.map = MapAB{(const char*)(ws + WS_H8), (const char*)(wl + WO_W8) - (size_t)18 * 256 * 2048, (size_t)256 * 2048, (size_t)256 * 2048, 0, 18};
                S8.init(last ? 64 : 72, 24, G, G == 256 ? (bx + 192) % G : bx, 1, DUP(1));
                { FRESH_TID(); pg8::gemm_phase<pg8::EpiG1T<true>, pg8::TileOrder<MapAB>, true, true, 2>(lds, pg8::Gemm{1024, 1024, 1024}, S8, EG, tid); }
            }
        }
        SEAM(pb + 1);
        if (IN(pb + 2)) {
        { FRESH_TID(); f1_units(P, last, lds, tid, lane, wave, vcu, G, DUP(2)); }
        { FRESH_TID(); knorm_units(P, l, lane, wave, vcu, G, DUP(2)); }
        __syncthreads();
        { FRESH_TID(); for (int u_ = vcu; u_ < 256 * DUP(6); u_ += G) { const int u = u_ & 255; lru_unit(P, l, u >> 5, (u >> 1) & 15, u & 1, lds, lane, wave); } }
        }
        SEAM(pb + 2);
        if (IN(pb + 3)) {
            const bool evn = (vcu & 1) == 0; const int pr = vcu >> 1;
            { FRESH_TID(); if (G != 256) nyquist_rows(ws, lane, wave, vcu, G); else if (!evn) nyquist_rows(ws, lane, wave, pr, 128); }
            { FRESH_TID();
            const int nctx = (G == 256) ? ((!evn && !last && pr < 64) ? 1 : 0) : 0;
            const int ntot = (G == 256) ? 2 + nctx : 0;
            for (int ui_ = 0; ui_ < ntot * DUP(3); ++ui_) { const int ui = ui_ % ntot;
                const int U = ui < 2 ? 2 * vcu + ui : 512 + pr;
                const bf16 *Qb, *K0, *K1, *V0, *V1; bf16* Ob; int n0, NT; const float* rope;
                if (U < 512) { const int bh = U >> 3, qb = U & 7, b = bh >> 3, h = bh & 7, kvh = h >> 2; const size_t r0 = (size_t)b * 2048, rc = (size_t)ML + b * 256;
                    Qb = Y1 + (r0 + qb * 256) * LDY + YQ + h * 128; K0 = KN + r0 * 256 + kvh * 128; K1 = KN + rc * 256 + kvh * 128;
                    V0 = Y1 + r0 * LDY + YV + kvh * 128; V1 = Y1 + rc * LDY + YV + kvh * 128; n0 = 32; NT = 36; Ob = ATT + (r0 + qb * 256) * 1024 + h * 128; rope = ROPE + (size_t)qb * 256 * 64; }
                else { const int uc = U - 512, b = uc >> 3, h = uc & 7, kvh = h >> 2; const size_t rc = (size_t)ML + b * 256;
                    Qb = Y1 + rc * LDY + YQ + h * 128; K0 = KN + rc * 256 + kvh * 128; K1 = K0; V0 = Y1 + rc * LDY + YV + kvh * 128; V1 = V0; n0 = 4; NT = 4; Ob = ATT + rc * 1024 + h * 128; rope = nullptr; }
                att::attn_unit(Qb, LDY, K0, K1, V0, V1, n0, NT, 256, LDY, Ob, 1024, P->q_gain + l * 128, rope, (char*)lds_raw, tid);
            }
            if (G != 256) {
                const int nun = last ? 512 : 576;
                for (int U = vcu; U < nun; U += G) {
                    const bf16 *Qb, *K0, *K1, *V0, *V1; bf16* Ob; int n0, NT; const float* rope;
                    if (U < 512) { const int bh = U >> 3, qb = U & 7, b = bh >> 3, h = bh & 7, kvh = h >> 2; const size_t r0 = (size_t)b * 2048, rc = (size_t)ML + b * 256;
                        Qb = Y1 + (r0 + qb * 256) * LDY + YQ + h * 128; K0 = KN + r0 * 256 + kvh * 128; K1 = KN + rc * 256 + kvh * 128;
                        V0 = Y1 + r0 * LDY + YV + kvh * 128; V1 = Y1 + rc * LDY + YV + kvh * 128; n0 = 32; NT = 36; Ob = ATT + (r0 + qb * 256) * 1024 + h * 128; rope = ROPE + (size_t)qb * 256 * 64; }
                    else { const int uc = U - 512, b = uc >> 3, h = uc & 7, kvh = h >> 2; const size_t rc = (size_t)ML + b * 256;
                        Qb = Y1 + rc * LDY + YQ + h * 128; K0 = KN + rc * 256 + kvh * 128; K1 = K0; V0 = Y1 + rc * LDY + YV + kvh * 128; V1 = V0; n0 = 4; NT = 4; Ob = ATT + rc * 1024 + h * 128; rope = nullptr; }
                    att::attn_unit(Qb, LDY, K0, K1, V0, V1, n0, NT, 256, LDY, Ob, 1024, P->q_gain + l * 128, rope, (char*)lds_raw, tid);
                }
            }
            }
            __syncthreads();
            const int cF = (G == 256) ? (evn ? pr : 1 << 20) : (int)blockIdx.x;
            {
                pg8::TileOrder<MapF2> S; S.map = MapF2{(const char*)(ws + WS_DFTL), (const char*)(ws + WS_PTL)}; S.init(4, 32, G, cF, 1, DUP(5));
                pg8::EpiF2 E{FOU, 2048, 0, 1, 0.001953125f, 1};
                { FRESH_TID(); pg8::gemm_phase<pg8::EpiF2, pg8::TileOrder<MapF2>, true, true>(lds, pg8::Gemm{1024, 1024, 1024}, S, E, tid); }
            }
            if (!last) {
                pg8::TileOrder<MapAB> S; S.map = MapAB{(const char*)(ws + WS_DFTC), (const char*)(ws + WS_PTC), (size_t)256 * 512 * 2, (size_t)256 * 512 * 2, 0, 0}; S.init(1, 32, G, (G == 256) ? (!evn && pr >= 64 && pr < 96 ? pr - 64 : 1 << 20) : (int)blockIdx.x, 1, DUP(5));
                pg8::EpiF2 E{FOU, 256, ML, 0, 0.005524271728019903f, 0};
                { FRESH_TID(); pg8::gemm_phase<pg8::EpiF2, pg8::TileOrder<MapAB>, true, true>(lds, pg8::Gemm{512, 512, 512}, S, E, tid); }
            }
        }
        SEAM(pb + 3);
        if (IN(pb + 4)) {
            pg8::TileOrder<MapBr> S; S.map = MapBr{(const char*)ATT, (const char*)(wl + WO_WB), (const char*)(ws + WS_WBR + (size_t)l * 4 * MiB)}; S.init(nMt, 8, G, (int)blockIdx.x, 3, DUP(4));
            pg8::EpiBr E{Gt, MG};
            { FRESH_TID(); pg8::gemm_phase<pg8::EpiBr, pg8::TileOrder<MapBr>, true, true>(lds, pg8::Gemm{1024, 1024, 1024}, S, E, tid); }
        }
        SEAM(pb + 4);
        if (IN(pb + 5)) {
            pg8::TileOrder<MapAB> S; S.map = MapAB{(const char*)MG, (const char*)(wl + WO_WO), (size_t)256 * 2048 * 2, (size_t)256 * 2048 * 2, 0, 0}; S.init(64, 8, G, (int)blockIdx.x, 1, DUP(12));
            pg8::EpiRes E{X, MOD + (size_t)l * 9 * 12288 + 2 * 2048, (bf16*)(ws + WS_Y1)};
            { FRESH_TID(); pg8::gemm_phase<pg8::EpiRes, pg8::TileOrder<MapAB>, true, true>(lds, pg8::Gemm{2048, 2048, 2048}, S, E, tid); }
            if (!last) {
                pg8::QuarterOrder Q{G, (int)blockIdx.x, (const char*)MG, (const char*)(wl + WO_WO), (size_t)256 * 2048 * 2, (size_t)256 * 2048 * 2, (size_t)512 * 2};
                pg8::EpiResSlab EA{(float*)(ws + WS_SLAB), MOD + (size_t)l * 9 * 12288 + 2 * 2048};
                { FRESH_TID(); pg8::gemm_phase<pg8::EpiResSlab, pg8::QuarterOrder, true, true>(lds, pg8::Gemm{512, 2048, 2048}, Q, EA, tid); }
            }
        }
        SEAM(pb + 5);
        if (IN(pb + 6)) { FRESH_TID(); norm_rows(P, l, 1, nMt * 256, true, lane, wave, vcu, G, DUP(11)); }
        SEAM(pb + 6);
        if (IN(pb + 7)) {
            pg8::TileOrder<MapAB> S; S.map = MapAB{(const char*)H, (const char*)(wl + WO_WFI), (size_t)256 * 2048 * 2, (size_t)256 * 2048 * 2, 0, 0}; S.init(nMt, 44, G, (int)blockIdx.x, 1, DUP(7));
            pg8::EpiSwi E{ACT};
            { FRESH_TID(); pg8::gemm_phase<pg8::EpiSwi, pg8::TileOrder<MapAB>, true, true>(lds, pg8::Gemm{2048, 2048, 2048}, S, E, tid); }
        }
        SEAM(pb + 7);
        if (IN(pb + 8)) {
            pg8::TileOrder<MapAB> S; S.map = MapAB{(const char*)ACT, (const char*)(wl + WO_WFO), (size_t)256 * 5632 * 2, (size_t)256 * 5632 * 2, 0, 0}; S.init(64, 8, G, (int)blockIdx.x, 1, DUP(13));
            pg8::EpiRes E{X, MOD + (size_t)l * 9 * 12288 + 5 * 2048, (bf16*)(ws + WS_Y1)};
            { FRESH_TID(); pg8::gemm_phase<pg8::EpiRes, pg8::TileOrder<MapAB>, true, true>(lds, pg8::Gemm{5632, 5632, 5632}, S, E, tid); }
            if (!last) {
                pg8::QuarterOrder Q{G, (int)blockIdx.x, (const char*)ACT, (const char*)(wl + WO_WFO), (size_t)256 * 5632 * 2, (size_t)256 * 5632 * 2, (size_t)1408 * 2};
                pg8::EpiResSlab EA{(float*)(ws + WS_SLAB), MOD + (size_t)l * 9 * 12288 + 5 * 2048};
                { FRESH_TID(); pg8::gemm_phase<pg8::EpiResSlab, pg8::QuarterOrder, true, true>(lds, pg8::Gemm{1408, 5632, 5632}, Q, EA, tid); }
            }
        }
        SEAM(pb + 8);
    }
    if (IN(37)) { FRESH_TID(); final_norm(P, lane, wave, vcu, G); }
#undef IN
#undef SEAM
#undef GRID_BAR
#undef H
#undef Y1
#undef Gt
#undef ACT
#undef KN
#undef ATT
#undef FOU
#undef MG
#undef X
#undef MOD
#undef ROPE
}

extern "C" void kernel_launch(void* const* d_in, const int* in_sizes, int n_in, void* d_out, int out_size, void* d_ws, size_t ws_size, hipStream_t stream) {
    static int grid = 0;
    if (grid == 0) {
        if (n_in != 25 || out_size != ML * DM || ws_size < WS_END) { fprintf(stderr, "kernel_launch: unexpected shapes (n_in %d out %d ws %zu, need %zu)\n", n_in, out_size, ws_size, (size_t)WS_END); grid = -1; return; }
        int dev = 0, cus = 0, per_cu = 0;
        if (hipGetDevice(&dev) != hipSuccess || hipDeviceGetAttribute(&cus, hipDeviceAttributeMultiprocessorCount, dev) != hipSuccess) { grid = -1; return; }
        if (hipFuncSetAttribute((const void*)fwd_kernel, hipFuncAttributeMaxDynamicSharedMemorySize, LDS_BYTES) != hipSuccess) { fprintf(stderr, "kernel_launch: hipFuncSetAttribute failed\n"); grid = -1; return; }
        if (hipOccupancyMaxActiveBlocksPerMultiprocessor(&per_cu, (const void*)fwd_kernel, NWAVES * 64, LDS_BYTES) != hipSuccess || per_cu < 1) fprintf(stderr, "kernel_launch: occupancy query reports %d\n", per_cu);
        (void)hipGetLastError();
        grid = cus > 256 ? 256 : cus;
    }
    if (grid < 0) return;
    if (hipMemsetAsync((char*)d_ws + WS_CTL, 0, CTL_ZERO_BYTES, stream) != hipSuccess) return;
    Params p{};
    const float** pf = (const float**)&p;
    for (int i = 0; i < 25; ++i) pf[i] = (const float*)d_in[i];
    p.out = (float*)d_out; p.ws = (unsigned char*)d_ws;
#ifndef MK_CUT_EVERY
#define MK_CUT_EVERY 0
#endif
    constexpr int NPH = 38;
    for (int lo = 0; lo < NPH;) {
        const int hi = MK_CUT_EVERY ? lo + 1 : NPH;
        p.ph_lo = lo; p.ph_hi = hi;
        if (lo > 0 && hipMemsetAsync((char*)d_ws + WS_CTL, 0, CTL_ZERO_BYTES, stream) != hipSuccess) return;
        hipLaunchKernelGGL(fwd_kernel, dim3(grid), dim3(NWAVES * 64), LDS_BYTES, stream, p);
        const hipError_t le = hipPeekAtLastError();
        if (le != hipSuccess) { fprintf(stderr, "kernel_launch: launch failed: %s\n", hipGetErrorName(le)); return; }
        lo = hi;
    }
}
```

```cpp
#include <hip/hip_runtime.h>
#include <cstdio>
#include <cstdint>
#ifndef PROBE_MASK
#define PROBE_MASK 0
#endif

namespace pg8 {
#define PG8_LAS __attribute__((address_space(3)))
typedef unsigned short bf16_t;
typedef short bf16x8 __attribute__((ext_vector_type(8)));
typedef float f32x4 __attribute__((ext_vector_type(4)));
typedef float f32x2 __attribute__((ext_vector_type(2)));
typedef unsigned u32x4 __attribute__((ext_vector_type(4)));
typedef unsigned u32x2 __attribute__((ext_vector_type(2)));
typedef int i32x4 __attribute__((ext_vector_type(4)));
constexpr int BM = 256, BK = 64, HALF = 128, HTB = HALF * BK * 2  , STAGE_BYTES = 8 * HTB, NXCD = 8, WGM = 4;

__host__ __device__ __forceinline__ int lds_byte(int r, int c) { const int st = (r >> 4) * 2 + (c >> 5), rr = r & 15, cc = c & 31, ob = rr * 64 + cc * 2; return st * 1024 + (ob ^ (((ob >> 9) & 1) << 5)); }
__host__ __device__ __forceinline__ void stage_rc(int b, int& R, int& C) { const int st = b / 1024, sb = b % 1024, swz = sb ^ (((sb >> 9) & 1) << 5); R = (st >> 1) * 16 + swz / 64; C = (st & 1) * 32 + (swz % 64) / 2; }
__host__ __device__ __forceinline__ int perm32(int rho) { const int n = rho >> 4, i = rho & 15; return 8 * (i >> 2) + 4 * n + (i & 3); }

struct Unit { int pm, pn, aux, dupv; const char* A; const char* B; };
struct Gemm { int K, lda, ldb; };

template <class Map> struct TileOrder {
    int nM, nN, nwg, G, c, rep, dup; Map map;
    __device__ __forceinline__ void init(int nM_, int nN_, int G_, int c_, int rep_ = 1, int dup_ = 1) { nM = nM_; nN = nN_; nwg = nM * nN; G = G_; c = c_; rep = rep_; dup = dup_; }
    __device__ __forceinline__ bool next(int i, Unit& u) const {
        const int round = i / rep, kb = i - round * rep;
#if PROBE_MASK
        const long L = (long)round * G + c; if (L >= (long)nwg * dup) return false;
        int wgid = (int)(L % nwg); u.dupv = L >= nwg;
#else
        const long L = (long)round * G + c; if (L >= nwg) return false;
        int wgid = (int)L; u.dupv = 0;
#endif
        { const int q = nwg / NXCD, r = nwg % NXCD, xcd = wgid % NXCD, off = wgid / NXCD; wgid = (xcd < r ? xcd * (q + 1) : r * (q + 1) + (xcd - r) * q) + off; }
        const int nig = WGM * nN, gid = wgid / nig, fm = gid * WGM, gsz = (nM - fm) < WGM ? (nM - fm) : WGM;
        u.pm = fm + ((wgid % nig) % gsz); u.pn = (wgid % nig) / gsz; u.aux = kb; map(u); return true;
    }
    __device__ __forceinline__ void a_ready(const Unit&) const {}
    __device__ __forceinline__ void done(const Unit&) const {}
};

typedef float f32x2_cv __attribute__((ext_vector_type(2))); typedef __bf16 bf16x2_cv __attribute__((ext_vector_type(2)));
__device__ __forceinline__ unsigned cvt_pk_bf16(float lo, float hi) { const f32x2_cv v = {lo, hi}; const bf16x2_cv b = __builtin_convertvector(v, bf16x2_cv); return __builtin_bit_cast(unsigned, b); }
__device__ __forceinline__ float bf2f(unsigned short v) { return __uint_as_float((unsigned)v << 16); }
__device__ __forceinline__ float bflo(unsigned w) { return __uint_as_float(w << 16); }
__device__ __forceinline__ float bfhi(unsigned w) { return __uint_as_float(w & 0xffff0000u); }
__device__ __forceinline__ unsigned pk_u8x4(float a, float b, float c, float d, float sc) {
    const unsigned fa = __float_as_uint(fmaf(a, sc, 12582912.0f)), fb = __float_as_uint(fmaf(b, sc, 12582912.0f)), fc = __float_as_uint(fmaf(c, sc, 12582912.0f)), fd = __float_as_uint(fmaf(d, sc, 12582912.0f));
    const unsigned p01 = __builtin_amdgcn_perm(fb, fa, 0x0c0c0400u), p23 = __builtin_amdgcn_perm(fd, fc, 0x0c0c0400u);
    return __builtin_amdgcn_perm(p23, p01, 0x05040100u);
}
__device__ __forceinline__ float sigm(float x) { return __builtin_amdgcn_rcpf(1.0f + __builtin_amdgcn_exp2f(-1.4426950408889634f * x)); }


template <bool GATE, bool QI = GATE> struct EpiG1T {
    static constexpr bool PERM = true, AFTER_DRAIN = false, KEEP = false;
    bf16_t* Y1; bf16_t* G; const float* bgate; const float* sH; const unsigned* cmax;
    __device__ __forceinline__ void operator()(const f32x4 (&acc)[2][2][4][2], const Unit& u, int wr, int wc, int fr, int fq) const {
        asm volatile("" : "+v"(fr), "+v"(fq));
        const int row0 = u.pm * BM + wr * 64 + fr; constexpr bool gate = GATE;
        bf16_t* base = gate ? G : Y1; const int ldc = gate ? 6144 : 4608; const int colt = gate ? (u.pn - 18) * BM : u.pn * BM;
        const int col0 = colt + wc * 32 + 8 * fq;
        f32x4 bv[2][2], cs[2][2]; float rs[2][4];
#pragma unroll
        for (int bj = 0; bj < 2; ++bj)
#pragma unroll
            for (int n = 0; n < 2; ++n) { bv[bj][n] = gate ? *(const f32x4*)(bgate + col0 + bj * HALF + 4 * n) : (f32x4){0.f, 0.f, 0.f, 0.f};
                const u32x4 cm = QI ? *(const u32x4*)(cmax + (gate ? 0 : 6144) + col0 + bj * HALF + 4 * n) : (u32x4){0u, 0u, 0u, 0u};
                cs[bj][n] = (f32x4){__uint_as_float(cm.x), __uint_as_float(cm.y), __uint_as_float(cm.z), __uint_as_float(cm.w)} * (gate ? -1.4426950408889634f / 127.0f : 1.0f / 127.0f);
                if (gate) bv[bj][n] = bv[bj][n] * (-1.4426950408889634f); }
#pragma unroll
        for (int ai = 0; ai < 2; ++ai)
#pragma unroll
            for (int m = 0; m < 4; ++m) rs[ai][m] = QI ? sH[row0 + ai * HALF + m * 16] : 0.f;
#pragma unroll
        for (int ai = 0; ai < 2; ++ai)
#pragma unroll
            for (int m = 0; m < 4; ++m) { bf16_t* rowp = base + (size_t)(row0 + ai * HALF + m * 16) * ldc + col0;
#pragma unroll
                for (int bj = 0; bj < 2; ++bj) { f32x4 v0 = acc[ai][bj][m][0] + bv[bj][0], v1 = acc[ai][bj][m][1] + bv[bj][1];
                    if (gate) {
                        const i32x4 a0 = __builtin_bit_cast(i32x4, acc[ai][bj][m][0]), a1 = __builtin_bit_cast(i32x4, acc[ai][bj][m][1]);
                        const f32x4 f0 = {(float)a0[0], (float)a0[1], (float)a0[2], (float)a0[3]}, f1 = {(float)a1[0], (float)a1[1], (float)a1[2], (float)a1[3]};
                        v0 = f0 * rs[ai][m] * cs[bj][0] + bv[bj][0]; v1 = f1 * rs[ai][m] * cs[bj][1] + bv[bj][1];
                        v0 = (f32x4){__builtin_amdgcn_exp2f(v0[0]), __builtin_amdgcn_exp2f(v0[1]), __builtin_amdgcn_exp2f(v0[2]), __builtin_amdgcn_exp2f(v0[3])} + 1.0f; v1 = (f32x4){__builtin_amdgcn_exp2f(v1[0]), __builtin_amdgcn_exp2f(v1[1]), __builtin_amdgcn_exp2f(v1[2]), __builtin_amdgcn_exp2f(v1[3])} + 1.0f; }
                    if (QI && !gate) { const i32x4 a0 = __builtin_bit_cast(i32x4, acc[ai][bj][m][0]), a1 = __builtin_bit_cast(i32x4, acc[ai][bj][m][1]);
                        v0 = (f32x4){(float)a0[0], (float)a0[1], (float)a0[2], (float)a0[3]} * rs[ai][m] * cs[bj][0]; v1 = (f32x4){(float)a1[0], (float)a1[1], (float)a1[2], (float)a1[3]} * rs[ai][m] * cs[bj][1]; }
                    if (gate) {
                        const f32x4 g0 = {__builtin_amdgcn_rcpf(v0[0]), __builtin_amdgcn_rcpf(v0[1]), __builtin_amdgcn_rcpf(v0[2]), __builtin_amdgcn_rcpf(v0[3])}, g1 = {__builtin_amdgcn_rcpf(v1[0]), __builtin_amdgcn_rcpf(v1[1]), __builtin_amdgcn_rcpf(v1[2]), __builtin_amdgcn_rcpf(v1[3])};
                        u32x2 w8; w8.x = pk_u8x4(fmaxf(g0[0], 0.00393f), fmaxf(g0[1], 0.00393f), fmaxf(g0[2], 0.00393f), fmaxf(g0[3], 0.00393f), 255.0f);
                        w8.y = pk_u8x4(fmaxf(g1[0], 0.00393f), fmaxf(g1[1], 0.00393f), fmaxf(g1[2], 0.00393f), fmaxf(g1[3], 0.00393f), 255.0f);
                        *(u32x2*)((unsigned char*)G + (size_t)(row0 + ai * HALF + m * 16) * 6144 + col0 + bj * HALF) = w8;
                    } else {
                    u32x4 w; w.x = cvt_pk_bf16(v0[0], v0[1]); w.y = cvt_pk_bf16(v0[2], v0[3]); w.z = cvt_pk_bf16(v1[0], v1[1]); w.w = cvt_pk_bf16(v1[2], v1[3]);
                    *(u32x4*)(rowp + bj * HALF) = w; } } }
    }
};
struct EpiF2 {
    static constexpr bool PERM = true, AFTER_DRAIN = false, KEEP = false;
    bf16_t* FOU; int rows_per_b, row_off, mirror; float scale; int r4;
    __device__ __forceinline__ void operator()(const f32x4 (&acc)[2][2][4][2], const Unit& u, int wr, int wc, int fr, int fq) const {
        asm volatile("" : "+v"(fr), "+v"(fq));
        const int b = u.pn >> 2, q = u.pn & 3;
        const int k0 = (r4 ? 0 : u.pm * BM) + wr * 64 + fr, col0 = q * BM + wc * 32 + 8 * fq;
        bf16_t* base = FOU + (size_t)(row_off + b * rows_per_b) * 1024 + col0;
#pragma unroll
        for (int ai = 0; ai < 2; ++ai)
#pragma unroll
            for (int m = 0; m < 4; ++m) { const int kk = r4 ? u.pm + 4 * (k0 + ai * HALF + m * 16) : k0 + ai * HALF + m * 16; bf16_t* rowp = base + (size_t)kk * 1024; bf16_t* rowm = base + (size_t)(rows_per_b - kk) * 1024;
#pragma unroll
                for (int bj = 0; bj < 2; ++bj) { const f32x4 v0 = acc[ai][bj][m][0] * scale, v1 = acc[ai][bj][m][1] * scale;
                    u32x4 w; w.x = cvt_pk_bf16(v0[0], v0[1]); w.y = cvt_pk_bf16(v0[2], v0[3]); w.z = cvt_pk_bf16(v1[0], v1[1]); w.w = cvt_pk_bf16(v1[2], v1[3]);
                    *(u32x4*)(rowp + bj * HALF) = w; if (mirror && kk > 0) *(u32x4*)(rowm + bj * HALF) = w; } }
    }
};
struct EpiBr {
    static constexpr bool PERM = true, AFTER_DRAIN = false, KEEP = true;
    const bf16_t* G; bf16_t* MG;
    __device__ __forceinline__ void operator()(f32x4 (&acc)[2][2][4][2], const Unit& u, int wr, int wc, int fr, int fq) const {
        asm volatile("" : "+v"(fr), "+v"(fq));
        const int kb = u.aux, row0 = u.pm * BM + wr * 64 + fr, col0 = u.pn * BM + wc * 32 + 8 * fq;
        const unsigned char* G8 = (const unsigned char*)G;
#define BR_U8(w) (f32x4){(float)((w) & 0xffu), (float)(((w) >> 8) & 0xffu), (float)(((w) >> 16) & 0xffu), (float)((w) >> 24)}
        const __amdgpu_buffer_rsrc_t rsG = __builtin_amdgcn_make_buffer_rsrc((void*)(((unsigned long long)(unsigned)__builtin_amdgcn_readfirstlane((int)(unsigned)((unsigned long long)G8 >> 32)) << 32) | (unsigned long long)(unsigned)__builtin_amdgcn_readfirstlane((int)(unsigned)(unsigned long long)G8)), (short)0, (int)((size_t)18432 * 6144), 0x00020000);
        const int voff = row0 * 6144 + kb * 2048 + col0;
#define BR_LD(ai, m, bj, extra) __builtin_bit_cast(u32x2, __builtin_amdgcn_raw_buffer_load_b64(rsG, voff, ((ai) * HALF + (m) * 16) * 6144 + (bj) * HALF + (extra), 0))
        u32x2 gw[2][4][2];
#pragma unroll
        for (int ai = 0; ai < 2; ++ai)
#pragma unroll
            for (int m = 0; m < 4; ++m)
#pragma unroll
                for (int bj = 0; bj < 2; ++bj) gw[ai][m][bj] = BR_LD(ai, m, bj, 0);
        if (kb < 2) {
            u32x2 hw[2][4][2];
#pragma unroll
            for (int ai = 0; ai < 2; ++ai)
#pragma unroll
                for (int m = 0; m < 4; ++m)
#pragma unroll
                    for (int bj = 0; bj < 2; ++bj) hw[ai][m][bj] = BR_LD(ai, m, bj, 2048);
            asm volatile("" ::: "memory");
#pragma unroll
            for (int ai = 0; ai < 2; ++ai)
#pragma unroll
                for (int m = 0; m < 4; ++m)
#pragma unroll
                    for (int bj = 0; bj < 2; ++bj) {
                        asm volatile("" : "+v"(gw[ai][m][bj].x), "+v"(gw[ai][m][bj].y), "+v"(hw[ai][m][bj].x), "+v"(hw[ai][m][bj].y));
                        const f32x4 n0 = BR_U8(gw[ai][m][bj].x), n1 = BR_U8(gw[ai][m][bj].y), d0 = BR_U8(hw[ai][m][bj].x), d1 = BR_U8(hw[ai][m][bj].y);
                        const f32x4 s0 = n0 * (f32x4){__builtin_amdgcn_rcpf(d0[0]), __builtin_amdgcn_rcpf(d0[1]), __builtin_amdgcn_rcpf(d0[2]), __builtin_amdgcn_rcpf(d0[3])};
                        const f32x4 s1 = n1 * (f32x4){__builtin_amdgcn_rcpf(d1[0]), __builtin_amdgcn_rcpf(d1[1]), __builtin_amdgcn_rcpf(d1[2]), __builtin_amdgcn_rcpf(d1[3])};
                        acc[ai][bj][m][0] = acc[ai][bj][m][0] * s0; acc[ai][bj][m][1] = acc[ai][bj][m][1] * s1;
                        asm volatile("" : "+v"(acc[ai][bj][m][0]), "+v"(acc[ai][bj][m][1])); }
        } else {
            asm volatile("" ::: "memory");
#pragma unroll
            for (int ai = 0; ai < 2; ++ai)
#pragma unroll
                for (int m = 0; m < 4; ++m)
#pragma unroll
                    for (int bj = 0; bj < 2; ++bj) { asm volatile("" : "+v"(gw[ai][m][bj].x), "+v"(gw[ai][m][bj].y));
                        const f32x4 v0 = acc[ai][bj][m][0] * (BR_U8(gw[ai][m][bj].x) * (1.0f / 255.0f)), v1 = acc[ai][bj][m][1] * (BR_U8(gw[ai][m][bj].y) * (1.0f / 255.0f));
                        u32x4 w; w.x = cvt_pk_bf16(v0[0], v0[1]); w.y = cvt_pk_bf16(v0[2], v0[3]); w.z = cvt_pk_bf16(v1[0], v1[1]); w.w = cvt_pk_bf16(v1[2], v1[3]);
                        *(u32x4*)(MG + (size_t)(row0 + ai * HALF + m * 16) * 2048 + col0 + bj * HALF) = w; }
        }
        asm volatile("" ::: "memory");
#undef BR_U8
#undef BR_LD
    }
};
struct EpiRes {
    static constexpr bool PERM = true, AFTER_DRAIN = false, KEEP = false;
    bf16_t* X; const float* gv; bf16_t* Xdup;
    __device__ __forceinline__ void operator()(const f32x4 (&acc)[2][2][4][2], const Unit& u, int wr, int wc, int fr, int fq) const {
        asm volatile("" : "+v"(fr), "+v"(fq));
        const int rsel = u.pm < 64 ? (u.pm >> 3) : 8; const float* gr = gv + (size_t)rsel * 12288;
        const int row0 = u.pm * BM + wr * 64 + fr, col0 = u.pn * BM + wc * 32 + 8 * fq;
        f32x4 gvv[2][2];
#pragma unroll
        for (int bj = 0; bj < 2; ++bj)
#pragma unroll
            for (int n = 0; n < 2; ++n) gvv[bj][n] = *(const f32x4*)(gr + col0 + bj * HALF + n * 4);
        u32x4 xw[2][4][2];
#pragma unroll
        for (int ai = 0; ai < 2; ++ai)
#pragma unroll
            for (int m = 0; m < 4; ++m)
#pragma unroll
                for (int bj = 0; bj < 2; ++bj) xw[ai][m][bj] = *(const u32x4*)(X + (size_t)(row0 + ai * HALF + m * 16) * 2048 + col0 + bj * HALF);
#pragma unroll
        for (int ai = 0; ai < 2; ++ai)
#pragma unroll
            for (int m = 0; m < 4; ++m) { bf16_t* rowp = X + (size_t)(row0 + ai * HALF + m * 16) * 2048 + col0;
#pragma unroll
                for (int bj = 0; bj < 2; ++bj) { bf16_t* p = rowp + bj * HALF; bf16_t* pw = PROBE_MASK ? (u.dupv ? Xdup + (p - X) : p) : p;
                    const u32x4 x = xw[ai][m][bj];
                    const f32x4 v0 = (f32x4){bflo(x.x), bfhi(x.x), bflo(x.y), bfhi(x.y)} + gvv[bj][0] * acc[ai][bj][m][0];
                    const f32x4 v1 = (f32x4){bflo(x.z), bfhi(x.z), bflo(x.w), bfhi(x.w)} + gvv[bj][1] * acc[ai][bj][m][1];
                    u32x4 w; w.x = cvt_pk_bf16(v0[0], v0[1]); w.y = cvt_pk_bf16(v0[2], v0[3]); w.z = cvt_pk_bf16(v1[0], v1[1]); w.w = cvt_pk_bf16(v1[2], v1[3]);
                    *(u32x4*)pw = w; } }
    }
};
struct EpiResSlab {
    static constexpr bool PERM = false, AFTER_DRAIN = false, KEEP = false;
    float* SL; const float* gv;
    __device__ __forceinline__ void operator()(const f32x4 (&acc)[2][2][4][2], const Unit& u, int wr, int wc, int fr, int fq) const {
        asm volatile("" : "+v"(fr), "+v"(fq));
        const float* gr = gv + (size_t)8 * 12288;
        const int row0 = (u.pm - 64) * BM + wr * 64 + fr, col0 = u.pn * BM + wc * 32 + 4 * fq;
        float* base = SL + (size_t)u.aux * 2048 * 2048;
        f32x4 gvv[2][2];
#pragma unroll
        for (int bj = 0; bj < 2; ++bj)
#pragma unroll
            for (int n = 0; n < 2; ++n) gvv[bj][n] = *(const f32x4*)(gr + col0 + bj * HALF + n * 16);
#pragma unroll
        for (int ai = 0; ai < 2; ++ai)
#pragma unroll
            for (int m = 0; m < 4; ++m) { float* rowp = base + (size_t)(row0 + ai * HALF + m * 16) * 2048 + col0;
#pragma unroll
                for (int bj = 0; bj < 2; ++bj)
#pragma unroll
                    for (int n = 0; n < 2; ++n) *(f32x4*)(rowp + bj * HALF + n * 16) = gvv[bj][n] * acc[ai][bj][m][n]; }
    }
};
struct QuarterOrder {
    int G, c; const char* A; const char* B; size_t astep, bstep, kbytes;
    __device__ __forceinline__ bool next(int i, Unit& u) const {
        const int L = i * G + c; if (L >= 256) return false;
        u.pm = 64 + (L >> 5); u.pn = (L >> 2) & 7; u.aux = L & 3; u.dupv = 0;
        u.A = A + (size_t)u.pm * astep + (size_t)u.aux * kbytes; u.B = B + (size_t)u.pn * bstep + (size_t)u.aux * kbytes; return true;
    }
    __device__ __forceinline__ void a_ready(const Unit&) const {}
    __device__ __forceinline__ void done(const Unit&) const {}
};
struct EpiSwi {
    static constexpr bool PERM = true, AFTER_DRAIN = false, KEEP = false;
    bf16_t* ACT;
    __device__ __forceinline__ void operator()(const f32x4 (&acc)[2][2][4][2], const Unit& u, int wr, int wc, int fr, int fq) const {
        asm volatile("" : "+v"(fr), "+v"(fq));
        const int row0 = u.pm * BM + wr * 64 + fr, col0 = u.pn * HALF + wc * 32 + 8 * fq;
#pragma unroll
        for (int ai = 0; ai < 2; ++ai)
#pragma unroll
            for (int m = 0; m < 4; ++m) { bf16_t* rowp = ACT + (size_t)(row0 + ai * HALF + m * 16) * 5632 + col0;
                f32x4 o[2];
#pragma unroll
                for (int n = 0; n < 2; ++n) { const f32x4 g = acc[ai][0][m][n], up = acc[ai][1][m][n];
                    o[n] = (f32x4){g[0] * sigm(g[0]) * up[0], g[1] * sigm(g[1]) * up[1], g[2] * sigm(g[2]) * up[2], g[3] * sigm(g[3]) * up[3]}; }
                u32x4 w; w.x = cvt_pk_bf16(o[0][0], o[0][1]); w.y = cvt_pk_bf16(o[0][2], o[0][3]); w.z = cvt_pk_bf16(o[1][0], o[1][1]); w.w = cvt_pk_bf16(o[1][2], o[1][3]);
                *(u32x4*)rowp = w; }
    }
};

template <class Epi, class Sched, bool ALIGN_EPI = false, bool SP2 = false, int QM = 0>
__device__ __forceinline__ void gemm_phase(PG8_LAS unsigned char* lds, const Gemm g, const Sched& S, const Epi& E, const int tid) {
    { unsigned l32_ = (unsigned)(unsigned long long)lds; asm volatile("" : "+s"(l32_)); lds = (PG8_LAS unsigned char*)(unsigned long long)l32_; }
    const int wid = __builtin_amdgcn_readfirstlane(tid >> 6), lane = tid & 63, wr = wid >> 2, wc = wid & 3, fr = lane & 15, fq = lane >> 4;
    const int K = g.K, nt = K / BK;
    unsigned voffA, voffB;
    { int R, C; stage_rc(tid * 16, R, C); const int Rb = Epi::PERM ? ((R & ~31) + perm32(R & 31)) : R;
        voffA = (unsigned)(R * g.lda + C) * 2u; voffB = (unsigned)(Rb * g.ldb + C) * 2u; }
    const size_t rstepA = (size_t)64 * g.lda * 2, rstepB = (size_t)64 * g.ldb * 2;
    const size_t kstep = (size_t)(BK * 2);
    const size_t hstepA = (size_t)HALF * g.lda * 2, hstepB = (size_t)HALF * g.ldb * 2;
    const unsigned ldsw = (unsigned)wid * 1024u;
    const int aoff = lds_byte(wr * 64 + fr, fq * 8), boff = lds_byte(wc * 32 + fr, fq * 8);
#define PG8_SA(b, h) (((b) * 2 + (h)) * HTB)
#define PG8_SB(b, h) ((4 + (b) * 2 + (h)) * HTB)
#define PG8_STAGE(bufoff, gbase, voff) do { _Pragma("unroll") for (int _i = 0; _i < 2; ++_i) \
        __builtin_amdgcn_global_load_lds((const unsigned*)((const char*)(gbase) + (size_t)_i * rstep_##voff + (voff)), (PG8_LAS unsigned*)(lds + (bufoff) + ldsw + _i * 8192), 16, 0, 0); } while (0)
#define rstep_voffA rstepA
#define rstep_voffB rstepB
#define PG8_LDA(dst, b, h) do { _Pragma("unroll") for (int m = 0; m < 4; ++m) _Pragma("unroll") for (int k = 0; k < 2; ++k) dst[m][k] = *(const PG8_LAS bf16x8*)(lds + PG8_SA(b, h) + aoff + m * 2048 + k * 1024); } while (0)
#define PG8_LDB(dst, b, h) do { _Pragma("unroll") for (int n = 0; n < 2; ++n) _Pragma("unroll") for (int k = 0; k < 2; ++k) dst[n][k] = *(const PG8_LAS bf16x8*)(lds + PG8_SB(b, h) + boff + n * 2048 + k * 1024); } while (0)
#define PG8_CAT(x, y) __builtin_shufflevector(__builtin_bit_cast(i32x4, x), __builtin_bit_cast(i32x4, y), 0, 1, 2, 3, 4, 5, 6, 7)
#define PG8_MMA(ai, bj, At, Bt) do { __builtin_amdgcn_s_setprio(1); \
        if constexpr (QM == 1) { _Pragma("unroll") for (int m = 0; m < 4; ++m) _Pragma("unroll") for (int n = 0; n < 2; ++n) \
            acc[ai][bj][m][n] = __builtin_amdgcn_mfma_scale_f32_16x16x128_f8f6f4(PG8_CAT(Bt[n][0], Bt[n][1]), PG8_CAT(At[m][0], At[m][1]), acc[ai][bj][m][n], 0, 0, 0, 0x7f7f7f7f, 0, 0x7f7f7f7f); } \
        else if constexpr (QM == 2) { _Pragma("unroll") for (int m = 0; m < 4; ++m) _Pragma("unroll") for (int n = 0; n < 2; ++n) _Pragma("unroll") for (int k = 0; k < 2; ++k) \
            acc[ai][bj][m][n] = __builtin_bit_cast(f32x4, __builtin_amdgcn_mfma_i32_16x16x64_i8(__builtin_bit_cast(i32x4, Bt[n][k]), __builtin_bit_cast(i32x4, At[m][k]), __builtin_bit_cast(i32x4, acc[ai][bj][m][n]), 0, 0, 0)); } \
        else { _Pragma("unroll") for (int m = 0; m < 4; ++m) _Pragma("unroll") for (int n = 0; n < 2; ++n) _Pragma("unroll") for (int k = 0; k < 2; ++k) \
            acc[ai][bj][m][n] = __builtin_amdgcn_mfma_f32_16x16x32_bf16(Bt[n][k], At[m][k], acc[ai][bj][m][n], 0, 0, 0); } \
        __builtin_amdgcn_s_setprio(0); } while (0)
#define PG8_WAIT_V(n) asm volatile("s_waitcnt vmcnt(" #n ")" ::: "memory")
#define PG8_WAIT_L(n) asm volatile("s_waitcnt lgkmcnt(" #n ")" ::: "memory")
#define PG8_BAR __builtin_amdgcn_s_barrier()
#define PG8_SCHED __builtin_amdgcn_sched_barrier(0)
    Unit cur, nxt; int ui = 0;
    if (!S.next(0, cur)) return;
    f32x4 acc[2][2][4][2];
#pragma unroll
    for (int a = 0; a < 2; ++a)
#pragma unroll
        for (int b = 0; b < 2; ++b)
#pragma unroll
            for (int m = 0; m < 4; ++m)
#pragma unroll
                for (int n = 0; n < 2; ++n) acc[a][b][m][n] = (f32x4){0.f, 0.f, 0.f, 0.f};
    bf16x8 At[4][2], B0[2][2], B1[2][2];
    const char* cA = cur.A; const char* cB = cur.B;
    S.a_ready(cur);
    if constexpr (SP2) {
        PG8_STAGE(PG8_SB(0, 0), cB, voffB); PG8_STAGE(PG8_SB(0, 1), cB + hstepB, voffB); PG8_STAGE(PG8_SA(0, 0), cA, voffA); PG8_STAGE(PG8_SA(0, 1), cA + hstepA, voffA);
        if (wr == 1) PG8_BAR;
        PG8_WAIT_V(2); PG8_BAR;
        PG8_STAGE(PG8_SB(1, 0), cB + kstep, voffB); PG8_STAGE(PG8_SA(1, 0), cA + kstep, voffA); PG8_STAGE(PG8_SB(1, 1), cB + hstepB + kstep, voffB);
        PG8_WAIT_V(6); PG8_BAR;
    } else {
        PG8_STAGE(PG8_SB(0, 0), cB, voffB); PG8_STAGE(PG8_SA(0, 0), cA, voffA); PG8_STAGE(PG8_SB(0, 1), cB + hstepB, voffB); PG8_STAGE(PG8_SA(0, 1), cA + hstepA, voffA);
        if (wr == 1) PG8_BAR;
        PG8_WAIT_V(4); PG8_BAR;
        PG8_STAGE(PG8_SB(1, 0), cB + kstep, voffB); PG8_STAGE(PG8_SA(1, 0), cA + kstep, voffA); PG8_STAGE(PG8_SB(1, 1), cB + hstepB + kstep, voffB);
        PG8_WAIT_V(6); PG8_BAR;
    }
    for (;;) {
        const bool has_next = S.next(ui + 1, nxt);
        const char* nA = has_next ? nxt.A : cA; const char* nB = has_next ? nxt.B : cB;
        for (int t = 0; t < nt; t += 2) {
            const bool last = (t == nt - 2);
            const char* a1 = cA + (size_t)(t + 1) * kstep;
            const char* a2 = last ? nA : cA + (size_t)(t + 2) * kstep; const char* b2 = last ? nB : cB + (size_t)(t + 2) * kstep;
            const char* a3 = a2 + kstep; const char* b3 = b2 + kstep;
            if (last && has_next) S.a_ready(nxt);
            if constexpr (SP2) {
            PG8_LDB(B0, 0, 0); PG8_LDB(B1, 0, 1); PG8_SCHED; PG8_LDA(At, 0, 0); PG8_STAGE(PG8_SA(1, 1), a1 + hstepA, voffA);
            PG8_WAIT_V(8); PG8_WAIT_L(0); PG8_BAR; PG8_MMA(0, 0, At, B0); PG8_MMA(0, 1, At, B1); PG8_BAR; PG8_SCHED;
            PG8_LDA(At, 0, 1); PG8_STAGE(PG8_SB(0, 0), b2, voffB); PG8_STAGE(PG8_SB(0, 1), b2 + hstepB, voffB); PG8_STAGE(PG8_SA(0, 0), a2, voffA);
            PG8_WAIT_V(8); PG8_WAIT_L(0); PG8_BAR; PG8_MMA(1, 0, At, B0); PG8_MMA(1, 1, At, B1); PG8_BAR; PG8_SCHED;
            PG8_LDB(B0, 1, 0); PG8_LDB(B1, 1, 1); PG8_SCHED; PG8_LDA(At, 1, 0); PG8_STAGE(PG8_SA(0, 1), a2 + hstepA, voffA);
            PG8_WAIT_V(8); PG8_WAIT_L(0); PG8_BAR; PG8_MMA(0, 0, At, B0); PG8_MMA(0, 1, At, B1); PG8_BAR; PG8_SCHED;
            PG8_LDA(At, 1, 1); PG8_STAGE(PG8_SB(1, 0), b3, voffB); PG8_STAGE(PG8_SB(1, 1), b3 + hstepB, voffB); PG8_STAGE(PG8_SA(1, 0), a3, voffA);
            PG8_WAIT_V(8); PG8_WAIT_L(0); PG8_BAR; PG8_MMA(1, 0, At, B0); PG8_MMA(1, 1, At, B1); PG8_BAR; PG8_SCHED;
            } else {
            PG8_LDB(B0, 0, 0); PG8_SCHED; PG8_LDA(At, 0, 0); PG8_STAGE(PG8_SA(1, 1), a1 + hstepA, voffA);
            PG8_WAIT_L(8); PG8_BAR; PG8_WAIT_L(0); PG8_MMA(0, 0, At, B0); PG8_BAR; PG8_SCHED;
            PG8_LDB(B1, 0, 1); PG8_STAGE(PG8_SB(0, 0), b2, voffB);
            PG8_BAR; PG8_WAIT_L(0); PG8_MMA(0, 1, At, B1); PG8_BAR;
            PG8_LDA(At, 0, 1); PG8_STAGE(PG8_SA(0, 0), a2, voffA);
            PG8_BAR; PG8_WAIT_L(0); PG8_MMA(1, 0, At, B0); PG8_BAR; PG8_SCHED;
            PG8_STAGE(PG8_SB(0, 1), b2 + hstepB, voffB);
            PG8_WAIT_V(6); PG8_BAR; PG8_MMA(1, 1, At, B1); PG8_BAR;
            PG8_LDB(B0, 1, 0); PG8_SCHED; PG8_LDA(At, 1, 0); PG8_STAGE(PG8_SA(0, 1), a2 + hstepA, voffA);
            PG8_WAIT_L(8); PG8_BAR; PG8_WAIT_L(0); PG8_MMA(0, 0, At, B0); PG8_BAR; PG8_SCHED;
            PG8_LDB(B1, 1, 1); PG8_STAGE(PG8_SB(1, 0), b3, voffB);
            PG8_BAR; PG8_WAIT_L(0); PG8_MMA(0, 1, At, B1); PG8_BAR;
            PG8_LDA(At, 1, 1); PG8_STAGE(PG8_SA(1, 0), a3, voffA);
            PG8_BAR; PG8_WAIT_L(0); PG8_MMA(1, 0, At, B0); PG8_BAR; PG8_SCHED;
            PG8_STAGE(PG8_SB(1, 1), b3 + hstepB, voffB);
            PG8_WAIT_V(6); PG8_BAR; PG8_MMA(1, 1, At, B1); PG8_BAR;
            }
        }
        if constexpr (ALIGN_EPI) { if (wr == 0) PG8_BAR; }
        if constexpr (!Epi::AFTER_DRAIN) { int l2_; asm volatile("v_mbcnt_lo_u32_b32 %0, -1, 0\n\tv_mbcnt_hi_u32_b32 %0, -1, %0" : "=v"(l2_)); E(acc, cur, wr, wc, l2_ & 15, l2_ >> 4); S.done(cur); }
        if (!has_next) break;
        if (!(Epi::KEEP && cur.aux < 2)) {
#pragma unroll
        for (int a = 0; a < 2; ++a)
#pragma unroll
            for (int b = 0; b < 2; ++b)
#pragma unroll
                for (int m = 0; m < 4; ++m)
#pragma unroll
                    for (int n = 0; n < 2; ++n) acc[a][b][m][n] = (f32x4){0.f, 0.f, 0.f, 0.f};
        }
        cur = nxt; cA = nA; cB = nB; ++ui;
        if constexpr (ALIGN_EPI) { if (wr == 1) PG8_BAR; }
    }
    PG8_WAIT_V(0);
    if constexpr (!ALIGN_EPI) { if (wr == 0) PG8_BAR; }
    PG8_BAR;
    if constexpr (Epi::AFTER_DRAIN) { E.fused(acc, cur, wr, wc, fr, fq, lds, wid, lane); S.done(cur); }
#undef PG8_SA
#undef PG8_SB
#undef PG8_STAGE
#undef rstep_voffA
#undef rstep_voffB
#undef PG8_LDA
#undef PG8_LDB
#undef PG8_MMA
#undef PG8_CAT
#undef PG8_WAIT_V
#undef PG8_WAIT_L
#undef PG8_BAR
#undef PG8_SCHED
}
}

namespace att {
typedef unsigned short bf16_t;
using bf16x8 = __attribute__((ext_vector_type(8))) short;
using s16x4  = __attribute__((ext_vector_type(4))) short;
using f32x16 = __attribute__((ext_vector_type(16))) float;
using f32x4  = __attribute__((ext_vector_type(4))) float;
using u32x4  = __attribute__((ext_vector_type(4))) unsigned;
constexpr int D = 128, NW = 8, QBLK = 32, KVBLK = 64;
constexpr float SCALE = 0.088388347648318440f;
constexpr float THR = 8.f;
constexpr int SDEPTH = 2;
constexpr size_t SHM_V = KVBLK * D * 2, SHM_K = KVBLK * D * 2, SHM_ATTN = 2 * SHM_V + 2 * SHM_K + NW * 64 * 4;
#define KSWZ(row, colB) ((row) * 256 + ((colB) ^ (((row) & 7) << 4)))
#define SBAR() __builtin_amdgcn_sched_barrier(0)
__device__ __forceinline__ int crow(int r, int hi) { return (r & 3) + 8 * (r >> 2) + 4 * hi; }
__device__ __forceinline__ unsigned cvtpk(float lo, float hi) { unsigned r; asm volatile("v_cvt_pk_bf16_f32 %0, %1, %2" : "=v"(r) : "v"(lo), "v"(hi)); return r; }
__device__ __forceinline__ bf16x8 ld8(const bf16_t* p) { return *reinterpret_cast<const bf16x8*>(p); }
__device__ __forceinline__ float b2f(short v) { return __uint_as_float(((unsigned)(unsigned short)v) << 16); }

__device__ __forceinline__ void partialSM(f32x16& p0, f32x16& p1, float& m_reg, float& mn, float& alpha) {
  constexpr float C = SCALE * 1.4426950408889634f;
  float pmax = p0[0]; for (int r = 1; r < 16; ++r) pmax = fmaxf(pmax, p0[r]); for (int r = 0; r < 16; ++r) pmax = fmaxf(pmax, p1[r]);
  { auto rr = __builtin_amdgcn_permlane32_swap(__float_as_uint(pmax), __float_as_uint(pmax), false, false);
    pmax = fmaxf(__uint_as_float(rr[0]), __uint_as_float(rr[1])); }
  if (__builtin_expect(__all(pmax - m_reg <= THR / SCALE), 1)) { mn = m_reg; alpha = 1.f; }
  else { mn = fmaxf(m_reg, pmax); alpha = __builtin_amdgcn_exp2f((m_reg - mn) * C); m_reg = mn; }
  float mnC = -mn * C;
  for (int r = 0; r < 16; ++r) p0[r] = fmaf(p0[r], C, mnC); for (int r = 0; r < 16; ++r) p1[r] = fmaf(p1[r], C, mnC);
  for (int r = 0; r < 16; ++r) p0[r] = __builtin_amdgcn_exp2f(p0[r]);
}
__device__ __forceinline__ void finishSM(f32x16& p0, f32x16& p1, float alpha, float& l_reg, bf16x8& pa0, bf16x8& pa1, bf16x8& pa2, bf16x8& pa3) {
  for (int r = 0; r < 16; ++r) p1[r] = __builtin_amdgcn_exp2f(p1[r]);
  float ps = 0; for (int r = 0; r < 16; ++r) ps += p0[r]; for (int r = 0; r < 16; ++r) ps += p1[r];
  { auto rr = __builtin_amdgcn_permlane32_swap(__float_as_uint(ps), __float_as_uint(ps), false, false);
    ps = __uint_as_float(rr[0]) + __uint_as_float(rr[1]); }
  l_reg = l_reg * alpha + ps;
#define PK4(P, BASE, OUT) do { unsigned a0 = cvtpk(P[BASE + 0], P[BASE + 1]), a1 = cvtpk(P[BASE + 2], P[BASE + 3]);   \
    unsigned b0 = cvtpk(P[BASE + 4], P[BASE + 5]), b1 = cvtpk(P[BASE + 6], P[BASE + 7]);                              \
    auto r0 = __builtin_amdgcn_permlane32_swap(a0, b0, false, false); auto r1 = __builtin_amdgcn_permlane32_swap(a1, b1, false, false); \
    u32x4 w = {r0[0], r1[0], r0[1], r1[1]}; OUT = *reinterpret_cast<bf16x8*>(&w); } while (0)
  PK4(p0, 0, pa0); PK4(p0, 8, pa1); PK4(p1, 0, pa2); PK4(p1, 8, pa3);
#undef PK4
}
__device__ __forceinline__ void qkt(f32x16& p0, f32x16& p1, const bf16_t* Ks, const bf16x8* qr, int r32, int hi) {
  p0 = f32x16{}; p1 = f32x16{};
  for (int d0 = 0; d0 < 8; ++d0) { int cb = (d0 * 16 + hi * 8) * 2;
    bf16x8 b0 = *reinterpret_cast<const bf16x8*>((const char*)Ks + KSWZ(r32, cb));
    bf16x8 b1 = *reinterpret_cast<const bf16x8*>((const char*)Ks + KSWZ(32 + r32, cb));
    p0 = __builtin_amdgcn_mfma_f32_32x32x16_bf16(b0, qr[d0], p0, 0, 0, 0);
    p1 = __builtin_amdgcn_mfma_f32_32x32x16_bf16(b1, qr[d0], p1, 0, 0, 0); }
}
__device__ __forceinline__ int v_st(int k, int c) { const int kk = (k & ~0xC) | ((k & 4) << 1) | ((k & 8) >> 1); return ((kk >> 3) * 4 + (c >> 5)) * 512 + ((kk & 7) * 32 + (c & 31)) * 2; }
__device__ __forceinline__ int v_rd_base(int lane) { return ((lane & 3) << 3) | (((lane >> 2) & 3) << 6) | (((lane >> 4) & 1) << 5) | (((lane >> 5) & 1) << 8); }
constexpr int v_rd_off(int d0, int ks, int half) { return d0 * 512 + ks * 4096 + half * 2048; }
template <int OFF> __device__ __forceinline__ s16x4 tr_read(int vb) {
  s16x4 r; asm volatile("ds_read_b64_tr_b16 %0, %1 offset:%2" : "=&v"(r) : "v"(vb), "i"(OFF) : "memory"); return r;
}
template <int D0> __device__ __forceinline__ void pv_one(f32x16& od, int vb, bf16x8 pa0, bf16x8 pa1, bf16x8 pa2, bf16x8 pa3) {
  const s16x4 l0 = tr_read<v_rd_off(D0, 0, 0)>(vb), h0 = tr_read<v_rd_off(D0, 0, 1)>(vb), l1 = tr_read<v_rd_off(D0, 1, 0)>(vb), h1 = tr_read<v_rd_off(D0, 1, 1)>(vb);
  const s16x4 l2 = tr_read<v_rd_off(D0, 2, 0)>(vb), h2 = tr_read<v_rd_off(D0, 2, 1)>(vb), l3 = tr_read<v_rd_off(D0, 3, 0)>(vb), h3 = tr_read<v_rd_off(D0, 3, 1)>(vb);
  asm volatile("s_waitcnt lgkmcnt(0)" ::: "memory"); SBAR();
#define PK(L, H) (bf16x8){L[0], L[1], L[2], L[3], H[0], H[1], H[2], H[3]}
  od = __builtin_amdgcn_mfma_f32_32x32x16_bf16(pa0, PK(l0, h0), od, 0, 0, 0);
  od = __builtin_amdgcn_mfma_f32_32x32x16_bf16(pa1, PK(l1, h1), od, 0, 0, 0);
  od = __builtin_amdgcn_mfma_f32_32x32x16_bf16(pa2, PK(l2, h2), od, 0, 0, 0);
  od = __builtin_amdgcn_mfma_f32_32x32x16_bf16(pa3, PK(l3, h3), od, 0, 0, 0);
#undef PK
}
__device__ __forceinline__ void pv_d0(f32x16* o, int vb, bf16x8 pa0, bf16x8 pa1, bf16x8 pa2, bf16x8 pa3) {
  pv_one<0>(o[0], vb, pa0, pa1, pa2, pa3); pv_one<1>(o[1], vb, pa0, pa1, pa2, pa3); pv_one<2>(o[2], vb, pa0, pa1, pa2, pa3); pv_one<3>(o[3], vb, pa0, pa1, pa2, pa3);
}

__device__ __forceinline__ void attn_unit(const bf16_t* __restrict__ Qb, int ldq, const bf16_t* __restrict__ K0, const bf16_t* __restrict__ K1, const bf16_t* __restrict__ V0, const bf16_t* __restrict__ V1,
                                          int n0, int NT, int ldk, int ldv, bf16_t* __restrict__ Ob, int ldo, const float* __restrict__ qgain, const float* __restrict__ rope_cs, char* lds, int tid) {
  asm volatile("" : "+v"(tid));
  const int wid = tid >> 6, lane = tid & 63, r32 = lane & 31, hi = lane >> 5;
  bf16_t* V_lds = (bf16_t*)lds; bf16_t* K_lds = (bf16_t*)(lds + 2 * SHM_V);
  float* ws = (float*)(lds + 2 * SHM_V + 2 * SHM_K) + wid * 64; float* li_l = ws; float* al_l = ws + 32;
  float m_reg = -1e30f, l_reg = 0; f32x16 o[4] = {}; bf16x8 qr[8];
  const bf16_t* Qw = Qb + (long)(wid * QBLK + r32) * ldq + hi * 8;
#pragma unroll
  for (int d0 = 0; d0 < 8; ++d0) qr[d0] = ld8(Qw + d0 * 16);
  {
    float ss = 0.f;
#pragma unroll
    for (int d0 = 0; d0 < 8; ++d0)
#pragma unroll
      for (int j = 0; j < 8; ++j) { const float f = b2f(qr[d0][j]); ss += f * f; }
    { auto rr = __builtin_amdgcn_permlane32_swap(__float_as_uint(ss), __float_as_uint(ss), false, false); ss = __uint_as_float(rr[0]) + __uint_as_float(rr[1]); }
    const float rstd = 1.0f / sqrtf(ss * (1.0f / 128.0f) + 1e-6f);
#pragma unroll
    for (int d0 = 0; d0 < 4; ++d0) {
      const int i0 = d0 * 16 + hi * 8;
      const f32x4 ga0 = *(const f32x4*)(qgain + i0), ga1 = *(const f32x4*)(qgain + i0 + 4), gb0 = *(const f32x4*)(qgain + 64 + i0), gb1 = *(const f32x4*)(qgain + 64 + i0 + 4);
      float a[8], b[8];
#pragma unroll
      for (int j = 0; j < 8; ++j) { a[j] = b2f(qr[d0][j]) * rstd * (j < 4 ? ga0[j & 3] : ga1[j & 3]); b[j] = b2f(qr[d0 + 4][j]) * rstd * (j < 4 ? gb0[j & 3] : gb1[j & 3]); }
      if (rope_cs) {
        const float* cp = rope_cs + (long)(wid * QBLK + r32) * 64 + i0;
        const f32x4 c0 = *(const f32x4*)cp, c1 = *(const f32x4*)(cp + 4), s0 = *(const f32x4*)(cp + 2048 * 64), s1 = *(const f32x4*)(cp + 2048 * 64 + 4);
#pragma unroll
        for (int j = 0; j < 8; ++j) { const float c = j < 4 ? c0[j & 3] : c1[j & 3], s = j < 4 ? s0[j & 3] : s1[j & 3]; const float na = a[j] * c - b[j] * s, nb = b[j] * c + a[j] * s; a[j] = na; b[j] = nb; }
      }
      u32x4 wa = {cvtpk(a[0], a[1]), cvtpk(a[2], a[3]), cvtpk(a[4], a[5]), cvtpk(a[6], a[7])}, wb = {cvtpk(b[0], b[1]), cvtpk(b[2], b[3]), cvtpk(b[4], b[5]), cvtpk(b[6], b[7])};
      qr[d0] = *reinterpret_cast<bf16x8*>(&wa); qr[d0 + 4] = *reinterpret_cast<bf16x8*>(&wb);
    }
  }
  const int sr = tid >> 4, sc = (tid & 15) * 8, vst0 = v_st(sr, sc), vst1 = v_st(32 + sr, sc);
  const int vb0 = (int)(uintptr_t)V_lds + v_rd_base(lane);
  struct { bf16x8 vs0, vs1, ks0, ks1; } sr_[SDEPTH];
#define SLOAD(i, tile) do { const int tl_ = (tile); const bf16_t* kp_ = tl_ < n0 ? K0 + (long)tl_ * KVBLK * ldk : K1 + (long)(tl_ - n0) * KVBLK * ldk; \
    const bf16_t* vp_ = tl_ < n0 ? V0 + (long)tl_ * KVBLK * ldv : V1 + (long)(tl_ - n0) * KVBLK * ldv; \
    sr_[i].vs0 = ld8(vp_ + (long)sr * ldv + sc); sr_[i].vs1 = ld8(vp_ + (long)(32 + sr) * ldv + sc); \
    sr_[i].ks0 = ld8(kp_ + (long)sr * ldk + sc); sr_[i].ks1 = ld8(kp_ + (long)(32 + sr) * ldk + sc); } while (0)
#define SWRITE(b, i) do { *(bf16x8*)((char*)V_lds + (b) * SHM_V + vst0) = sr_[i].vs0;          \
    *(bf16x8*)((char*)V_lds + (b) * SHM_V + vst1) = sr_[i].vs1; int kc = sc * 2;               \
    *(bf16x8*)((char*)K_lds + (b) * SHM_K + KSWZ(sr, kc)) = sr_[i].ks0;                       \
    *(bf16x8*)((char*)K_lds + (b) * SHM_K + KSWZ(32 + sr, kc)) = sr_[i].ks1; } while (0)
#define SWAIT() asm volatile("s_waitcnt vmcnt(4)" ::: "memory")
#define RESC(a) do { if (__any((a) < 1.f)) { if (hi == 0) al_l[r32] = (a); asm volatile("s_waitcnt lgkmcnt(0)" ::: "memory"); \
    for (int d = 0; d < 4; ++d) for (int r = 0; r < 16; ++r) o[d][r] *= al_l[crow(r, hi)]; } } while (0)
  f32x16 pA0, pA1, pB0, pB1; float mnA, mnB, alA, alB; bf16x8 pa0, pa1, pa2, pa3;
  constexpr int SE = 0, SO = SDEPTH - 1;
  SLOAD(SE, 0); asm volatile("s_waitcnt vmcnt(0)" ::: "memory"); SWRITE(0, SE); __syncthreads();
  qkt(pA0, pA1, K_lds, qr, r32, hi); partialSM(pA0, pA1, m_reg, mnA, alA);
  SLOAD(SO, 1); if (2 < NT) SLOAD(SE, 2);
  SWAIT(); SWRITE(1, SO); __syncthreads();
  for (int j = 1; j + 1 < NT; j += 2) {
    SBAR(); qkt(pB0, pB1, (bf16_t*)((char*)K_lds + SHM_K), qr, r32, hi);
    finishSM(pA0, pA1, alA, l_reg, pa0, pa1, pa2, pa3); SBAR();
    SLOAD(SO, j + SDEPTH); SBAR();
    pv_d0(o, vb0, pa0, pa1, pa2, pa3); partialSM(pB0, pB1, m_reg, mnB, alB);
    __syncthreads(); SWAIT(); SWRITE(0, SE);
    RESC(alB); __syncthreads();
    SBAR(); qkt(pA0, pA1, K_lds, qr, r32, hi);
    finishSM(pB0, pB1, alB, l_reg, pa0, pa1, pa2, pa3); SBAR();
    if (j + 3 < NT) SLOAD(SE, j + 1 + SDEPTH); SBAR();
    pv_d0(o, vb0 + (int)SHM_V, pa0, pa1, pa2, pa3); partialSM(pA0, pA1, m_reg, mnA, alA);
    __syncthreads(); SWAIT(); SWRITE(1, SO);
    RESC(alA); __syncthreads();
  }
  SBAR(); qkt(pB0, pB1, (bf16_t*)((char*)K_lds + SHM_K), qr, r32, hi);
  finishSM(pA0, pA1, alA, l_reg, pa0, pa1, pa2, pa3); SBAR();
  pv_d0(o, vb0, pa0, pa1, pa2, pa3); partialSM(pB0, pB1, m_reg, mnB, alB);
  __syncthreads(); RESC(alB);
  finishSM(pB0, pB1, alB, l_reg, pa0, pa1, pa2, pa3); SBAR();
  pv_d0(o, vb0 + (int)SHM_V, pa0, pa1, pa2, pa3);
  if (hi == 0) li_l[r32] = l_reg; asm volatile("s_waitcnt lgkmcnt(0)" ::: "memory");
  float rli[16];
#pragma unroll
  for (int r = 0; r < 16; ++r) rli[r] = __builtin_amdgcn_rcpf(li_l[crow(r, hi)]);
  bf16_t* Ow = Ob + (long)(wid * QBLK) * ldo;
  {
    char* stg = lds + SHM_ATTN + wid * 8704;
#pragma unroll
    for (int r = 0; r < 16; ++r) { const int orow = crow(r, hi);
#pragma unroll
      for (int d0 = 0; d0 < 4; ++d0) *(bf16_t*)(stg + orow * 272 + (d0 * 32 + r32) * 2) = (bf16_t)(cvtpk(o[d0][r] * rli[r], 0.f) & 0xffffu); }
    asm volatile("s_waitcnt lgkmcnt(0)" ::: "memory");
#pragma unroll
    for (int i = 0; i < 8; ++i) { const int row = i * 4 + (lane >> 4), ch = lane & 15; const u32x4 v = *(const u32x4*)(stg + row * 272 + ch * 16); *(u32x4*)(Ow + (long)row * ldo + ch * 8) = v; }
  }
#undef SLOAD
#undef SWRITE
#undef SWAIT
#undef RESC
  __syncthreads();
}
#undef KSWZ
#undef SBAR
}

constexpr int NWAVES = 8;
constexpr int DM = 2048, NB = 8, SEQ = 2048, DEPTH = 4, CTXL = 256, DBR = 1024, DFF = 5632;
constexpr int ML = NB * SEQ, MC = NB * CTXL, MT = ML + MC;
constexpr int LDY = 4608, YQ = 0, YK = 1024, YV = 1280, YUX = 1536, YUG = 2560, YUF = 3584;
constexpr int LDG = 6144;
constexpr float NEPS = 1e-6f;
constexpr size_t MiB = 1u << 20;
constexpr size_t WS_CTL = 0, CTL_ZERO_BYTES = 1 * MiB;
constexpr size_t WS_MOD = 1 * MiB, WS_ROPE = 3 * MiB, WS_WLT = 4 * MiB, WS_CST = 6 * MiB, WS_SPT = 6 * MiB + 131072, WS_DFTC = 7 * MiB, WS_DFTL = 8 * MiB, WS_TW = 9 * MiB;
constexpr size_t WS_W = 24 * MiB, W_LAYER = 128 * MiB, WO_W1 = 0, WO_W8 = (size_t)4608 * 2048 * 2  , WO_WB = 42 * MiB, WO_WO = 54 * MiB, WO_WFI = 62 * MiB, WO_WFO = 106 * MiB;
constexpr size_t WS_X = 536 * MiB, WS_H = 680 * MiB, WS_Y1 = 752 * MiB, WS_G = 914 * MiB, WS_ACT = WS_G, WS_KN = 1130 * MiB;
constexpr size_t WS_PTL = 1139 * MiB, WS_BRS = WS_PTL, WS_PTC = 1203 * MiB, WS_ATT = 1211 * MiB, WS_REC = 1247 * MiB, WS_FOU = 1283 * MiB, WS_MG = 1319 * MiB, WS_SLAB = 1391 * MiB, WS_WBR = 1455 * MiB, WS_END = 1471 * MiB;
static_assert((size_t)MT * DBR * 2 == 36 * MiB && (size_t)MT * LDY * 2 == 162 * MiB && (size_t)MT * LDG * 2 == 216 * MiB && (size_t)MT * DM * 4 == 144 * MiB, "ws map");
constexpr int CMAX_L = 6144 + 4608;
constexpr size_t WO_UF8 = (size_t)1280 * 2048;
constexpr size_t WS_CMAX = 256 * 1024  , WS_SH = 512 * 1024  ;
constexpr size_t WS_H8 = WS_MG;
constexpr int CW_BAR = 4096;
constexpr int RING_BYTES = 147456;
constexpr int LDSCTL_OFF = RING_BYTES, MISC_OFF = LDSCTL_OFF + 320;
constexpr int LDS_BYTES = RING_BYTES + 1024;

#define GAS __attribute__((address_space(1)))
#define LAS __attribute__((address_space(3)))
typedef unsigned short bf16;
typedef unsigned v4u __attribute__((ext_vector_type(4)));
typedef float f32x4 __attribute__((ext_vector_type(4)));
typedef short bf16x8 __attribute__((ext_vector_type(8)));
typedef GAS unsigned gu32;
typedef GAS unsigned long long gu64;
#define RLX_AGENT __ATOMIC_RELAXED, __HIP_MEMORY_SCOPE_AGENT
#define LDS_WAIT() asm volatile("s_waitcnt lgkmcnt(0)" ::: "memory")
#define VM_WAIT() asm volatile("s_waitcnt vmcnt(0)" ::: "memory")
__device__ __forceinline__ unsigned long long rt() { return __builtin_amdgcn_s_memrealtime(); }
__device__ __forceinline__ unsigned f2bf(float f) { unsigned u = __builtin_bit_cast(unsigned, f); return (u + 0x7fffu + ((u >> 16) & 1u)) >> 16; }
__device__ __forceinline__ unsigned pk2(float lo, float hi) { return f2bf(lo) | (f2bf(hi) << 16); }

#define XB_TMO      128
#define XB_XCNT(j)  (256  + 64 * (j))
#define XB_XSUB(j)  (1280 + 64 * (j))
#define XB_XGEN(j)  (2304 + 64 * (j))
#define XB_TOP      3328
#define XB_TOPGEN   3392
#define XCD_BAR_WORDS 3456
#define XB_SPIN_CAP (1u << 18)

__device__ __forceinline__ unsigned xb_ld(unsigned* p)              { return __hip_atomic_load(p, __ATOMIC_RELAXED, __HIP_MEMORY_SCOPE_AGENT); }
__device__ __forceinline__ unsigned xb_add(unsigned* p, unsigned v) { return __hip_atomic_fetch_add(p, v, __ATOMIC_RELAXED, __HIP_MEMORY_SCOPE_AGENT); }
__device__ __forceinline__ unsigned xb_xcc_id() { return (unsigned)__builtin_amdgcn_s_getreg((3 << 11) | 20) & 0xFu; }
#define XB_SPIN(cond, bar) do { unsigned _sp = 0; while (cond) { __builtin_amdgcn_s_sleep(1); \
    if ((++_sp & 255u) == 0u) { if (xb_ld(&(bar)[XB_TMO])) break; if (_sp > XB_SPIN_CAP) { atomicAdd(&(bar)[XB_TMO], 1u); break; } } } } while (0)

struct XcdBarrier {
    unsigned* bar; unsigned x;
    volatile LAS unsigned* st;
};

__device__ __forceinline__ XcdBarrier xcd_barrier_post(unsigned* bar, volatile LAS unsigned* st) {
    XcdBarrier b; b.bar = bar; b.x = xb_xcc_id(); b.st = st;
    if (threadIdx.x == 0) (void)xb_add(&bar[XB_XCNT(b.x)], 1u);
    return b;
}
__device__ __forceinline__ void xcd_barrier_complete(unsigned* bar, unsigned x, unsigned& nloc, unsigned& nx) {
    const unsigned G = gridDim.x * gridDim.y * gridDim.z;
    unsigned sum, cnt, mine, sp = 0u;
    for (;;) {
        sum = 0u; cnt = 0u; mine = 0u;
#pragma unroll
        for (unsigned j = 0; j < 16; ++j) { const unsigned c = xb_ld(&bar[XB_XCNT(j)]); sum += c; cnt += (c > 0u) ? 1u : 0u; mine = (j == x) ? c : mine; }
        if (sum == G) break;
        __builtin_amdgcn_s_sleep(1);
        if ((++sp & 255u) == 0u) { if (xb_ld(&bar[XB_TMO])) break; if (sp > XB_SPIN_CAP) { atomicAdd(&bar[XB_TMO], 1u); break; } }
    }
    nloc = mine > 0u ? mine : 1u; nx = cnt > 0u ? cnt : 1u;
}

__device__ __forceinline__ void xcd_barrier(const XcdBarrier& b, const bool is_thread0) {
    asm volatile("s_waitcnt vmcnt(0)" ::: "memory");
    __syncthreads();
    if (is_thread0) {
        unsigned* bar = b.bar;
        __builtin_amdgcn_s_waitcnt(0);
        unsigned nloc = b.st[0], nx = b.st[1];
        if (nloc == 0u) { xcd_barrier_complete(bar, b.x, nloc, nx); b.st[0] = nloc; b.st[1] = nx; }
        const unsigned old = xb_add(&bar[XB_XSUB(b.x)], 1u);
        const unsigned gen = old / nloc;
        if (old + 1u == (gen + 1u) * nloc) {
            __builtin_amdgcn_fence(__ATOMIC_RELEASE, "agent");
            asm volatile("s_waitcnt vmcnt(0)" ::: "memory");
            const unsigned og = xb_add(&bar[XB_TOP], 1u);
            const unsigned tg = og / nx;
            if (og + 1u == (tg + 1u) * nx) xb_add(&bar[XB_TOPGEN], 1u);
            else XB_SPIN(xb_ld(&bar[XB_TOPGEN]) == tg, bar);
            __builtin_amdgcn_fence(__ATOMIC_ACQUIRE, "agent");
            xb_add(&bar[XB_XGEN(b.x)], 1u);
            asm volatile("s_waitcnt vmcnt(0)" ::: "memory");
        } else {
            XB_SPIN(xb_ld(&bar[XB_XGEN(b.x)]) == gen, bar);
            __builtin_amdgcn_fence(__ATOMIC_ACQUIRE, "agent");
            asm volatile("s_waitcnt vmcnt(0)" ::: "memory");
        }
    }
    __syncthreads();
}

using pg8::bf2f; using pg8::cvt_pk_bf16; using pg8::sigm; using pg8::bflo; using pg8::bfhi;
typedef float f32x16 __attribute__((ext_vector_type(16)));
typedef unsigned u32x2 __attribute__((ext_vector_type(2)));
__device__ __forceinline__ float dpp_f(float v, const int ctrl_sel) {
    const int x = __builtin_bit_cast(int, v); int r;
    if (ctrl_sel == 0) r = __builtin_amdgcn_mov_dpp(x, 0xB1, 0xF, 0xF, false); else if (ctrl_sel == 1) r = __builtin_amdgcn_mov_dpp(x, 0x4E, 0xF, 0xF, false);
    else if (ctrl_sel == 2) r = __builtin_amdgcn_mov_dpp(x, 0x141, 0xF, 0xF, false); else r = __builtin_amdgcn_mov_dpp(x, 0x140, 0xF, 0xF, false);
    return __builtin_bit_cast(float, r);
}
__device__ __forceinline__ float wave_max(float v) {
    v = fmaxf(v, dpp_f(v, 0)); v = fmaxf(v, dpp_f(v, 1)); v = fmaxf(v, dpp_f(v, 2)); v = fmaxf(v, dpp_f(v, 3));
    const int x = __builtin_bit_cast(int, v);
    const float r0 = __builtin_bit_cast(float, __builtin_amdgcn_readlane(x, 0)), r1 = __builtin_bit_cast(float, __builtin_amdgcn_readlane(x, 16));
    const float r2 = __builtin_bit_cast(float, __builtin_amdgcn_readlane(x, 32)), r3 = __builtin_bit_cast(float, __builtin_amdgcn_readlane(x, 48));
    return fmaxf(fmaxf(r0, r1), fmaxf(r2, r3));
}
__device__ __forceinline__ unsigned pack_i8x4(float a, float b, float c, float d, float inv) {
    const unsigned fa = __float_as_uint(fmaf(a, inv, 12582912.0f)), fb = __float_as_uint(fmaf(b, inv, 12582912.0f)), fc = __float_as_uint(fmaf(c, inv, 12582912.0f)), fd = __float_as_uint(fmaf(d, inv, 12582912.0f));
    const unsigned p01 = __builtin_amdgcn_perm(fb, fa, 0x0c0c0400u), p23 = __builtin_amdgcn_perm(fd, fc, 0x0c0c0400u);
    return __builtin_amdgcn_perm(p23, p01, 0x05040100u);
}
__device__ __forceinline__ float wave_sum(float v) {
    v += dpp_f(v, 0); v += dpp_f(v, 1); v += dpp_f(v, 2); v += dpp_f(v, 3);
    const int x = __builtin_bit_cast(int, v);
    const float r0 = __builtin_bit_cast(float, __builtin_amdgcn_readlane(x, 0)), r1 = __builtin_bit_cast(float, __builtin_amdgcn_readlane(x, 16));
    const float r2 = __builtin_bit_cast(float, __builtin_amdgcn_readlane(x, 32)), r3 = __builtin_bit_cast(float, __builtin_amdgcn_readlane(x, 48));
    return (r0 + r1) + (r2 + r3);
}
__device__ __forceinline__ float silu_f(float x) { return x / (1.0f + __expf(-x)); }
__device__ __forceinline__ float gelu_tanh(float x) { return x * sigm(1.5957691216057308f * (x + 0.044715f * x * x * x)); }

struct Params {
    const float *x, *c, *ctx, *c_ctx, *w_mod, *b_mod, *g_norm1, *g_norm2, *w_in, *q_gain, *k_gain, *conv_w, *conv_b, *lru_w_r, *lru_b_r, *lru_w_i, *lru_b_i, *lru_lambda,
                *w_branch, *w_gate, *b_gate, *w_out, *w_ffn_in, *w_ffn_out, *g_final;
    float* out; unsigned char* ws; int ph_lo, ph_hi;
};
typedef const __attribute__((address_space(4))) Params* KP;
__device__ __forceinline__ KP fresh_kp() { KP p = (KP)__builtin_amdgcn_kernarg_segment_ptr(); asm volatile("" : "+s"(p)); return p; }

__device__ __forceinline__ void tr_item(const float* W, int ldn, bf16* WT, int ldk, int k0, int n0, int drow0, LAS float* scr, int lane, bool rev = false) {
#pragma unroll 8
    for (int i = 0; i < 32; ++i) { const int kk = 2 * i + (lane >> 5); const int ks = k0 + kk, sr = rev ? ((ks & ~127) | ((128 - (ks & 127)) & 127)) : ks;
        scr[kk * 33 + (lane & 31)] = W[(size_t)sr * ldn + n0 + (lane & 31)]; }
    LDS_WAIT(); asm volatile("" ::: "memory");
    const int c = lane & 7;
#pragma unroll
    for (int j = 0; j < 4; ++j) { const int n = (lane >> 3) + 8 * j; const LAS float* s = scr + (8 * c) * 33 + n;
        v4u o; o.x = pk2(s[0 * 33], s[1 * 33]); o.y = pk2(s[2 * 33], s[3 * 33]); o.z = pk2(s[4 * 33], s[5 * 33]); o.w = pk2(s[6 * 33], s[7 * 33]);
        *(v4u*)(WT + (size_t)(drow0 + n) * ldk + k0 + 8 * c) = o; }
    LDS_WAIT(); asm volatile("" ::: "memory");
}

__device__ __forceinline__ void p0_prologue(KP P, LAS unsigned char* lds, int tid, int lane, int wave, int vcu, int G, int dupA, int dupB, int dupC) {
    unsigned char* ws = P->ws;
    {
        LAS float* SC = (LAS float*)lds;
        LAS float* red = (LAS float*)(lds + 73728);
        for (int i = tid; i < 9 * 2048; i += 512) { const int r = i >> 11, k = i & 2047; const float v = r < 8 ? P->c[r * 2048 + k] : P->c_ctx[k]; SC[i] = silu_f(v); }
        __syncthreads();
        float* MOD = (float*)(ws + WS_MOD);
        for (int unit_ = vcu; unit_ < 4 * 192 * dupA; unit_ += G) { const int unit = unit_ % 768;
            const int l = unit / 192, n0 = (unit % 192) * 64;
            const float* wp = P->w_mod + ((size_t)l * 2048 + wave * 256) * 12288 + n0 + lane;
            float acc[9];
#pragma unroll
            for (int r = 0; r < 9; ++r) acc[r] = 0.f;
            for (int k8 = 0; k8 < 256; k8 += 32) {
                float wv[32];
#pragma unroll
                for (int j = 0; j < 32; ++j) wv[j] = wp[(size_t)(k8 + j) * 12288];
#pragma unroll
                for (int j = 0; j < 32; ++j)
#pragma unroll
                    for (int r = 0; r < 9; ++r) acc[r] += SC[r * 2048 + wave * 256 + k8 + j] * wv[j];
            }
#pragma unroll
            for (int r = 0; r < 9; ++r) red[(wave * 9 + r) * 64 + lane] = acc[r];
            __syncthreads();
            for (int i = tid; i < 9 * 64; i += 512) { const int r = i >> 6, ln = i & 63; float s = 0.f;
#pragma unroll
                for (int w = 0; w < 8; ++w) s += red[(w * 9 + r) * 64 + ln];
                MOD[((size_t)l * 9 + r) * 12288 + n0 + ln] = s + P->b_mod[l * 12288 + n0 + ln]; }
            __syncthreads();
        }
    }
    {
        LAS float* scr = (LAS float*)(lds + wave * 16384);
        const int gw = vcu * NWAVES + wave, NGW = G * NWAVES;
        constexpr int PER_L = 32768 + 1024, NIT = 4 * PER_L + 512;
        for (int it_ = gw; it_ < NIT * dupB; it_ += NGW) { const int it = it_ % NIT;
            if (it < 4 * PER_L) {
                const int l = it / PER_L; int r = it % PER_L;
                unsigned char* wl = ws + WS_W + (size_t)l * W_LAYER;
                if (r < 4608) { const int kb = r / 144, nb = r % 144; if (nb < 40 || nb >= 112) continue;
                    tr_item(P->w_in + (size_t)l * 2048 * 4608, 4608, (bf16*)(wl + WO_W1), 2048, kb * 64, nb * 32, nb * 32, scr, lane); continue; } r -= 4608;
                if (r < 6144) { const int kb = r / 192, nb = r % 192; continue; }        r -= 6144;
                if (r < 3072) { const int br = r / 1024, rr = r % 1024, kb = rr / 64, nb = rr % 64;
                    tr_item(P->w_branch + ((size_t)l * 3 + br) * 1024 * 2048, 2048, (bf16*)(wl + WO_WB) + (size_t)br * 2048 * 1024, 1024, kb * 64, nb * 32, nb * 32, scr, lane); continue; } r -= 3072;
                if (r < 2048) { const int kb = r / 64, nb = r % 64; tr_item(P->w_out + (size_t)l * 2048 * 2048, 2048, (bf16*)(wl + WO_WO), 2048, kb * 64, nb * 32, nb * 32, scr, lane); continue; } r -= 2048;
                if (r < 11264) { const int kb = r / 352, nb = r % 352, n0 = nb * 32, half = n0 / 5632, j = n0 % 5632, pn = j / 128, jj = j % 128;
                    tr_item(P->w_ffn_in + (size_t)l * 2048 * 11264, 11264, (bf16*)(wl + WO_WFI), 2048, kb * 64, n0, pn * 256 + half * 128 + jj, scr, lane); continue; } r -= 11264;
                if (r < 5632) { const int kb = r / 64, nb = r % 64; tr_item(P->w_ffn_out + (size_t)l * 5632 * 2048, 2048, (bf16*)(wl + WO_WFO), 5632, kb * 64, nb * 32, nb * 32, scr, lane); continue; } r -= 5632;
                { const int kb = r / 64, nb = r % 64; tr_item(P->w_branch + ((size_t)l * 3 + 2) * 1024 * 2048, 2048, (bf16*)(ws + WS_WBR + (size_t)l * 4 * MiB), 1024, kb * 64, nb * 32, nb * 32, scr, lane, true); }
            } else {
                const int r = it - 4 * PER_L, mat = r >> 1, nb = r & 1, gate = mat & 1, ldn = mat >> 1;
                const float* W = (gate ? P->lru_w_i : P->lru_w_r) + (size_t)ldn * 4096;
                tr_item(W, 64, (bf16*)(ws + WS_WLT) + (size_t)mat * 4096, 64, 0, nb * 32, nb * 32, scr, lane);
            }
        }
    }
    {
        __syncthreads();
        LAS float* scr = (LAS float*)(lds + wave * 16384);
        LAS float* red = (LAS float*)(lds + 131072);
        unsigned* CM = (unsigned*)(ws + WS_CMAX);
        const int c = lane & 15, rg = lane >> 4;
        for (int it = vcu; it < 4 * (384 + 80 + 64); it += G) {
            const int l = it / 528, r = it % 528; const bool gatew = r < 384, ufw = r >= 464; const int n0 = gatew ? r * 16 : (ufw ? 3584 + (r - 464) * 16 : (r - 384) * 16);
            const int nd = ufw ? (r - 464) * 16 : n0;
            const float* W = gatew ? P->w_gate + (size_t)l * 2048 * 6144 : P->w_in + (size_t)l * 2048 * 4608; const int ldn = gatew ? 6144 : 4608;
            unsigned char* W8 = ws + WS_W + (size_t)l * W_LAYER + (gatew ? WO_W8 : (ufw ? WO_W1 + WO_UF8 : WO_W1));
            const int cidx = l * CMAX_L + (gatew ? 0 : 6144) + n0;
            float r_[64];
#pragma unroll
            for (int i = 0; i < 64; ++i) r_[i] = W[(size_t)(wave * 256 + 4 * i + rg) * ldn + n0 + c];
            float mx = 0.f;
#pragma unroll
            for (int i = 0; i < 64; ++i) mx = fmaxf(mx, fabsf(r_[i]));
            red[wave * 64 + lane] = mx;
            __syncthreads();
            float m = 0.f;
#pragma unroll
            for (int w = 0; w < 8; ++w)
#pragma unroll
                for (int g4 = 0; g4 < 4; ++g4) m = fmaxf(m, red[w * 64 + g4 * 16 + c]);
            m = fmaxf(m, 1e-30f); const float inv = 127.0f / m;
            if (wave == 0 && rg == 0) CM[cidx + c] = __float_as_uint(m);
#pragma unroll
            for (int h = 0; h < 2; ++h) {
#pragma unroll
                for (int i = 0; i < 32; ++i) scr[(4 * i + rg) * 17 + c] = r_[32 * h + i];
                LDS_WAIT(); asm volatile("" ::: "memory");
                const LAS float* sp = scr + (32 * rg) * 17 + c;
                v4u o0, o1;
                o0.x = pack_i8x4(sp[0 * 17], sp[1 * 17], sp[2 * 17], sp[3 * 17], inv); o0.y = pack_i8x4(sp[4 * 17], sp[5 * 17], sp[6 * 17], sp[7 * 17], inv);
                o0.z = pack_i8x4(sp[8 * 17], sp[9 * 17], sp[10 * 17], sp[11 * 17], inv); o0.w = pack_i8x4(sp[12 * 17], sp[13 * 17], sp[14 * 17], sp[15 * 17], inv);
                o1.x = pack_i8x4(sp[16 * 17], sp[17 * 17], sp[18 * 17], sp[19 * 17], inv); o1.y = pack_i8x4(sp[20 * 17], sp[21 * 17], sp[22 * 17], sp[23 * 17], inv);
                o1.z = pack_i8x4(sp[24 * 17], sp[25 * 17], sp[26 * 17], sp[27 * 17], inv); o1.w = pack_i8x4(sp[28 * 17], sp[29 * 17], sp[30 * 17], sp[31 * 17], inv);
                unsigned char* dp = W8 + (size_t)(nd + c) * 2048 + wave * 256 + 128 * h + 32 * rg;
                *(v4u*)dp = o0; *(v4u*)(dp + 16) = o1;
                LDS_WAIT(); asm volatile("" ::: "memory");
            }
            __syncthreads();
        }
    }
    {
        const int gid = vcu * 512 + tid, NT = G * 512;
        float* ROPE = (float*)(ws + WS_ROPE);
        for (int i = gid; i < 2048 * 64; i += NT) { const int t = i >> 6, j = i & 63; const float pos = (float)(j < 32 ? (t >> 6) : (t & 63));
            const float inv = exp2f(-(float)(j & 31) * (13.287712379549449f / 32.0f)); const float ang = pos * inv; ROPE[i] = cosf(ang); ROPE[2048 * 64 + i] = sinf(ang); }
        float* SPT = (float*)(ws + WS_SPT);
        for (int i = gid; i < 4 * 2 * 1024; i += NT) SPT[i] = 8.0f * 1.4426950408889634f * log1pf(__expf(-P->lru_lambda[i]));
        bf16* CST = (bf16*)(ws + WS_CST);
        for (int i = gid; i < 256 * 128; i += NT) { const int col = i >> 7, cc = i & 127, s = col >> 7, m = col & 127; const float a = (float)((m * cc) & 127) * (2.0f / 128.0f);
            CST[i] = (bf16)f2bf(s ? sinpif(a) : cospif(a)); }
        bf16* DFTC = (bf16*)(ws + WS_DFTC);
        for (int i = gid; i < 256 * 512; i += NT) { const int k = i >> 9, cc = i & 511, s = cc >> 8, t = cc & 255; const float a = (float)((k * t) & 255) * (2.0f / 256.0f);
            DFTC[i] = (bf16)f2bf(s ? -sinpif(a) : cospif(a)); }
        bf16* DFTN = (bf16*)(ws + WS_DFTL);
        for (int i_ = gid; i_ < 256 * 1024 * dupC; i_ += NT) { const int i = i_ & (256 * 1024 - 1); const int k2 = i >> 10, cc = i & 1023, s = cc >> 9, t2 = cc & 511; const float a = (float)((k2 * t2) & 511) * (2.0f / 512.0f);
            DFTN[i] = (bf16)f2bf(s ? sinpif(a) : cospif(a)); }
        float* TW = (float*)(ws + WS_TW);
        for (int i = gid; i < 3 * 512; i += NT) { const int k1 = i / 512 + 1, t2 = i % 512; const float a = (float)(k1 * t2) * (2.0f / 2048.0f); TW[2 * i] = cospif(a); TW[2 * i + 1] = sinpif(a); }
    }
}

__device__ __forceinline__ void norm_rows(KP P, int l, int which, int nrows, bool slab, int lane, int wave, int vcu, int G, int dup) {
    unsigned char* ws = P->ws; bf16* X = (bf16*)(ws + WS_X); bf16* H = (bf16*)(ws + WS_H); const float* MOD = (const float*)(ws + WS_MOD);
    const float* gn = (which ? P->g_norm2 : P->g_norm1) + l * 2048;
    const bool first = (l == 0 && which == 0);
    const int gw = vcu * NWAVES + wave, NGW = G * NWAVES;
    f32x4 gq[8];
#pragma unroll
    for (int j = 0; j < 8; ++j) gq[j] = *(const f32x4*)(gn + ((j >> 1) * 64 + lane) * 8 + (j & 1) * 4);
    for (int m_ = gw; m_ < nrows * dup; m_ += NGW) { const int m = m_ % nrows;
        const int rsel = m < ML ? (m >> 11) : 8;
        const float* mv = MOD + ((size_t)l * 9 + rsel) * 12288 + (which ? 3 * 2048 : 0);
        f32x4 v[8], shq[8], scq[8]; float ss = 0.f;
        if (first) { const float* src = m < ML ? P->x + (size_t)m * DM : P->ctx + (size_t)(m - ML) * DM;
#pragma unroll
            for (int j = 0; j < 8; ++j) v[j] = *(const f32x4*)(src + ((j >> 1) * 64 + lane) * 8 + (j & 1) * 4);
        } else { const bf16* src = X + (size_t)m * DM;
            v4u xw[4];
#pragma unroll
            for (int jj = 0; jj < 4; ++jj) xw[jj] = *(const v4u*)(src + (jj * 64 + lane) * 8);
#pragma unroll
            for (int jj = 0; jj < 4; ++jj) { v[2 * jj] = (f32x4){bflo(xw[jj].x), bfhi(xw[jj].x), bflo(xw[jj].y), bfhi(xw[jj].y)}; v[2 * jj + 1] = (f32x4){bflo(xw[jj].z), bfhi(xw[jj].z), bflo(xw[jj].w), bfhi(xw[jj].w)}; }
        }
#pragma unroll
        for (int j = 0; j < 8; ++j) { const int col = ((j >> 1) * 64 + lane) * 8 + (j & 1) * 4; shq[j] = *(const f32x4*)(mv + col); scq[j] = *(const f32x4*)(mv + 2048 + col); }
        asm volatile("" ::: "memory");
#pragma unroll
        for (int j = 0; j < 8; ++j) ss += (v[j].x * v[j].x + v[j].y * v[j].y) + (v[j].z * v[j].z + v[j].w * v[j].w);
        const bool addslab = slab && m >= ML && m_ < nrows;
        if (addslab) { const float* SL = (const float*)(ws + WS_SLAB) + (size_t)(m - ML) * DM; ss = 0.f;
#pragma unroll
            for (int j = 0; j < 8; ++j) { const int col = ((j >> 1) * 64 + lane) * 8 + (j & 1) * 4;
                v[j] = (((v[j] + *(const f32x4*)(SL + col)) + *(const f32x4*)(SL + (size_t)2048 * 2048 + col)) + *(const f32x4*)(SL + (size_t)2 * 2048 * 2048 + col)) + *(const f32x4*)(SL + (size_t)3 * 2048 * 2048 + col);
                ss += (v[j].x * v[j].x + v[j].y * v[j].y) + (v[j].z * v[j].z + v[j].w * v[j].w); } }
        const float rstd = 1.0f / sqrtf(wave_sum(ss) * (1.0f / DM) + NEPS);
        f32x4 oq[8]; float amax = 0.f;
#pragma unroll
        for (int jj = 0; jj < 4; ++jj) { const int col = (jj * 64 + lane) * 8;
            if (first || addslab) { v4u xo; xo.x = cvt_pk_bf16(v[2 * jj].x, v[2 * jj].y); xo.y = cvt_pk_bf16(v[2 * jj].z, v[2 * jj].w); xo.z = cvt_pk_bf16(v[2 * jj + 1].x, v[2 * jj + 1].y); xo.w = cvt_pk_bf16(v[2 * jj + 1].z, v[2 * jj + 1].w);
                *(v4u*)(X + (size_t)m * DM + col) = xo; }
            const f32x4 o0 = v[2 * jj] * rstd * gq[2 * jj] * (scq[2 * jj] + 1.0f) + shq[2 * jj], o1 = v[2 * jj + 1] * rstd * gq[2 * jj + 1] * (scq[2 * jj + 1] + 1.0f) + shq[2 * jj + 1];
            v4u w; w.x = cvt_pk_bf16(o0.x, o0.y); w.y = cvt_pk_bf16(o0.z, o0.w); w.z = cvt_pk_bf16(o1.x, o1.y); w.w = cvt_pk_bf16(o1.z, o1.w);
            *(v4u*)(H + (size_t)m * DM + col) = w;
            oq[2 * jj] = o0; oq[2 * jj + 1] = o1;
            amax = fmaxf(amax, fmaxf(fmaxf(fmaxf(fabsf(o0.x), fabsf(o0.y)), fmaxf(fabsf(o0.z), fabsf(o0.w))), fmaxf(fmaxf(fabsf(o1.x), fabsf(o1.y)), fmaxf(fabsf(o1.z), fabsf(o1.w))))); }
        if (!which) {
            const float rmax = fmaxf(wave_max(amax), 1e-20f); const float inv = 127.0f / rmax;
#pragma unroll
            for (int jj = 0; jj < 4; ++jj) { u32x2 w8; w8.x = pack_i8x4(oq[2 * jj].x, oq[2 * jj].y, oq[2 * jj].z, oq[2 * jj].w, inv); w8.y = pack_i8x4(oq[2 * jj + 1].x, oq[2 * jj + 1].y, oq[2 * jj + 1].z, oq[2 * jj + 1].w, inv);
                *(u32x2*)(ws + WS_H8 + (size_t)m * DM + (jj * 64 + lane) * 8) = w8; }
            if (lane == 0) ((float*)(ws + WS_SH))[m] = rmax * (1.0f / 127.0f);
        }
    }
}
__device__ __forceinline__ void final_norm(KP P, int lane, int wave, int vcu, int G) {
    const bf16* X = (const bf16*)(P->ws + WS_X);
    const int gw = vcu * NWAVES + wave, NGW = G * NWAVES;
    for (int m = gw; m < ML; m += NGW) {
        const bf16* src = X + (size_t)m * DM; f32x4 v[8]; float ss = 0.f;
#pragma unroll
        for (int jj = 0; jj < 4; ++jj) { const v4u xw = *(const v4u*)(src + (jj * 64 + lane) * 8);
            v[2 * jj] = (f32x4){bflo(xw.x), bfhi(xw.x), bflo(xw.y), bfhi(xw.y)}; v[2 * jj + 1] = (f32x4){bflo(xw.z), bfhi(xw.z), bflo(xw.w), bfhi(xw.w)}; }
#pragma unroll
        for (int j = 0; j < 8; ++j) ss += (v[j].x * v[j].x + v[j].y * v[j].y) + (v[j].z * v[j].z + v[j].w * v[j].w);
        const float rstd = 1.0f / sqrtf(wave_sum(ss) * (1.0f / DM) + NEPS);
#pragma unroll
        for (int j = 0; j < 8; ++j) { const int col = ((j >> 1) * 64 + lane) * 8 + (j & 1) * 4; *(f32x4*)(P->out + (size_t)m * DM + col) = v[j] * rstd * *(const f32x4*)(P->g_final + col); }
    }
}

__device__ __forceinline__ void f1_units(KP P, bool last, LAS unsigned char* lds, int tid, int lane, int wave, int vcu, int G, int dup) {
    unsigned char* ws = P->ws; const bf16* Y1 = (const bf16*)(ws + WS_Y1); bf16* PTN = (bf16*)(ws + WS_PTL); bf16* PTC = (bf16*)(ws + WS_PTC);
    { const v4u* src = (const v4u*)(ws + WS_CST);
      for (int i = tid; i < 256 * 16; i += 512) { const int row = i >> 4, ch = i & 15; v4u t_ = src[i]; asm volatile("" : "+v"(t_)); *(LAS v4u*)(lds + row * 272 + ch * 16) = t_; } }
    __syncthreads();
    const int r = lane & 31, h = lane >> 5;
    const int gw = vcu * NWAVES + wave, NGW = G * NWAVES;
    const float* TW = (const float*)(ws + WS_TW);
    for (int wu_ = gw; wu_ < 4096 * dup; wu_ += NGW) {
        const int wu = wu_ & 4095; const int b = wu >> 9, tb = (wu >> 3) & 63, g = wu & 7;
        const bf16* ap = Y1 + (size_t)(b * 2048 + 512 * (r >> 3) + 8 * tb + (r & 7)) * LDY + YUF + g * 128 + h * 8;
        bf16x8 Af[8];
#pragma unroll
        for (int kk = 0; kk < 8; ++kk) Af[kk] = *(const bf16x8*)(ap + kk * 16);
        float twc[3][4], tws[3][4];
#pragma unroll
        for (int k1 = 0; k1 < 3; ++k1) { const f32x4 w0 = *(const f32x4*)(TW + 2 * (k1 * 512 + 8 * tb + 4 * h)), w1 = *(const f32x4*)(TW + 2 * (k1 * 512 + 8 * tb + 4 * h) + 4);
            twc[k1][0] = w0.x; tws[k1][0] = w0.y; twc[k1][1] = w0.z; tws[k1][1] = w0.w; twc[k1][2] = w1.x; tws[k1][2] = w1.y; twc[k1][3] = w1.z; tws[k1][3] = w1.w; }
#pragma unroll 1
        for (int cp = 0; cp < 4; ++cp) {
            f32x16 ac = {}, as = {};
#pragma unroll
            for (int kk = 0; kk < 8; ++kk) { const bf16x8 Bc = *(const LAS bf16x8*)(lds + (cp * 32 + r) * 272 + (kk * 16 + h * 8) * 2), Bs = *(const LAS bf16x8*)(lds + ((cp + 4) * 32 + r) * 272 + (kk * 16 + h * 8) * 2);
                ac = __builtin_amdgcn_mfma_f32_32x32x16_bf16(Af[kk], Bc, ac, 0, 0, 0); as = __builtin_amdgcn_mfma_f32_32x32x16_bf16(Af[kk], Bs, as, 0, 0, 0); }
            float ore[4][4], oim[4][4];
#pragma unroll
            for (int i = 0; i < 4; ++i) {
                const float z0r = ac[i], z1r = ac[4 + i], z2r = ac[8 + i], z3r = ac[12 + i], z0i = -as[i], z1i = -as[4 + i], z2i = -as[8 + i], z3i = -as[12 + i];
                const float ar = z0r + z2r, ai = z0i + z2i, br = z1r + z3r, bi = z1i + z3i, cr = z0r - z2r, ci = z0i - z2i, dr = z1r - z3r, di = z1i - z3i;
                ore[0][i] = ar + br; oim[0][i] = ai + bi;
                { const float wr = cr + di, wi = ci - dr; ore[1][i] = wr * twc[0][i] + wi * tws[0][i]; oim[1][i] = wi * twc[0][i] - wr * tws[0][i]; }
                { const float wr = ar - br, wi = ai - bi; ore[2][i] = wr * twc[1][i] + wi * tws[1][i]; oim[2][i] = wi * twc[1][i] - wr * tws[1][i]; }
                { const float wr = cr - di, wi = ci + dr; ore[3][i] = wr * twc[2][i] + wi * tws[2][i]; oim[3][i] = wi * twc[2][i] - wr * tws[2][i]; }
            }
            const int m = cp * 32 + r;
            bf16* dp = PTN + ((size_t)((b * 8 + g) * 128 + m)) * 1024 + 8 * tb + 4 * h;
#pragma unroll
            for (int k1 = 0; k1 < 4; ++k1) { u32x2 w; w.x = cvt_pk_bf16(ore[k1][0], ore[k1][1]); w.y = cvt_pk_bf16(ore[k1][2], ore[k1][3]); *(u32x2*)(dp + (size_t)k1 * 8192 * 1024) = w;
                u32x2 v; v.x = cvt_pk_bf16(oim[k1][0], oim[k1][1]); v.y = cvt_pk_bf16(oim[k1][2], oim[k1][3]); *(u32x2*)(dp + (size_t)k1 * 8192 * 1024 + 512) = v; }
        }
    }
    if (!last) {
    for (int wu_ = gw; wu_ < 512 * dup; wu_ += NGW) {
        const int wu = wu_ & 511; const int tt = 512 + (wu >> 3), g = wu & 7, m0 = tt * 32;
        const bf16* ap = Y1 + (size_t)(m0 + r) * LDY + YUF + g * 128 + h * 8;
        bf16x8 Af[8];
#pragma unroll
        for (int kk = 0; kk < 8; ++kk) Af[kk] = *(const bf16x8*)(ap + kk * 16);
        const int mc = m0 - ML, b = mc >> 8, t0 = mc & 255; bf16* base = PTC + (size_t)((b * 8 + g) * 128) * 512 + t0;
#pragma unroll 1
        for (int ct = 0; ct < 8; ++ct) {
            f32x16 acc = {};
#pragma unroll
            for (int kk = 0; kk < 8; ++kk) { const bf16x8 Bf = *(const LAS bf16x8*)(lds + (ct * 32 + r) * 272 + (kk * 16 + h * 8) * 2); acc = __builtin_amdgcn_mfma_f32_32x32x16_bf16(Af[kk], Bf, acc, 0, 0, 0); }
            const int s = ct >> 2, m = (ct & 3) * 32 + r;
            bf16* dp = base + (size_t)m * 512 + s * 256 + 4 * h;
#pragma unroll
            for (int q4 = 0; q4 < 4; ++q4) { u32x2 w; w.x = cvt_pk_bf16(acc[4 * q4], acc[4 * q4 + 1]); w.y = cvt_pk_bf16(acc[4 * q4 + 2], acc[4 * q4 + 3]); *(u32x2*)(dp + 8 * q4) = w; }
        }
    }
    }
}
__device__ __forceinline__ void knorm_units(KP P, int l, int lane, int wave, int vcu, int G, int dup) {
    unsigned char* ws = P->ws; const bf16* Y1 = (const bf16*)(ws + WS_Y1); bf16* KN = (bf16*)(ws + WS_KN); const float* ROPE = (const float*)(ws + WS_ROPE);
    const float g1 = P->k_gain[l * 128 + lane], g2 = P->k_gain[l * 128 + 64 + lane];
    const int gw = vcu * NWAVES + wave, NGW = G * NWAVES;
    for (int it0 = gw; it0 < MT * 2 * dup; it0 += 3 * NGW) {
        float k1[3], k2[3]; int mm[3], hh[3];
#pragma unroll
        for (int q = 0; q < 3; ++q) { const int it_ = it0 + q * NGW; const int it = (it_ < MT * 2 * dup ? it_ : gw) % (MT * 2); mm[q] = it >> 1; hh[q] = it & 1;
            const bf16* kp = Y1 + (size_t)mm[q] * LDY + YK + hh[q] * 128; k1[q] = bf2f(kp[lane]); k2[q] = bf2f(kp[64 + lane]); }
#pragma unroll
        for (int q = 0; q < 3; ++q) { if (it0 + q * NGW >= MT * 2 * dup) break;
            const int m = mm[q];
            const float rstd = 1.0f / sqrtf(wave_sum(k1[q] * k1[q] + k2[q] * k2[q]) * (1.0f / 128.0f) + NEPS);
            float a = k1[q] * rstd * g1, b = k2[q] * rstd * g2;
            if (m < ML) { const int t = m & 2047; const float c = ROPE[t * 64 + lane], s = ROPE[2048 * 64 + t * 64 + lane]; const float na = a * c - b * s, nb = b * c + a * s; a = na; b = nb; }
            bf16* op = KN + (size_t)m * 256 + hh[q] * 128;
            op[lane] = (bf16)(cvt_pk_bf16(a, 0.f) & 0xffffu); op[64 + lane] = (bf16)(cvt_pk_bf16(b, 0.f) & 0xffffu); }
    }
}
template <int D>
__device__ __forceinline__ void lru_sweep(const int b, const int nb, const int hc, LAS unsigned char* lds, const int lane, const int wave,
                                          const void* pY, const void* pR, const void* pF,
                                          const float cw0, const float cw1, const float cw2, const float cw3, const float cb, const float br, const float bi, const float sp) {
    const int j = lane & 31, hi = lane >> 5;
#define LRU_UNI(p_) ((void*)(((unsigned long long)(unsigned)__builtin_amdgcn_readfirstlane((int)(unsigned)((unsigned long long)(p_) >> 32)) << 32) | (unsigned long long)(unsigned)__builtin_amdgcn_readfirstlane((int)(unsigned)(unsigned long long)(p_))))
    const __amdgpu_buffer_rsrc_t rsY = __builtin_amdgcn_make_buffer_rsrc(LRU_UNI(pY), (short)0, (int)((size_t)MT * LDY * 2), 0x00020000);
    const __amdgpu_buffer_rsrc_t rsR = __builtin_amdgcn_make_buffer_rsrc(LRU_UNI(pR), (short)0, (int)((size_t)MT * 1024 * 2), 0x00020000);
    const __amdgpu_buffer_rsrc_t rsF = __builtin_amdgcn_make_buffer_rsrc(LRU_UNI(pF), (short)0, (int)((size_t)MT * 1024 * 2), 0x00020000);
#undef LRU_UNI
    LAS bf16* uS = (LAS bf16*)(lds + wave * 4608);
    LAS unsigned char* BL = lds + 36864;
    typedef float f32x2 __attribute__((ext_vector_type(2)));
    LAS f32x2* SUMS = (LAS f32x2*)(lds + 55296);
    const int chin = nb * 64 + lane, cho = nb * 64 + hc * 32 + j;
    constexpr float L2E = 1.4426950408889634f;
    const int arow = ((j >> 2) & 1) * 16 + (j & 3) + 4 * (j >> 3);
    const int voX = (YUX + chin) * 2, voG = (hi * 16 * LDY + YUG + cho) * 2, voR = (hi * 16 * 1024 + cho) * 2, voF = (hi * 16 * 1024 + cho) * 2;
#define LRU_GEOM(s_) const int q_ = (s_) * 8 + wave; const bool isc_ = q_ < 8; const int rowbase = isc_ ? ML + b * 256 : b * 2048, Lq = isc_ ? 256 : 2048, T0 = isc_ ? 32 * q_ : 32 * (q_ - 8)
#define LRU_ROWOFF(row_) ({ int rr_ = (row_); rr_ = rr_ < 0 ? 0 : (rr_ > MT - 1 ? MT - 1 : rr_); __builtin_amdgcn_readfirstlane(rr_ * (LDY * 2)); })
#define LRU_XLOAD(dst, s_) do { LRU_GEOM(s_); const int r0_ = rowbase + T0 - 2; \
        _Pragma("unroll") for (int i = 0; i < 35; ++i) dst[i] = __builtin_amdgcn_raw_buffer_load_b16(rsY, voX, LRU_ROWOFF(r0_ + i), 0); } while (0)
#define LRU_STEP(si_) (D == 0 ? (si_) : ((si_) == 0 ? 0 : 9 - (si_)))
    unsigned short xr[35];
    LRU_XLOAD(xr, LRU_STEP(0));
    float cstep = 0.f; int buf = 0;
#pragma unroll 1
    for (int si = 0; si < 9; ++si) {
        const int step = LRU_STEP(si);
        LRU_GEOM(step);
        {
          float xin[35];
#pragma unroll
          for (int i = 0; i < 35; ++i) { const int t = T0 - 2 + i; xin[i] = (t >= 0 && t < Lq) ? bf2f(xr[i]) : 0.f; }
#pragma unroll
          for (int i = 0; i < 32; ++i) uS[i * 72 + lane] = (bf16)(cvt_pk_bf16(cb + cw0 * xin[i] + cw1 * xin[i + 1] + cw2 * xin[i + 2] + cw3 * xin[i + 3], 0.f) & 0xffffu); }
        if (si < 8) { LRU_XLOAD(xr, LRU_STEP(si + 1)); }
        unsigned short hfv[16]; unsigned short ugr[16];
        if (D == 1) { const int r0 = rowbase + T0;
#pragma unroll
            for (int r = 0; r < 16; ++r) hfv[r] = __builtin_amdgcn_raw_buffer_load_b16(rsF, voF, __builtin_amdgcn_readfirstlane((r0 + r) * 2048), 0);
#pragma unroll
            for (int r = 0; r < 16; ++r) ugr[r] = __builtin_amdgcn_raw_buffer_load_b16(rsY, voG, __builtin_amdgcn_readfirstlane((r0 + r) * (LDY * 2)), 0); }
        asm volatile("" ::: "memory");
        LDS_WAIT(); asm volatile("" ::: "memory");
        f32x16 acc[2];
#pragma unroll
        for (int tl = 0; tl < 2; ++tl) acc[tl] = (f32x16){};
#pragma unroll
        for (int kk = 0; kk < 4; ++kk) {
            const bf16x8 Af = *(const LAS bf16x8*)(uS + arow * 72 + kk * 16 + hi * 8);
#pragma unroll
            for (int tl = 0; tl < 2; ++tl) acc[tl] = __builtin_amdgcn_mfma_f32_32x32x16_bf16(Af, *(const LAS bf16x8*)(BL + ((2 * D + tl) * 32 + j) * 144 + (kk * 16 + hi * 8) * 2), acc[tl], 0, 0, 0);
        }
        float yl[16], cp[16];
#define LRU_GATES(r0_, r1_, a0_, a1_, x0_, x1_) \
            const f32x2 u_ = {bf2f(uS[(hi * 16 + (r0_)) * 72 + hc * 32 + j]), bf2f(uS[(hi * 16 + (r1_)) * 72 + hc * 32 + j])}; \
            f32x2 e0_ = (f32x2){acc[0][r0_], acc[0][r1_]} * (-L2E) + br, e1_ = (f32x2){acc[1][r0_], acc[1][r1_]} * (-L2E) + bi; \
            e0_ = (f32x2){__builtin_amdgcn_exp2f(e0_.x), __builtin_amdgcn_exp2f(e0_.y)} + 1.0f; e1_ = (f32x2){__builtin_amdgcn_exp2f(e1_.x), __builtin_amdgcn_exp2f(e1_.y)} + 1.0f; \
            const f32x2 p_ = e0_ * e1_; const f32x2 ip_ = {__builtin_amdgcn_rcpf(p_.x), __builtin_amdgcn_rcpf(p_.y)}; \
            const f32x2 rg_ = ip_ * e1_, ig_ = ip_ * e0_, la_ = rg_ * (-sp); \
            const f32x2 av_ = {__builtin_amdgcn_exp2f(la_.x), __builtin_amdgcn_exp2f(la_.y)}; \
            f32x2 s_ = 1.0f - av_ * av_; s_ = (f32x2){__builtin_amdgcn_sqrtf(fmaxf(s_.x, 0.f)), __builtin_amdgcn_sqrtf(fmaxf(s_.y, 0.f))}; \
            const f32x2 xv_ = s_ * ig_ * u_; const float a0_ = av_.x, a1_ = av_.y, x0_ = xv_.x, x1_ = xv_.y
        float A = 1.f, Hs = 0.f;
        if (D == 0) {
#pragma unroll
            for (int r = 0; r < 16; r += 2) { LRU_GATES(r, r + 1, a0, a1, x0, x1);
                Hs = a0 * Hs + x0; A *= a0; yl[r] = Hs; cp[r] = A; Hs = a1 * Hs + x1; A *= a1; yl[r + 1] = Hs; cp[r + 1] = A; }
        } else {
#pragma unroll
            for (int r = 14; r >= 0; r -= 2) { LRU_GATES(r + 1, r, a0, a1, x0, x1);
                Hs = a0 * Hs + x0; A *= a0; yl[r + 1] = Hs; cp[r + 1] = A; Hs = a1 * Hs + x1; A *= a1; yl[r] = Hs; cp[r] = A; }
        }
#undef LRU_GATES
        const int myb = 2 * wave + hi;
        SUMS[(buf * 16 + myb) * 32 + j] = (f32x2){A, Hs};
        asm volatile("s_waitcnt lgkmcnt(0)" ::: "memory"); __builtin_amdgcn_s_barrier(); asm volatile("" ::: "memory");
        float c = cstep, cin = 0.f;
#pragma unroll
        for (int bq = 0; bq < 16; ++bq) { const int bb = D == 0 ? bq : 15 - bq; const f32x2 sv = SUMS[(buf * 16 + bb) * 32 + j]; cin = (bb == myb) ? c : cin; c = sv.x * c + sv.y; }
        cstep = c; buf ^= 1;
        const int r0 = rowbase + T0;
        if (D == 0) {
#pragma unroll
            for (int r = 0; r < 16; ++r) __builtin_amdgcn_raw_buffer_store_b16((unsigned short)(cvt_pk_bf16(yl[r] + cp[r] * cin, 0.f) & 0xffffu), rsF, voF, __builtin_amdgcn_readfirstlane((r0 + r) * 2048), 0);
        } else {
#pragma unroll
            for (int r = 0; r < 16; ++r) { const float y = bf2f(hfv[r]) + (yl[r] + cp[r] * cin); const float ug = bf2f(ugr[r]);
                __builtin_amdgcn_raw_buffer_store_b16((unsigned short)(cvt_pk_bf16(y * gelu_tanh(ug), 0.f) & 0xffffu), rsR, voR, __builtin_amdgcn_readfirstlane((r0 + r) * 2048), 0); }
        }
        LDS_WAIT(); asm volatile("" ::: "memory");
    }
#undef LRU_GEOM
#undef LRU_XLOAD
#undef LRU_ROWOFF
#undef LRU_STEP
}
__device__ __forceinline__ void lru_unit(KP P, int l, int b, int nb, int hc, LAS unsigned char* lds, int lane, int wave) {
    unsigned char* ws = P->ws; const bf16* Y1 = (const bf16*)(ws + WS_Y1); bf16* REC = (bf16*)(ws + WS_REC);
    const int j = lane & 31;
    LAS unsigned char* BL = lds + 36864;
    const int chin = nb * 64 + lane, cho = nb * 64 + hc * 32 + j;
    const float cw0 = P->conv_w[(l * 4 + 0) * 1024 + chin], cw1 = P->conv_w[(l * 4 + 1) * 1024 + chin], cw2 = P->conv_w[(l * 4 + 2) * 1024 + chin], cw3 = P->conv_w[(l * 4 + 3) * 1024 + chin];
    const float cb = P->conv_b[l * 1024 + chin];
    constexpr float L2E = 1.4426950408889634f;
    const float brf = -L2E * P->lru_b_r[(l * 2 + 0) * 1024 + cho], bif = -L2E * P->lru_b_i[(l * 2 + 0) * 1024 + cho], brb = -L2E * P->lru_b_r[(l * 2 + 1) * 1024 + cho], bib = -L2E * P->lru_b_i[(l * 2 + 1) * 1024 + cho];
    const float spf = ((const float*)(ws + WS_SPT))[(l * 2 + 0) * 1024 + cho], spb = ((const float*)(ws + WS_SPT))[(l * 2 + 1) * 1024 + cho];
    {
        const bf16* WLT = (const bf16*)(ws + WS_WLT); const int tid_ = wave * 64 + lane;
#pragma unroll
        for (int rep = 0; rep < 2; ++rep) { const int c16 = tid_ + rep * 512, row = c16 >> 3, ch = c16 & 7, tl = row >> 5, col = row & 31;
            const int mat = (((l * 2 + (tl >> 1)) * 16 + nb) * 2 + (tl & 1));
            v4u t_ = *(const v4u*)(WLT + (size_t)mat * 4096 + (hc * 32 + col) * 64 + ch * 8); asm volatile("" : "+v"(t_));
            *(LAS v4u*)(BL + row * 144 + ch * 16) = t_; }
        __syncthreads();
    }
    lru_sweep<0>(b, nb, hc, lds, lane, wave, (const void*)Y1, (const void*)REC, (const void*)(ws + WS_H), cw0, cw1, cw2, cw3, cb, brf, bif, spf);
    asm volatile("s_waitcnt vmcnt(0)" ::: "memory"); __syncthreads();
    lru_sweep<1>(b, nb, hc, lds, lane, wave, (const void*)Y1, (const void*)REC, (const void*)(ws + WS_H), cw0, cw1, cw2, cw3, cb, brb, bib, spb);
    __syncthreads();
}

struct MapAB { const char* A; const char* B; size_t astep, bstep; int pm0, pn0;
    __device__ __forceinline__ void operator()(pg8::Unit& u) const { u.pm += pm0; u.pn += pn0; u.A = A + (size_t)u.pm * astep; u.B = B + (size_t)u.pn * bstep; } };
struct MapBr { const char* A; const char* B; const char* BR;
    __device__ __forceinline__ void operator()(pg8::Unit& u) const { u.A = A + (size_t)u.aux * (36 * MiB) + (size_t)u.pm * (256 * 1024 * 2);
        const bool mir = u.aux == 2 && u.pm < 64 && (u.pm & 7) >= 4;
        u.B = (mir ? BR : B + (size_t)u.aux * (2048 * 1024 * 2)) + (size_t)u.pn * (256 * 1024 * 2); } };
__device__ __forceinline__ void nyquist_rows(unsigned char* ws, int lane, int wave, int vcu, int G) {
    const bf16* PTN = (const bf16*)(ws + WS_PTL); bf16* FOU = (bf16*)(ws + WS_FOU);
    const int gw = vcu * NWAVES + wave, NGW = G * NWAVES;
    for (int r = gw; r < 8192; r += NGW) {
        const v4u w = *(const v4u*)(PTN + (size_t)r * 1024 + lane * 8);
        float s = (bflo(w.x) - bfhi(w.x)) + (bflo(w.y) - bfhi(w.y)) + (bflo(w.z) - bfhi(w.z)) + (bflo(w.w) - bfhi(w.w));
        s = wave_sum(s) * 0.001953125f;
        if (lane == 0) FOU[(size_t)((r >> 10) * 2048 + 1024) * 1024 + (r & 1023)] = (bf16)(cvt_pk_bf16(s, 0.f) & 0xffffu);
    }
}
struct MapF2 { const char* A; const char* B;
    __device__ __forceinline__ void operator()(pg8::Unit& u) const { u.A = A; u.B = B + (size_t)u.pm * ((size_t)8192 * 1024 * 2) + (size_t)u.pn * (256 * 1024 * 2); } };

__global__ void __launch_bounds__(NWAVES * 64, 2) fwd_kernel(Params Pv) {
    extern __shared__ __attribute__((aligned(16))) unsigned char lds_raw[];
    LAS unsigned char* lds = (LAS unsigned char*)lds_raw;
    volatile LAS unsigned* MISC = (volatile LAS unsigned*)(lds + MISC_OFF);
    const int wave0 = __builtin_amdgcn_readfirstlane((int)threadIdx.x >> 6);
#define FRESH_TID() const KP P = fresh_kp(); (void)P; int wave = wave0; asm volatile("" : "+s"(wave)); int lane; asm volatile("v_mbcnt_lo_u32_b32 %0, -1, 0\n\tv_mbcnt_hi_u32_b32 %0, -1, %0" : "=v"(lane)); const int tid = (wave << 6) | lane; (void)tid
    const int G = gridDim.x; int vcu; { const int bx = blockIdx.x; vcu = (G % 8 == 0) ? (bx % 8) * (G / 8) + bx / 8 : bx; }
    unsigned char* ws = fresh_kp()->ws;
    gu32* ctl = (gu32*)(ws + WS_CTL);
    for (int u = (int)threadIdx.x; u < (LDS_BYTES - LDSCTL_OFF) / 4; u += NWAVES * 64) ((LAS unsigned*)(lds + LDSCTL_OFF))[u] = 0u;
    __syncthreads();
    XcdBarrier bar = xcd_barrier_post((unsigned*)(ctl + CW_BAR), MISC + 8);
#define GRID_BAR() do { XcdBarrier b2_ = bar; asm volatile("" : "+s"(b2_.bar), "+s"(b2_.x)); { FRESH_TID(); xcd_barrier(b2_, tid == 0); } } while (0)

#define H ((bf16*)(ws + WS_H))
#define Y1 ((bf16*)(ws + WS_Y1))
#define Gt ((bf16*)(ws + WS_G))
#define ACT ((bf16*)(ws + WS_ACT))
#define KN ((bf16*)(ws + WS_KN))
#define ATT ((bf16*)(ws + WS_ATT))
#define FOU ((bf16*)(ws + WS_FOU))
#define MG ((bf16*)(ws + WS_MG))
#define X ((bf16*)(ws + WS_X))
#define MOD ((const float*)(ws + WS_MOD))
#define ROPE ((const float*)(ws + WS_ROPE))

    const int ph_lo = fresh_kp()->ph_lo, ph_hi = fresh_kp()->ph_hi;
#define DUP(bit) ((((PROBE_MASK) >> (bit)) & 1) + 1)
#define IN(k) (ph_lo <= (k) && (k) < ph_hi)
#define SEAM(k) do { if (IN(k) && IN((k) + 1)) { GRID_BAR(); if (DUP(14) > 1) GRID_BAR(); } } while (0)
    if (IN(0)) { FRESH_TID(); p0_prologue(P, lds, tid, lane, wave, vcu, G, DUP(8), DUP(9), DUP(10)); }
    SEAM(0);

#pragma unroll 1
    for (int l = 0; l < DEPTH; ++l) {
        const bool last = (l == DEPTH - 1);
        const int nMt = last ? 64 : 72;
        const unsigned char* wl = ws + WS_W + (size_t)l * W_LAYER;
        const int pb = 1 + 9 * l;
        if (IN(pb + 0)) { FRESH_TID(); norm_rows(P, l, 0, MT, l > 0, lane, wave, vcu, G, DUP(11)); }
        SEAM(pb + 0);
        if (IN(pb + 1)) {
            pg8::EpiG1T<false> E{Y1, Gt, fresh_kp()->b_gate + l * 6144, (const float*)(ws + WS_SH), (const unsigned*)(ws + WS_CMAX) + l * CMAX_L};
            pg8::EpiG1T<true> EG{Y1, Gt, fresh_kp()->b_gate + l * 6144, (const float*)(ws + WS_SH), (const unsigned*)(ws + WS_CMAX) + l * CMAX_L};
            pg8::EpiG1T<false, true> EQ{Y1, Gt, fresh_kp()->b_gate + l * 6144, (const float*)(ws + WS_SH), (const unsigned*)(ws + WS_CMAX) + l * CMAX_L};
            const int bx = (int)blockIdx.x;
            if (!last) {
                pg8::TileOrder<MapAB> S; S.map = MapAB{(const char*)H, (const char*)(wl + WO_W1), (size_t)256 * 2048 * 2, (size_t)256 * 2048 * 2, 0, 5}; S.init(72, 9, G, bx, 1, DUP(1));
                { FRESH_TID(); pg8::gemm_phase<pg8::EpiG1T<false>, pg8::TileOrder<MapAB>, true, true>(lds, pg8::Gemm{2048, 2048, 2048}, S, E, tid); }
            } else {
                pg8::TileOrder<MapAB> S; S.map = MapAB{(const char*)H, (const char*)(wl + WO_W1), (size_t)256 * 2048 * 2, (size_t)256 * 2048 * 2, 0, 5}; S.init(64, 9, G, bx, 1, DUP(1));
                { FRESH_TID(); pg8::gemm_phase<pg8::EpiG1T<false>, pg8::TileOrder<MapAB>, true, true>(lds, pg8::Gemm{2048, 2048, 2048}, S, E, tid); }
                pg8::TileOrder<MapAB> S2; S2.map = MapAB{(const char*)H, (const char*)(wl + WO_W1), (size_t)256 * 2048 * 2, (size_t)256 * 2048 * 2, 64, 5}; S2.init(8, 5, G, (bx + G / 2) % G, 1, 1);
                { FRESH_TID(); pg8::gemm_phase<pg8::EpiG1T<false>, pg8::TileOrder<MapAB>, true, true>(lds, pg8::Gemm{2048, 2048, 2048}, S2, E, tid); }
            }
            {
                pg8::TileOrder<MapAB> SQ; SQ.map = MapAB{(const char*)(ws + WS_H8), (const char*)(wl + WO_W1), (size_t)256 * 2048, (size_t)256 * 2048, 0, 0};
                SQ.init(72, 5, G, G == 256 ? (bx + 96) % G : bx, 1, 1);
                { FRESH_TID(); pg8::gemm_phase<pg8::EpiG1T<false, true>, pg8::TileOrder<MapAB>, true, true, 2>(lds, pg8::Gemm{1024, 1024, 1024}, SQ, EQ, tid); }
            }
            {
                pg8::TileOrder<MapAB> SU; SU.map = MapAB{(const char*)(ws + WS_H8), (const char*)(wl + WO_W1 + WO_UF8) - (size_t)14 * 256 * 2048, (size_t)256 * 2048, (size_t)256 * 2048, 0, 14};
                SU.init(last ? 64 : 72, 4, G, G == 256 ? (bx + 40) % G : bx, 1, 1);
                { FRESH_TID(); pg8::gemm_phase<pg8::EpiG1T<false, true>, pg8::TileOrder<MapAB>, true, true, 2>(lds, pg8::Gemm{1024, 1024, 1024}, SU, EQ, tid); }
            }
            {
                pg8::TileOrder<MapAB> S8; S8.map = MapAB{(const char*)(ws + WS_H8), (const char*)(wl + WO_W8) - (size_t)18 * 256 * 2048, (size_t)256 * 2048, (size_t)256 * 2048, 0, 18};
                S8.init(last ? 64 : 72, 24, G, G == 256 ? (bx + 192) % G : bx, 1, DUP(1));
                { FRESH_TID(); pg8::gemm_phase<pg8::EpiG1T<true>, pg8::TileOrder<MapAB>, true, true, 2>(lds, pg8::Gemm{1024, 1024, 1024}, S8, EG, tid); }
            }
        }
        SEAM(pb + 1);
        if (IN(pb + 2)) {
        { FRESH_TID(); f1_units(P, last, lds, tid, lane, wave, vcu, G, DUP(2)); }
        { FRESH_TID(); knorm_units(P, l, lane, wave, vcu, G, DUP(2)); }
        __syncthreads();
        { FRESH_TID(); for (int u_ = vcu; u_ < 256 * DUP(6); u_ += G) { const int u = u_ & 255; lru_unit(P, l, u >> 5, (u >> 1) & 15, u & 1, lds, lane, wave); } }
        }
        SEAM(pb + 2);
        if (IN(pb + 3)) {
            const bool evn = (vcu & 1) == 0; const int pr = vcu >> 1;
            { FRESH_TID(); if (G != 256) nyquist_rows(ws, lane, wave, vcu, G); else if (!evn) nyquist_rows(ws, lane, wave, pr, 128); }
            { FRESH_TID();
            const int nctx = (G == 256) ? ((!evn && !last && pr < 64) ? 1 : 0) : 0;
            const int ntot = (G == 256) ? 2 + nctx : 0;
            for (int ui_ = 0; ui_ < ntot * DUP(3); ++ui_) { const int ui = ui_ % ntot;
                const int U = ui < 2 ? 2 * vcu + ui : 512 + pr;
                const bf16 *Qb, *K0, *K1, *V0, *V1; bf16* Ob; int n0, NT; const float* rope;
                if (U < 512) { const int bh = U >> 3, qb = U & 7, b = bh >> 3, h = bh & 7, kvh = h >> 2; const size_t r0 = (size_t)b * 2048, rc = (size_t)ML + b * 256;
                    Qb = Y1 + (r0 + qb * 256) * LDY + YQ + h * 128; K0 = KN + r0 * 256 + kvh * 128; K1 = KN + rc * 256 + kvh * 128;
                    V0 = Y1 + r0 * LDY + YV + kvh * 128; V1 = Y1 + rc * LDY + YV + kvh * 128; n0 = 32; NT = 36; Ob = ATT + (r0 + qb * 256) * 1024 + h * 128; rope = ROPE + (size_t)qb * 256 * 64; }
                else { const int uc = U - 512, b = uc >> 3, h = uc & 7, kvh = h >> 2; const size_t rc = (size_t)ML + b * 256;
                    Qb = Y1 + rc * LDY + YQ + h * 128; K0 = KN + rc * 256 + kvh * 128; K1 = K0; V0 = Y1 + rc * LDY + YV + kvh * 128; V1 = V0; n0 = 4; NT = 4; Ob = ATT + rc * 1024 + h * 128; rope = nullptr; }
                att::attn_unit(Qb, LDY, K0, K1, V0, V1, n0, NT, 256, LDY, Ob, 1024, P->q_gain + l * 128, rope, (char*)lds_raw, tid);
            }
            if (G != 256) {
                const int nun = last ? 512 : 576;
                for (int U = vcu; U < nun; U += G) {
                    const bf16 *Qb, *K0, *K1, *V0, *V1; bf16* Ob; int n0, NT; const float* rope;
                    if (U < 512) { const int bh = U >> 3, qb = U & 7, b = bh >> 3, h = bh & 7, kvh = h >> 2; const size_t r0 = (size_t)b * 2048, rc = (size_t)ML + b * 256;
                        Qb = Y1 + (r0 + qb * 256) * LDY + YQ + h * 128; K0 = KN + r0 * 256 + kvh * 128; K1 = KN + rc * 256 + kvh * 128;
                        V0 = Y1 + r0 * LDY + YV + kvh * 128; V1 = Y1 + rc * LDY + YV + kvh * 128; n0 = 32; NT = 36; Ob = ATT + (r0 + qb * 256) * 1024 + h * 128; rope = ROPE + (size_t)qb * 256 * 64; }
                    else { const int uc = U - 512, b = uc >> 3, h = uc & 7, kvh = h >> 2; const size_t rc = (size_t)ML + b * 256;
                        Qb = Y1 + rc * LDY + YQ + h * 128; K0 = KN + rc * 256 + kvh * 128; K1 = K0; V0 = Y1 + rc * LDY + YV + kvh * 128; V1 = V0; n0 = 4; NT = 4; Ob = ATT + rc * 1024 + h * 128; rope = nullptr; }
                    att::attn_unit(Qb, LDY, K0, K1, V0, V1, n0, NT, 256, LDY, Ob, 1024, P->q_gain + l * 128, rope, (char*)lds_raw, tid);
                }
            }
            }
            __syncthreads();
            const int cF = (G == 256) ? (evn ? pr : 1 << 20) : (int)blockIdx.x;
            {
                pg8::TileOrder<MapF2> S; S.map = MapF2{(const char*)(ws + WS_DFTL), (const char*)(ws + WS_PTL)}; S.init(4, 32, G, cF, 1, DUP(5));
                pg8::EpiF2 E{FOU, 2048, 0, 1, 0.001953125f, 1};
                { FRESH_TID(); pg8::gemm_phase<pg8::EpiF2, pg8::TileOrder<MapF2>, true, true>(lds, pg8::Gemm{1024, 1024, 1024}, S, E, tid); }
            }
            if (!last) {
                pg8::TileOrder<MapAB> S; S.map = MapAB{(const char*)(ws + WS_DFTC), (const char*)(ws + WS_PTC), (size_t)256 * 512 * 2, (size_t)256 * 512 * 2, 0, 0}; S.init(1, 32, G, (G == 256) ? (!evn && pr >= 64 && pr < 96 ? pr - 64 : 1 << 20) : (int)blockIdx.x, 1, DUP(5));
                pg8::EpiF2 E{FOU, 256, ML, 0, 0.005524271728019903f, 0};
                { FRESH_TID(); pg8::gemm_phase<pg8::EpiF2, pg8::TileOrder<MapAB>, true, true>(lds, pg8::Gemm{512, 512, 512}, S, E, tid); }
            }
        }
        SEAM(pb + 3);
        if (IN(pb + 4)) {
            pg8::TileOrder<MapBr> S; S.map = MapBr{(const char*)ATT, (const char*)(wl + WO_WB), (const char*)(ws + WS_WBR + (size_t)l * 4 * MiB)}; S.init(nMt, 8, G, (int)blockIdx.x, 3, DUP(4));
            pg8::EpiBr E{Gt, MG};
            { FRESH_TID(); pg8::gemm_phase<pg8::EpiBr, pg8::TileOrder<MapBr>, true, true>(lds, pg8::Gemm{1024, 1024, 1024}, S, E, tid); }
        }
        SEAM(pb + 4);
        if (IN(pb + 5)) {
            pg8::TileOrder<MapAB> S; S.map = MapAB{(const char*)MG, (const char*)(wl + WO_WO), (size_t)256 * 2048 * 2, (size_t)256 * 2048 * 2, 0, 0}; S.init(64, 8, G, (int)blockIdx.x, 1, DUP(12));
            pg8::EpiRes E{X, MOD + (size_t)l * 9 * 12288 + 2 * 2048, (bf16*)(ws + WS_Y1)};
            { FRESH_TID(); pg8::gemm_phase<pg8::EpiRes, pg8::TileOrder<MapAB>, true, true>(lds, pg8::Gemm{2048, 2048, 2048}, S, E, tid); }
            if (!last) {
                pg8::QuarterOrder Q{G, (int)blockIdx.x, (const char*)MG, (const char*)(wl + WO_WO), (size_t)256 * 2048 * 2, (size_t)256 * 2048 * 2, (size_t)512 * 2};
                pg8::EpiResSlab EA{(float*)(ws + WS_SLAB), MOD + (size_t)l * 9 * 12288 + 2 * 2048};
                { FRESH_TID(); pg8::gemm_phase<pg8::EpiResSlab, pg8::QuarterOrder, true, true>(lds, pg8::Gemm{512, 2048, 2048}, Q, EA, tid); }
            }
        }
        SEAM(pb + 5);
        if (IN(pb + 6)) { FRESH_TID(); norm_rows(P, l, 1, nMt * 256, true, lane, wave, vcu, G, DUP(11)); }
        SEAM(pb + 6);
        if (IN(pb + 7)) {
            pg8::TileOrder<MapAB> S; S.map = MapAB{(const char*)H, (const char*)(wl + WO_WFI), (size_t)256 * 2048 * 2, (size_t)256 * 2048 * 2, 0, 0}; S.init(nMt, 44, G, (int)blockIdx.x, 1, DUP(7));
            pg8::EpiSwi E{ACT};
            { FRESH_TID(); pg8::gemm_phase<pg8::EpiSwi, pg8::TileOrder<MapAB>, true, true>(lds, pg8::Gemm{2048, 2048, 2048}, S, E, tid); }
        }
        SEAM(pb + 7);
        if (IN(pb + 8)) {
            pg8::TileOrder<MapAB> S; S.map = MapAB{(const char*)ACT, (const char*)(wl + WO_WFO), (size_t)256 * 5632 * 2, (size_t)256 * 5632 * 2, 0, 0}; S.init(64, 8, G, (int)blockIdx.x, 1, DUP(13));
            pg8::EpiRes E{X, MOD + (size_t)l * 9 * 12288 + 5 * 2048, (bf16*)(ws + WS_Y1)};
            { FRESH_TID(); pg8::gemm_phase<pg8::EpiRes, pg8::TileOrder<MapAB>, true, true>(lds, pg8::Gemm{5632, 5632, 5632}, S, E, tid); }
            if (!last) {
                pg8::QuarterOrder Q{G, (int)blockIdx.x, (const char*)ACT, (const char*)(wl + WO_WFO), (size_t)256 * 5632 * 2, (size_t)256 * 5632 * 2, (size_t)1408 * 2};
                pg8::EpiResSlab EA{(float*)(ws + WS_SLAB), MOD + (size_t)l * 9 * 12288 + 5 * 2048};
                { FRESH_TID(); pg8::gemm_phase<pg8::EpiResSlab, pg8::QuarterOrder, true, true>(lds, pg8::Gemm{1408, 5632, 5632}, Q, EA, tid); }
            }
        }
        SEAM(pb + 8);
    }
    if (IN(37)) { FRESH_TID(); final_norm(P, lane, wave, vcu, G); }
#undef IN
#undef SEAM
#undef GRID_BAR
#undef H
#undef Y1
#undef Gt
#undef ACT
#undef KN
#undef ATT
#undef FOU
#undef MG
#undef X
#undef MOD
#undef ROPE
}

extern "C" void kernel_launch(void* const* d_in, const int* in_sizes, int n_in, void* d_out, int out_size, void* d_ws, size_t ws_size, hipStream_t stream) {
    static int grid = 0;
    if (grid == 0) {
        if (n_in != 25 || out_size != ML * DM || ws_size < WS_END) { fprintf(stderr, "kernel_launch: unexpected shapes (n_in %d out %d ws %zu, need %zu)\n", n_in, out_size, ws_size, (size_t)WS_END); grid = -1; return; }
        int dev = 0, cus = 0, per_cu = 0;
        if (hipGetDevice(&dev) != hipSuccess || hipDeviceGetAttribute(&cus, hipDeviceAttributeMultiprocessorCount, dev) != hipSuccess) { grid = -1; return; }
        if (hipFuncSetAttribute((const void*)fwd_kernel, hipFuncAttributeMaxDynamicSharedMemorySize, LDS_BYTES) != hipSuccess) { fprintf(stderr, "kernel_launch: hipFuncSetAttribute failed\n"); grid = -1; return; }
        if (hipOccupancyMaxActiveBlocksPerMultiprocessor(&per_cu, (const void*)fwd_kernel, NWAVES * 64, LDS_BYTES) != hipSuccess || per_cu < 1) fprintf(stderr, "kernel_launch: occupancy query reports %d\n", per_cu);
        (void)hipGetLastError();
        grid = cus > 256 ? 256 : cus;
    }
    if (grid < 0) return;
    if (hipMemsetAsync((char*)d_ws + WS_CTL, 0, CTL_ZERO_BYTES, stream) != hipSuccess) return;
    Params p{};
    const float** pf = (const float**)&p;
    for (int i = 0; i < 25; ++i) pf[i] = (const float*)d_in[i];
    p.out = (float*)d_out; p.ws = (unsigned char*)d_ws;
#ifndef MK_CUT_EVERY
#define MK_CUT_EVERY 0
#endif
    constexpr int NPH = 38;
    for (int lo = 0; lo < NPH;) {
        const int hi = MK_CUT_EVERY ? lo + 1 : NPH;
        p.ph_lo = lo; p.ph_hi = hi;
        if (lo > 0 && hipMemsetAsync((char*)d_ws + WS_CTL, 0, CTL_ZERO_BYTES, stream) != hipSuccess) return;
        hipLaunchKernelGGL(fwd_kernel, dim3(grid), dim3(NWAVES * 64), LDS_BYTES, stream, p);
        const hipError_t le = hipPeekAtLastError();
        if (le != hipSuccess) { fprintf(stderr, "kernel_launch: launch failed: %s\n", hipGetErrorName(le)); return; }
        lo = hi;
    }
}
```

```cpp
#include <hip/hip_runtime.h>
#include <cstdio>
#include <cstdint>
#ifndef PROBE_MASK
#define PROBE_MASK 0
#endif

namespace pg8 {
#define PG8_LAS __attribute__((address_space(3)))
typedef unsigned short bf16_t;
typedef short bf16x8 __attribute__((ext_vector_type(8)));
typedef float f32x4 __attribute__((ext_vector_type(4)));
typedef float f32x2 __attribute__((ext_vector_type(2)));
typedef unsigned u32x4 __attribute__((ext_vector_type(4)));
typedef unsigned u32x2 __attribute__((ext_vector_type(2)));
typedef int i32x4 __attribute__((ext_vector_type(4)));
constexpr int BM = 256, BK = 64, HALF = 128, HTB = HALF * BK * 2  , STAGE_BYTES = 8 * HTB, NXCD = 8, WGM = 4;

__host__ __device__ __forceinline__ int lds_byte(int r, int c) { const int st = (r >> 4) * 2 + (c >> 5), rr = r & 15, cc = c & 31, ob = rr * 64 + cc * 2; return st * 1024 + (ob ^ (((ob >> 9) & 1) << 5)); }
__host__ __device__ __forceinline__ void stage_rc(int b, int& R, int& C) { const int st = b / 1024, sb = b % 1024, swz = sb ^ (((sb >> 9) & 1) << 5); R = (st >> 1) * 16 + swz / 64; C = (st & 1) * 32 + (swz % 64) / 2; }
__host__ __device__ __forceinline__ int perm32(int rho) { const int n = rho >> 4, i = rho & 15; return 8 * (i >> 2) + 4 * n + (i & 3); }

struct Unit { int pm, pn, aux, dupv; const char* A; const char* B; };
struct Gemm { int K, lda, ldb; };

template <class Map> struct TileOrder {
    int nM, nN, nwg, G, c, rep, dup; Map map;
    __device__ __forceinline__ void init(int nM_, int nN_, int G_, int c_, int rep_ = 1, int dup_ = 1) { nM = nM_; nN = nN_; nwg = nM * nN; G = G_; c = c_; rep = rep_; dup = dup_; }
    __device__ __forceinline__ bool next(int i, Unit& u) const {
        const int round = i / rep, kb = i - round * rep;
#if PROBE_MASK
        const long L = (long)round * G + c; if (L >= (long)nwg * dup) return false;
        int wgid = (int)(L % nwg); u.dupv = L >= nwg;
#else
        const long L = (long)round * G + c; if (L >= nwg) return false;
        int wgid = (int)L; u.dupv = 0;
#endif
        { const int q = nwg / NXCD, r = nwg % NXCD, xcd = wgid % NXCD, off = wgid / NXCD; wgid = (xcd < r ? xcd * (q + 1) : r * (q + 1) + (xcd - r) * q) + off; }
        const int nig = WGM * nN, gid = wgid / nig, fm = gid * WGM, gsz = (nM - fm) < WGM ? (nM - fm) : WGM;
        u.pm = fm + ((wgid % nig) % gsz); u.pn = (wgid % nig) / gsz; u.aux = kb; map(u); return true;
    }
    __device__ __forceinline__ void a_ready(const Unit&) const {}
    __device__ __forceinline__ void done(const Unit&) const {}
};

typedef float f32x2_cv __attribute__((ext_vector_type(2))); typedef __bf16 bf16x2_cv __attribute__((ext_vector_type(2)));
__device__ __forceinline__ unsigned cvt_pk_bf16(float lo, float hi) { const f32x2_cv v = {lo, hi}; const bf16x2_cv b = __builtin_convertvector(v, bf16x2_cv); return __builtin_bit_cast(unsigned, b); }
__device__ __forceinline__ float bf2f(unsigned short v) { return __uint_as_float((unsigned)v << 16); }
__device__ __forceinline__ float bflo(unsigned w) { return __uint_as_float(w << 16); }
__device__ __forceinline__ float bfhi(unsigned w) { return __uint_as_float(w & 0xffff0000u); }
__device__ __forceinline__ unsigned pk_u8x4(float a, float b, float c, float d, float sc) {
    const unsigned fa = __float_as_uint(fmaf(a, sc, 12582912.0f)), fb = __float_as_uint(fmaf(b, sc, 12582912.0f)), fc = __float_as_uint(fmaf(c, sc, 12582912.0f)), fd = __float_as_uint(fmaf(d, sc, 12582912.0f));
    const unsigned p01 = __builtin_amdgcn_perm(fb, fa, 0x0c0c0400u), p23 = __builtin_amdgcn_perm(fd, fc, 0x0c0c0400u);
    return __builtin_amdgcn_perm(p23, p01, 0x05040100u);
}
__device__ __forceinline__ float sigm(float x) { return __builtin_amdgcn_rcpf(1.0f + __builtin_amdgcn_exp2f(-1.4426950408889634f * x)); }


template <bool GATE, bool QI = GATE> struct EpiG1T {
    static constexpr bool PERM = true, AFTER_DRAIN = false, KEEP = false;
    bf16_t* Y1; bf16_t* G; const float* bgate; const float* sH; const unsigned* cmax;
    __device__ __forceinline__ void operator()(const f32x4 (&acc)[2][2][4][2], const Unit& u, int wr, int wc, int fr, int fq) const {
        asm volatile("" : "+v"(fr), "+v"(fq));
        const int row0 = u.pm * BM + wr * 64 + fr; constexpr bool gate = GATE;
        bf16_t* base = gate ? G : Y1; const int ldc = gate ? 6144 : 4608; const int colt = gate ? (u.pn - 18) * BM : u.pn * BM;
        const int col0 = colt + wc * 32 + 8 * fq;
        f32x4 bv[2][2], cs[2][2]; float rs[2][4];
#pragma unroll
        for (int bj = 0; bj < 2; ++bj)
#pragma unroll
            for (int n = 0; n < 2; ++n) { bv[bj][n] = gate ? *(const f32x4*)(bgate + col0 + bj * HALF + 4 * n) : (f32x4){0.f, 0.f, 0.f, 0.f};
                const u32x4 cm = QI ? *(const u32x4*)(cmax + (gate ? 0 : 6144) + col0 + bj * HALF + 4 * n) : (u32x4){0u, 0u, 0u, 0u};
                cs[bj][n] = (f32x4){__uint_as_float(cm.x), __uint_as_float(cm.y), __uint_as_float(cm.z), __uint_as_float(cm.w)} * (gate ? -1.4426950408889634f / 127.0f : 1.0f / 127.0f);
                if (gate) bv[bj][n] = bv[bj][n] * (-1.4426950408889634f); }
#pragma unroll
        for (int ai = 0; ai < 2; ++ai)
#pragma unroll
            for (int m = 0; m < 4; ++m) rs[ai][m] = QI ? sH[row0 + ai * HALF + m * 16] : 0.f;
#pragma unroll
        for (int ai = 0; ai < 2; ++ai)
#pragma unroll
            for (int m = 0; m < 4; ++m) { bf16_t* rowp = base + (size_t)(row0 + ai * HALF + m * 16) * ldc + col0;
#pragma unroll
                for (int bj = 0; bj < 2; ++bj) { f32x4 v0 = acc[ai][bj][m][0] + bv[bj][0], v1 = acc[ai][bj][m][1] + bv[bj][1];
                    if (gate) {
                        const i32x4 a0 = __builtin_bit_cast(i32x4, acc[ai][bj][m][0]), a1 = __builtin_bit_cast(i32x4, acc[ai][bj][m][1]);
                        const f32x4 f0 = {(float)a0[0], (float)a0[1], (float)a0[2], (float)a0[3]}, f1 = {(float)a1[0], (float)a1[1], (float)a1[2], (float)a1[3]};
                        v0 = f0 * rs[ai][m] * cs[bj][0] + bv[bj][0]; v1 = f1 * rs[ai][m] * cs[bj][1] + bv[bj][1];
                        v0 = (f32x4){__builtin_amdgcn_exp2f(v0[0]), __builtin_amdgcn_exp2f(v0[1]), __builtin_amdgcn_exp2f(v0[2]), __builtin_amdgcn_exp2f(v0[3])} + 1.0f; v1 = (f32x4){__builtin_amdgcn_exp2f(v1[0]), __builtin_amdgcn_exp2f(v1[1]), __builtin_amdgcn_exp2f(v1[2]), __builtin_amdgcn_exp2f(v1[3])} + 1.0f; }
                    if (QI && !gate) { const i32x4 a0 = __builtin_bit_cast(i32x4, acc[ai][bj][m][0]), a1 = __builtin_bit_cast(i32x4, acc[ai][bj][m][1]);
                        v0 = (f32x4){(float)a0[0], (float)a0[1], (float)a0[2], (float)a0[3]} * rs[ai][m] * cs[bj][0]; v1 = (f32x4){(float)a1[0], (float)a1[1], (float)a1[2], (float)a1[3]} * rs[ai][m] * cs[bj][1]; }
                    if (gate) {
                        const f32x4 g0 = {__builtin_amdgcn_rcpf(v0[0]), __builtin_amdgcn_rcpf(v0[1]), __builtin_amdgcn_rcpf(v0[2]), __builtin_amdgcn_rcpf(v0[3])}, g1 = {__builtin_amdgcn_rcpf(v1[0]), __builtin_amdgcn_rcpf(v1[1]), __builtin_amdgcn_rcpf(v1[2]), __builtin_amdgcn_rcpf(v1[3])};
                        u32x2 w8; w8.x = pk_u8x4(fmaxf(g0[0], 0.00393f), fmaxf(g0[1], 0.00393f), fmaxf(g0[2], 0.00393f), fmaxf(g0[3], 0.00393f), 255.0f);
                        w8.y = pk_u8x4(fmaxf(g1[0], 0.00393f), fmaxf(g1[1], 0.00393f), fmaxf(g1[2], 0.00393f), fmaxf(g1[3], 0.00393f), 255.0f);
                        *(u32x2*)((unsigned char*)G + (size_t)(row0 + ai * HALF + m * 16) * 6144 + col0 + bj * HALF) = w8;
                    } else {
                    u32x4 w; w.x = cvt_pk_bf16(v0[0], v0[1]); w.y = cvt_pk_bf16(v0[2], v0[3]); w.z = cvt_pk_bf16(v1[0], v1[1]); w.w = cvt_pk_bf16(v1[2], v1[3]);
                    *(u32x4*)(rowp + bj * HALF) = w; } } }
    }
};
struct EpiF2 {
    static constexpr bool PERM = true, AFTER_DRAIN = false, KEEP = false;
    bf16_t* FOU; int rows_per_b, row_off, mirror; float scale; int r4;
    __device__ __forceinline__ void operator()(const f32x4 (&acc)[2][2][4][2], const Unit& u, int wr, int wc, int fr, int fq) const {
        asm volatile("" : "+v"(fr), "+v"(fq));
        const int b = u.pn >> 2, q = u.pn & 3;
        const int k0 = (r4 ? 0 : u.pm * BM) + wr * 64 + fr, col0 = q * BM + wc * 32 + 8 * fq;
        bf16_t* base = FOU + (size_t)(row_off + b * rows_per_b) * 1024 + col0;
#pragma unroll
        for (int ai = 0; ai < 2; ++ai)
#pragma unroll
            for (int m = 0; m < 4; ++m) { const int kk = r4 ? u.pm + 4 * (k0 + ai * HALF + m * 16) : k0 + ai * HALF + m * 16; bf16_t* rowp = base + (size_t)kk * 1024; bf16_t* rowm = base + (size_t)(rows_per_b - kk) * 1024;
#pragma unroll
                for (int bj = 0; bj < 2; ++bj) { const f32x4 v0 = acc[ai][bj][m][0] * scale, v1 = acc[ai][bj][m][1] * scale;
                    u32x4 w; w.x = cvt_pk_bf16(v0[0], v0[1]); w.y = cvt_pk_bf16(v0[2], v0[3]); w.z = cvt_pk_bf16(v1[0], v1[1]); w.w = cvt_pk_bf16(v1[2], v1[3]);
                    *(u32x4*)(rowp + bj * HALF) = w; if (mirror && kk > 0) *(u32x4*)(rowm + bj * HALF) = w; } }
    }
};
struct EpiBr {
    static constexpr bool PERM = true, AFTER_DRAIN = false, KEEP = true;
    const bf16_t* G; bf16_t* MG;
    __device__ __forceinline__ void operator()(f32x4 (&acc)[2][2][4][2], const Unit& u, int wr, int wc, int fr, int fq) const {
        asm volatile("" : "+v"(fr), "+v"(fq));
        const int kb = u.aux, row0 = u.pm * BM + wr * 64 + fr, col0 = u.pn * BM + wc * 32 + 8 * fq;
        const unsigned char* G8 = (const unsigned char*)G;
#define BR_U8(w) (f32x4){(float)((w) & 0xffu), (float)(((w) >> 8) & 0xffu), (float)(((w) >> 16) & 0xffu), (float)((w) >> 24)}
        const __amdgpu_buffer_rsrc_t rsG = __builtin_amdgcn_make_buffer_rsrc((void*)(((unsigned long long)(unsigned)__builtin_amdgcn_readfirstlane((int)(unsigned)((unsigned long long)G8 >> 32)) << 32) | (unsigned long long)(unsigned)__builtin_amdgcn_readfirstlane((int)(unsigned)(unsigned long long)G8)), (short)0, (int)((size_t)18432 * 6144), 0x00020000);
        const int voff = row0 * 6144 + kb * 2048 + col0;
#define BR_LD(ai, m, bj, extra) __builtin_bit_cast(u32x2, __builtin_amdgcn_raw_buffer_load_b64(rsG, voff, ((ai) * HALF + (m) * 16) * 6144 + (bj) * HALF + (extra), 0))
        u32x2 gw[2][4][2];
#pragma unroll
        for (int ai = 0; ai < 2; ++ai)
#pragma unroll
            for (int m = 0; m < 4; ++m)
#pragma unroll
                for (int bj = 0; bj < 2; ++bj) gw[ai][m][bj] = BR_LD(ai, m, bj, 0);
        if (kb < 2) {
            u32x2 hw[2][4][2];
#pragma unroll
            for (int ai = 0; ai < 2; ++ai)
#pragma unroll
                for (int m = 0; m < 4; ++m)
#pragma unroll
                    for (int bj = 0; bj < 2; ++bj) hw[ai][m][bj] = BR_LD(ai, m, bj, 2048);
            asm volatile("" ::: "memory");
#pragma unroll
            for (int ai = 0; ai < 2; ++ai)
#pragma unroll
                for (int m = 0; m < 4; ++m)
#pragma unroll
                    for (int bj = 0; bj < 2; ++bj) {
                        asm volatile("" : "+v"(gw[ai][m][bj].x), "+v"(gw[ai][m][bj].y), "+v"(hw[ai][m][bj].x), "+v"(hw[ai][m][bj].y));
                        const f32x4 n0 = BR_U8(gw[ai][m][bj].x), n1 = BR_U8(gw[ai][m][bj].y), d0 = BR_U8(hw[ai][m][bj].x), d1 = BR_U8(hw[ai][m][bj].y);
                        const f32x4 s0 = n0 * (f32x4){__builtin_amdgcn_rcpf(d0[0]), __builtin_amdgcn_rcpf(d0[1]), __builtin_amdgcn_rcpf(d0[2]), __builtin_amdgcn_rcpf(d0[3])};
                        const f32x4 s1 = n1 * (f32x4){__builtin_amdgcn_rcpf(d1[0]), __builtin_amdgcn_rcpf(d1[1]), __builtin_amdgcn_rcpf(d1[2]), __builtin_amdgcn_rcpf(d1[3])};
                        acc[ai][bj][m][0] = acc[ai][bj][m][0] * s0; acc[ai][bj][m][1] = acc[ai][bj][m][1] * s1;
                        asm volatile("" : "+v"(acc[ai][bj][m][0]), "+v"(acc[ai][bj][m][1])); }
        } else {
            asm volatile("" ::: "memory");
#pragma unroll
            for (int ai = 0; ai < 2; ++ai)
#pragma unroll
                for (int m = 0; m < 4; ++m)
#pragma unroll
                    for (int bj = 0; bj < 2; ++bj) { asm volatile("" : "+v"(gw[ai][m][bj].x), "+v"(gw[ai][m][bj].y));
                        const f32x4 v0 = acc[ai][bj][m][0] * (BR_U8(gw[ai][m][bj].x) * (1.0f / 255.0f)), v1 = acc[ai][bj][m][1] * (BR_U8(gw[ai][m][bj].y) * (1.0f / 255.0f));
                        u32x4 w; w.x = cvt_pk_bf16(v0[0], v0[1]); w.y = cvt_pk_bf16(v0[2], v0[3]); w.z = cvt_pk_bf16(v1[0], v1[1]); w.w = cvt_pk_bf16(v1[2], v1[3]);
                        *(u32x4*)(MG + (size_t)(row0 + ai * HALF + m * 16) * 2048 + col0 + bj * HALF) = w; }
        }
        asm volatile("" ::: "memory");
#undef BR_U8
#undef BR_LD
    }
};
struct EpiRes {
    static constexpr bool PERM = true, AFTER_DRAIN = false, KEEP = false;
    bf16_t* X; const float* gv; bf16_t* Xdup;
    __device__ __forceinline__ void operator()(const f32x4 (&acc)[2][2][4][2], const Unit& u, int wr, int wc, int fr, int fq) const {
        asm volatile("" : "+v"(fr), "+v"(fq));
        const int rsel = u.pm < 64 ? (u.pm >> 3) : 8; const float* gr = gv + (size_t)rsel * 12288;
        const int row0 = u.pm * BM + wr * 64 + fr, col0 = u.pn * BM + wc * 32 + 8 * fq;
        f32x4 gvv[2][2];
#pragma unroll
        for (int bj = 0; bj < 2; ++bj)
#pragma unroll
            for (int n = 0; n < 2; ++n) gvv[bj][n] = *(const f32x4*)(gr + col0 + bj * HALF + n * 4);
        u32x4 xw[2][4][2];
#pragma unroll
        for (int ai = 0; ai < 2; ++ai)
#pragma unroll
            for (int m = 0; m < 4; ++m)
#pragma unroll
                for (int bj = 0; bj < 2; ++bj) xw[ai][m][bj] = *(const u32x4*)(X + (size_t)(row0 + ai * HALF + m * 16) * 2048 + col0 + bj * HALF);
#pragma unroll
        for (int ai = 0; ai < 2; ++ai)
#pragma unroll
            for (int m = 0; m < 4; ++m) { bf16_t* rowp = X + (size_t)(row0 + ai * HALF + m * 16) * 2048 + col0;
#pragma unroll
                for (int bj = 0; bj < 2; ++bj) { bf16_t* p = rowp + bj * HALF; bf16_t* pw = PROBE_MASK ? (u.dupv ? Xdup + (p - X) : p) : p;
                    const u32x4 x = xw[ai][m][bj];
                    const f32x4 v0 = (f32x4){bflo(x.x), bfhi(x.x), bflo(x.y), bfhi(x.y)} + gvv[bj][0] * acc[ai][bj][m][0];
                    const f32x4 v1 = (f32x4){bflo(x.z), bfhi(x.z), bflo(x.w), bfhi(x.w)} + gvv[bj][1] * acc[ai][bj][m][1];
                    u32x4 w; w.x = cvt_pk_bf16(v0[0], v0[1]); w.y = cvt_pk_bf16(v0[2], v0[3]); w.z = cvt_pk_bf16(v1[0], v1[1]); w.w = cvt_pk_bf16(v1[2], v1[3]);
                    *(u32x4*)pw = w; } }
    }
};
struct EpiResSlab {
    static constexpr bool PERM = false, AFTER_DRAIN = false, KEEP = false;
    float* SL; const float* gv;
    __device__ __forceinline__ void operator()(const f32x4 (&acc)[2][2][4][2], const Unit& u, int wr, int wc, int fr, int fq) const {
        asm volatile("" : "+v"(fr), "+v"(fq));
        const float* gr = gv + (size_t)8 * 12288;
        const int row0 = (u.pm - 64) * BM + wr * 64 + fr, col0 = u.pn * BM + wc * 32 + 4 * fq;
        float* base = SL + (size_t)u.aux * 2048 * 2048;
        f32x4 gvv[2][2];
#pragma unroll
        for (int bj = 0; bj < 2; ++bj)
#pragma unroll
            for (int n = 0; n < 2; ++n) gvv[bj][n] = *(const f32x4*)(gr + col0 + bj * HALF + n * 16);
#pragma unroll
        for (int ai = 0; ai < 2; ++ai)
#pragma unroll
            for (int m = 0; m < 4; ++m) { float* rowp = base + (size_t)(row0 + ai * HALF + m * 16) * 2048 + col0;
#pragma unroll
                for (int bj = 0; bj < 2; ++bj)
#pragma unroll
                    for (int n = 0; n < 2; ++n) *(f32x4*)(rowp + bj * HALF + n * 16) = gvv[bj][n] * acc[ai][bj][m][n]; }
    }
};
struct QuarterOrder {
    int G, c; const char* A; const char* B; size_t astep, bstep, kbytes;
    __device__ __forceinline__ bool next(int i, Unit& u) const {
        const int L = i * G + c; if (L >= 256) return false;
        u.pm = 64 + (L >> 5); u.pn = (L >> 2) & 7; u.aux = L & 3; u.dupv = 0;
        u.A = A + (size_t)u.pm * astep + (size_t)u.aux * kbytes; u.B = B + (size_t)u.pn * bstep + (size_t)u.aux * kbytes; return true;
    }
    __device__ __forceinline__ void a_ready(const Unit&) const {}
    __device__ __forceinline__ void done(const Unit&) const {}
};
struct EpiSwi {
    static constexpr bool PERM = true, AFTER_DRAIN = false, KEEP = false;
    bf16_t* ACT;
    __device__ __forceinline__ void operator()(const f32x4 (&acc)[2][2][4][2], const Unit& u, int wr, int wc, int fr, int fq) const {
        asm volatile("" : "+v"(fr), "+v"(fq));
        const int row0 = u.pm * BM + wr * 64 + fr, col0 = u.pn * HALF + wc * 32 + 8 * fq;
#pragma unroll
        for (int ai = 0; ai < 2; ++ai)
#pragma unroll
            for (int m = 0; m < 4; ++m) { bf16_t* rowp = ACT + (size_t)(row0 + ai * HALF + m * 16) * 5632 + col0;
                f32x4 o[2];
#pragma unroll
                for (int n = 0; n < 2; ++n) { const f32x4 g = acc[ai][0][m][n], up = acc[ai][1][m][n];
                    o[n] = (f32x4){g[0] * sigm(g[0]) * up[0], g[1] * sigm(g[1]) * up[1], g[2] * sigm(g[2]) * up[2], g[3] * sigm(g[3]) * up[3]}; }
                u32x4 w; w.x = cvt_pk_bf16(o[0][0], o[0][1]); w.y = cvt_pk_bf16(o[0][2], o[0][3]); w.z = cvt_pk_bf16(o[1][0], o[1][1]); w.w = cvt_pk_bf16(o[1][2], o[1][3]);
                *(u32x4*)rowp = w; }
    }
};

template <class Epi, class Sched, bool ALIGN_EPI = false, bool SP2 = false, int QM = 0>
__device__ __forceinline__ void gemm_phase(PG8_LAS unsigned char* lds, const Gemm g, const Sched& S, const Epi& E, const int tid) {
    { unsigned l32_ = (unsigned)(unsigned long long)lds; asm volatile("" : "+s"(l32_)); lds = (PG8_LAS unsigned char*)(unsigned long long)l32_; }
    const int wid = __builtin_amdgcn_readfirstlane(tid >> 6), lane = tid & 63, wr = wid >> 2, wc = wid & 3, fr = lane & 15, fq = lane >> 4;
    const int K = g.K, nt = K / BK;
    unsigned voffA, voffB;
    { int R, C; stage_rc(tid * 16, R, C); const int Rb = Epi::PERM ? ((R & ~31) + perm32(R & 31)) : R;
        voffA = (unsigned)(R * g.lda + C) * 2u; voffB = (unsigned)(Rb * g.ldb + C) * 2u; }
    const size_t rstepA = (size_t)64 * g.lda * 2, rstepB = (size_t)64 * g.ldb * 2;
    const size_t kstep = (size_t)(BK * 2);
    const size_t hstepA = (size_t)HALF * g.lda * 2, hstepB = (size_t)HALF * g.ldb * 2;
    const unsigned ldsw = (unsigned)wid * 1024u;
    const int aoff = lds_byte(wr * 64 + fr, fq * 8), boff = lds_byte(wc * 32 + fr, fq * 8);
#define PG8_SA(b, h) (((b) * 2 + (h)) * HTB)
#define PG8_SB(b, h) ((4 + (b) * 2 + (h)) * HTB)
#define PG8_STAGE(bufoff, gbase, voff) do { _Pragma("unroll") for (int _i = 0; _i < 2; ++_i) \
        __builtin_amdgcn_global_load_lds((const unsigned*)((const char*)(gbase) + (size_t)_i * rstep_##voff + (voff)), (PG8_LAS unsigned*)(lds + (bufoff) + ldsw + _i * 8192), 16, 0, 0); } while (0)
#define rstep_voffA rstepA
#define rstep_voffB rstepB
#define PG8_LDA(dst, b, h) do { _Pragma("unroll") for (int m = 0; m < 4; ++m) _Pragma("unroll") for (int k = 0; k < 2; ++k) dst[m][k] = *(const PG8_LAS bf16x8*)(lds + PG8_SA(b, h) + aoff + m * 2048 + k * 1024); } while (0)
#define PG8_LDB(dst, b, h) do { _Pragma("unroll") for (int n = 0; n < 2; ++n) _Pragma("unroll") for (int k = 0; k < 2; ++k) dst[n][k] = *(const PG8_LAS bf16x8*)(lds + PG8_SB(b, h) + boff + n * 2048 + k * 1024); } while (0)
#define PG8_CAT(x, y) __builtin_shufflevector(__builtin_bit_cast(i32x4, x), __builtin_bit_cast(i32x4, y), 0, 1, 2, 3, 4, 5, 6, 7)
#define PG8_MMA(ai, bj, At, Bt) do { __builtin_amdgcn_s_setprio(1); \
        if constexpr (QM == 1) { _Pragma("unroll") for (int m = 0; m < 4; ++m) _Pragma("unroll") for (int n = 0; n < 2; ++n) \
            acc[ai][bj][m][n] = __builtin_amdgcn_mfma_scale_f32_16x16x128_f8f6f4(PG8_CAT(Bt[n][0], Bt[n][1]), PG8_CAT(At[m][0], At[m][1]), acc[ai][bj][m][n], 0, 0, 0, 0x7f7f7f7f, 0, 0x7f7f7f7f); } \
        else if constexpr (QM == 2) { _Pragma("unroll") for (int m = 0; m < 4; ++m) _Pragma("unroll") for (int n = 0; n < 2; ++n) _Pragma("unroll") for (int k = 0; k < 2; ++k) \
            acc[ai][bj][m][n] = __builtin_bit_cast(f32x4, __builtin_amdgcn_mfma_i32_16x16x64_i8(__builtin_bit_cast(i32x4, Bt[n][k]), __builtin_bit_cast(i32x4, At[m][k]), __builtin_bit_cast(i32x4, acc[ai][bj][m][n]), 0, 0, 0)); } \
        else { _Pragma("unroll") for (int m = 0; m < 4; ++m) _Pragma("unroll") for (int n = 0; n < 2; ++n) _Pragma("unroll") for (int k = 0; k < 2; ++k) \
            acc[ai][bj][m][n] = __builtin_amdgcn_mfma_f32_16x16x32_bf16(Bt[n][k], At[m][k], acc[ai][bj][m][n], 0, 0, 0); } \
        __builtin_amdgcn_s_setprio(0); } while (0)
#define PG8_WAIT_V(n) asm volatile("s_waitcnt vmcnt(" #n ")" ::: "memory")
#define PG8_WAIT_L(n) asm volatile("s_waitcnt lgkmcnt(" #n ")" ::: "memory")
#define PG8_BAR __builtin_amdgcn_s_barrier()
#define PG8_SCHED __builtin_amdgcn_sched_barrier(0)
    Unit cur, nxt; int ui = 0;
    if (!S.next(0, cur)) return;
    f32x4 acc[2][2][4][2];
#pragma unroll
    for (int a = 0; a < 2; ++a)
#pragma unroll
        for (int b = 0; b < 2; ++b)
#pragma unroll
            for (int m = 0; m < 4; ++m)
#pragma unroll
                for (int n = 0; n < 2; ++n) acc[a][b][m][n] = (f32x4){0.f, 0.f, 0.f, 0.f};
    bf16x8 At[4][2], B0[2][2], B1[2][2];
    const char* cA = cur.A; const char* cB = cur.B;
    S.a_ready(cur);
    if constexpr (SP2) {
        PG8_STAGE(PG8_SB(0, 0), cB, voffB); PG8_STAGE(PG8_SB(0, 1), cB + hstepB, voffB); PG8_STAGE(PG8_SA(0, 0), cA, voffA); PG8_STAGE(PG8_SA(0, 1), cA + hstepA, voffA);
        if (wr == 1) PG8_BAR;
        PG8_WAIT_V(2); PG8_BAR;
        PG8_STAGE(PG8_SB(1, 0), cB + kstep, voffB); PG8_STAGE(PG8_SA(1, 0), cA + kstep, voffA); PG8_STAGE(PG8_SB(1, 1), cB + hstepB + kstep, voffB);
        PG8_WAIT_V(6); PG8_BAR;
    } else {
        PG8_STAGE(PG8_SB(0, 0), cB, voffB); PG8_STAGE(PG8_SA(0, 0), cA, voffA); PG8_STAGE(PG8_SB(0, 1), cB + hstepB, voffB); PG8_STAGE(PG8_SA(0, 1), cA + hstepA, voffA);
        if (wr == 1) PG8_BAR;
        PG8_WAIT_V(4); PG8_BAR;
        PG8_STAGE(PG8_SB(1, 0), cB + kstep, voffB); PG8_STAGE(PG8_SA(1, 0), cA + kstep, voffA); PG8_STAGE(PG8_SB(1, 1), cB + hstepB + kstep, voffB);
        PG8_WAIT_V(6); PG8_BAR;
    }
    for (;;) {
        const bool has_next = S.next(ui + 1, nxt);
        const char* nA = has_next ? nxt.A : cA; const char* nB = has_next ? nxt.B : cB;
        for (int t = 0; t < nt; t += 2) {
            const bool last = (t == nt - 2);
            const char* a1 = cA + (size_t)(t + 1) * kstep;
            const char* a2 = last ? nA : cA + (size_t)(t + 2) * kstep; const char* b2 = last ? nB : cB + (size_t)(t + 2) * kstep;
            const char* a3 = a2 + kstep; const char* b3 = b2 + kstep;
            if (last && has_next) S.a_ready(nxt);
            if constexpr (SP2) {
            PG8_LDB(B0, 0, 0); PG8_LDB(B1, 0, 1); PG8_SCHED; PG8_LDA(At, 0, 0); PG8_STAGE(PG8_SA(1, 1), a1 + hstepA, voffA);
            PG8_WAIT_V(8); PG8_WAIT_L(0); PG8_BAR; PG8_MMA(0, 0, At, B0); PG8_MMA(0, 1, At, B1); PG8_BAR; PG8_SCHED;
            PG8_LDA(At, 0, 1); PG8_STAGE(PG8_SB(0, 0), b2, voffB); PG8_STAGE(PG8_SB(0, 1), b2 + hstepB, voffB); PG8_STAGE(PG8_SA(0, 0), a2, voffA);
            PG8_WAIT_V(8); PG8_WAIT_L(0); PG8_BAR; PG8_MMA(1, 0, At, B0); PG8_MMA(1, 1, At, B1); PG8_BAR; PG8_SCHED;
            PG8_LDB(B0, 1, 0); PG8_LDB(B1, 1, 1); PG8_SCHED; PG8_LDA(At, 1, 0); PG8_STAGE(PG8_SA(0, 1), a2 + hstepA, voffA);
            PG8_WAIT_V(8); PG8_WAIT_L(0); PG8_BAR; PG8_MMA(0, 0, At, B0); PG8_MMA(0, 1, At, B1); PG8_BAR; PG8_SCHED;
            PG8_LDA(At, 1, 1); PG8_STAGE(PG8_SB(1, 0), b3, voffB); PG8_STAGE(PG8_SB(1, 1), b3 + hstepB, voffB); PG8_STAGE(PG8_SA(1, 0), a3, voffA);
            PG8_WAIT_V(8); PG8_WAIT_L(0); PG8_BAR; PG8_MMA(1, 0, At, B0); PG8_MMA(1, 1, At, B1); PG8_BAR; PG8_SCHED;
            } else {
            PG8_LDB(B0, 0, 0); PG8_SCHED; PG8_LDA(At, 0, 0); PG8_STAGE(PG8_SA(1, 1), a1 + hstepA, voffA);
            PG8_WAIT_L(8); PG8_BAR; PG8_WAIT_L(0); PG8_MMA(0, 0, At, B0); PG8_BAR; PG8_SCHED;
            PG8_LDB(B1, 0, 1); PG8_STAGE(PG8_SB(0, 0), b2, voffB);
            PG8_BAR; PG8_WAIT_L(0); PG8_MMA(0, 1, At, B1); PG8_BAR;
            PG8_LDA(At, 0, 1); PG8_STAGE(PG8_SA(0, 0), a2, voffA);
            PG8_BAR; PG8_WAIT_L(0); PG8_MMA(1, 0, At, B0); PG8_BAR; PG8_SCHED;
            PG8_STAGE(PG8_SB(0, 1), b2 + hstepB, voffB);
            PG8_WAIT_V(6); PG8_BAR; PG8_MMA(1, 1, At, B1); PG8_BAR;
            PG8_LDB(B0, 1, 0); PG8_SCHED; PG8_LDA(At, 1, 0); PG8_STAGE(PG8_SA(0, 1), a2 + hstepA, voffA);
            PG8_WAIT_L(8); PG8_BAR; PG8_WAIT_L(0); PG8_MMA(0, 0, At, B0); PG8_BAR; PG8_SCHED;
            PG8_LDB(B1, 1, 1); PG8_STAGE(PG8_SB(1, 0), b3, voffB);
            PG8_BAR; PG8_WAIT_L(0); PG8_MMA(0, 1, At, B1); PG8_BAR;
            PG8_LDA(At, 1, 1); PG8_STAGE(PG8_SA(1, 0), a3, voffA);
            PG8_BAR; PG8_WAIT_L(0); PG8_MMA(1, 0, At, B0); PG8_BAR; PG8_SCHED;
            PG8_STAGE(PG8_SB(1, 1), b3 + hstepB, voffB);
            PG8_WAIT_V(6); PG8_BAR; PG8_MMA(1, 1, At, B1); PG8_BAR;
            }
        }
        if constexpr (ALIGN_EPI) { if (wr == 0) PG8_BAR; }
        if constexpr (!Epi::AFTER_DRAIN) { int l2_; asm volatile("v_mbcnt_lo_u32_b32 %0, -1, 0\n\tv_mbcnt_hi_u32_b32 %0, -1, %0" : "=v"(l2_)); E(acc, cur, wr, wc, l2_ & 15, l2_ >> 4); S.done(cur); }
        if (!has_next) break;
        if (!(Epi::KEEP && cur.aux < 2)) {
#pragma unroll
        for (int a = 0; a < 2; ++a)
#pragma unroll
            for (int b = 0; b < 2; ++b)
#pragma unroll
                for (int m = 0; m < 4; ++m)
#pragma unroll
                    for (int n = 0; n < 2; ++n) acc[a][b][m][n] = (f32x4){0.f, 0.f, 0.f, 0.f};
        }
        cur = nxt; cA = nA; cB = nB; ++ui;
        if constexpr (ALIGN_EPI) { if (wr == 1) PG8_BAR; }
    }
    PG8_WAIT_V(0);
    if constexpr (!ALIGN_EPI) { if (wr == 0) PG8_BAR; }
    PG8_BAR;
    if constexpr (Epi::AFTER_DRAIN) { E.fused(acc, cur, wr, wc, fr, fq, lds, wid, lane); S.done(cur); }
#undef PG8_SA
#undef PG8_SB
#undef PG8_STAGE
#undef rstep_voffA
#undef rstep_voffB
#undef PG8_LDA
#undef PG8_LDB
#undef PG8_MMA
#undef PG8_CAT
#undef PG8_WAIT_V
#undef PG8_WAIT_L
#undef PG8_BAR
#undef PG8_SCHED
}
}

namespace att {
typedef unsigned short bf16_t;
using bf16x8 = __attribute__((ext_vector_type(8))) short;
using s16x4  = __attribute__((ext_vector_type(4))) short;
using f32x16 = __attribute__((ext_vector_type(16))) float;
using f32x4  = __attribute__((ext_vector_type(4))) float;
using u32x4  = __attribute__((ext_vector_type(4))) unsigned;
constexpr int D = 128, NW = 8, QBLK = 32, KVBLK = 64;
constexpr float SCALE = 0.088388347648318440f;
constexpr float THR = 8.f;
constexpr int SDEPTH = 2;
constexpr size_t SHM_V = KVBLK * D * 2, SHM_K = KVBLK * D * 2, SHM_ATTN = 2 * SHM_V + 2 * SHM_K + NW * 64 * 4;
#define KSWZ(row, colB) ((row) * 256 + ((colB) ^ (((row) & 7) << 4)))
#define SBAR() __builtin_amdgcn_sched_barrier(0)
__device__ __forceinline__ int crow(int r, int hi) { return (r & 3) + 8 * (r >> 2) + 4 * hi; }
__device__ __forceinline__ unsigned cvtpk(float lo, float hi) { unsigned r; asm volatile("v_cvt_pk_bf16_f32 %0, %1, %2" : "=v"(r) : "v"(lo), "v"(hi)); return r; }
__device__ __forceinline__ bf16x8 ld8(const bf16_t* p) { return *reinterpret_cast<const bf16x8*>(p); }
__device__ __forceinline__ float b2f(short v) { return __uint_as_float(((unsigned)(unsigned short)v) << 16); }

__device__ __forceinline__ void partialSM(f32x16& p0, f32x16& p1, float& m_reg, float& mn, float& alpha) {
  constexpr float C = SCALE * 1.4426950408889634f;
  float pmax = p0[0]; for (int r = 1; r < 16; ++r) pmax = fmaxf(pmax, p0[r]); for (int r = 0; r < 16; ++r) pmax = fmaxf(pmax, p1[r]);
  { auto rr = __builtin_amdgcn_permlane32_swap(__float_as_uint(pmax), __float_as_uint(pmax), false, false);
    pmax = fmaxf(__uint_as_float(rr[0]), __uint_as_float(rr[1])); }
  if (__builtin_expect(__all(pmax - m_reg <= THR / SCALE), 1)) { mn = m_reg; alpha = 1.f; }
  else { mn = fmaxf(m_reg, pmax); alpha = __builtin_amdgcn_exp2f((m_reg - mn) * C); m_reg = mn; }
  float mnC = -mn * C;
  for (int r = 0; r < 16; ++r) p0[r] = fmaf(p0[r], C, mnC); for (int r = 0; r < 16; ++r) p1[r] = fmaf(p1[r], C, mnC);
  for (int r = 0; r < 16; ++r) p0[r] = __builtin_amdgcn_exp2f(p0[r]);
}
__device__ __forceinline__ void finishSM(f32x16& p0, f32x16& p1, float alpha, float& l_reg, bf16x8& pa0, bf16x8& pa1, bf16x8& pa2, bf16x8& pa3) {
  for (int r = 0; r < 16; ++r) p1[r] = __builtin_amdgcn_exp2f(p1[r]);
  float ps = 0; for (int r = 0; r < 16; ++r) ps += p0[r]; for (int r = 0; r < 16; ++r) ps += p1[r];
  { auto rr = __builtin_amdgcn_permlane32_swap(__float_as_uint(ps), __float_as_uint(ps), false, false);
    ps = __uint_as_float(rr[0]) + __uint_as_float(rr[1]); }
  l_reg = l_reg * alpha + ps;
#define PK4(P, BASE, OUT) do { unsigned a0 = cvtpk(P[BASE + 0], P[BASE + 1]), a1 = cvtpk(P[BASE + 2], P[BASE + 3]);   \
    unsigned b0 = cvtpk(P[BASE + 4], P[BASE + 5]), b1 = cvtpk(P[BASE + 6], P[BASE + 7]);                              \
    auto r0 = __builtin_amdgcn_permlane32_swap(a0, b0, false, false); auto r1 = __builtin_amdgcn_permlane32_swap(a1, b1, false, false); \
    u32x4 w = {r0[0], r1[0], r0[1], r1[1]}; OUT = *reinterpret_cast<bf16x8*>(&w); } while (0)
  PK4(p0, 0, pa0); PK4(p0, 8, pa1); PK4(p1, 0, pa2); PK4(p1, 8, pa3);
#undef PK4
}
__device__ __forceinline__ void qkt(f32x16& p0, f32x16& p1, const bf16_t* Ks, const bf16x8* qr, int r32, int hi) {
  p0 = f32x16{}; p1 = f32x16{};
  for (int d0 = 0; d0 < 8; ++d0) { int cb = (d0 * 16 + hi * 8) * 2;
    bf16x8 b0 = *reinterpret_cast<const bf16x8*>((const char*)Ks + KSWZ(r32, cb));
    bf16x8 b1 = *reinterpret_cast<const bf16x8*>((const char*)Ks + KSWZ(32 + r32, cb));
    p0 = __builtin_amdgcn_mfma_f32_32x32x16_bf16(b0, qr[d0], p0, 0, 0, 0);
    p1 = __builtin_amdgcn_mfma_f32_32x32x16_bf16(b1, qr[d0], p1, 0, 0, 0); }
}
__device__ __forceinline__ int v_st(int k, int c) { const int kk = (k & ~0xC) | ((k & 4) << 1) | ((k & 8) >> 1); return ((kk >> 3) * 4 + (c >> 5)) * 512 + ((kk & 7) * 32 + (c & 31)) * 2; }
__device__ __forceinline__ int v_rd_base(int lane) { return ((lane & 3) << 3) | (((lane >> 2) & 3) << 6) | (((lane >> 4) & 1) << 5) | (((lane >> 5) & 1) << 8); }
constexpr int v_rd_off(int d0, int ks, int half) { return d0 * 512 + ks * 4096 + half * 2048; }
template <int OFF> __device__ __forceinline__ s16x4 tr_read(int vb) {
  s16x4 r; asm volatile("ds_read_b64_tr_b16 %0, %1 offset:%2" : "=&v"(r) : "v"(vb), "i"(OFF) : "memory"); return r;
}
template <int D0> __device__ __forceinline__ void pv_one(f32x16& od, int vb, bf16x8 pa0, bf16x8 pa1, bf16x8 pa2, bf16x8 pa3) {
  const s16x4 l0 = tr_read<v_rd_off(D0, 0, 0)>(vb), h0 = tr_read<v_rd_off(D0, 0, 1)>(vb), l1 = tr_read<v_rd_off(D0, 1, 0)>(vb), h1 = tr_read<v_rd_off(D0, 1, 1)>(vb);
  const s16x4 l2 = tr_read<v_rd_off(D0, 2, 0)>(vb), h2 = tr_read<v_rd_off(D0, 2, 1)>(vb), l3 = tr_read<v_rd_off(D0, 3, 0)>(vb), h3 = tr_read<v_rd_off(D0, 3, 1)>(vb);
  asm volatile("s_waitcnt lgkmcnt(0)" ::: "memory"); SBAR();
#define PK(L, H) (bf16x8){L[0], L[1], L[2], L[3], H[0], H[1], H[2], H[3]}
  od = __builtin_amdgcn_mfma_f32_32x32x16_bf16(pa0, PK(l0, h0), od, 0, 0, 0);
  od = __builtin_amdgcn_mfma_f32_32x32x16_bf16(pa1, PK(l1, h1), od, 0, 0, 0);
  od = __builtin_amdgcn_mfma_f32_32x32x16_bf16(pa2, PK(l2, h2), od, 0, 0, 0);
  od = __builtin_amdgcn_mfma_f32_32x32x16_bf16(pa3, PK(l3, h3), od, 0, 0, 0);
#undef PK
}
__device__ __forceinline__ void pv_d0(f32x16* o, int vb, bf16x8 pa0, bf16x8 pa1, bf16x8 pa2, bf16x8 pa3) {
  pv_one<0>(o[0], vb, pa0, pa1, pa2, pa3); pv_one<1>(o[1], vb, pa0, pa1, pa2, pa3); pv_one<2>(o[2], vb, pa0, pa1, pa2, pa3); pv_one<3>(o[3], vb, pa0, pa1, pa2, pa3);
}

__device__ __forceinline__ void attn_unit(const bf16_t* __restrict__ Qb, int ldq, const bf16_t* __restrict__ K0, const bf16_t* __restrict__ K1, const bf16_t* __restrict__ V0, const bf16_t* __restrict__ V1,
                                          int n0, int NT, int ldk, int ldv, bf16_t* __restrict__ Ob, int ldo, const float* __restrict__ qgain, const float* __restrict__ rope_cs, char* lds, int tid) {
  asm volatile("" : "+v"(tid));
  const int wid = tid >> 6, lane = tid & 63, r32 = lane & 31, hi = lane >> 5;
  bf16_t* V_lds = (bf16_t*)lds; bf16_t* K_lds = (bf16_t*)(lds + 2 * SHM_V);
  float* ws = (float*)(lds + 2 * SHM_V + 2 * SHM_K) + wid * 64; float* li_l = ws; float* al_l = ws + 32;
  float m_reg = -1e30f, l_reg = 0; f32x16 o[4] = {}; bf16x8 qr[8];
  const bf16_t* Qw = Qb + (long)(wid * QBLK + r32) * ldq + hi * 8;
#pragma unroll
  for (int d0 = 0; d0 < 8; ++d0) qr[d0] = ld8(Qw + d0 * 16);
  {
    float ss = 0.f;
#pragma unroll
    for (int d0 = 0; d0 < 8; ++d0)
#pragma unroll
      for (int j = 0; j < 8; ++j) { const float f = b2f(qr[d0][j]); ss += f * f; }
    { auto rr = __builtin_amdgcn_permlane32_swap(__float_as_uint(ss), __float_as_uint(ss), false, false); ss = __uint_as_float(rr[0]) + __uint_as_float(rr[1]); }
    const float rstd = 1.0f / sqrtf(ss * (1.0f / 128.0f) + 1e-6f);
#pragma unroll
    for (int d0 = 0; d0 < 4; ++d0) {
      const int i0 = d0 * 16 + hi * 8;
      const f32x4 ga0 = *(const f32x4*)(qgain + i0), ga1 = *(const f32x4*)(qgain + i0 + 4), gb0 = *(const f32x4*)(qgain + 64 + i0), gb1 = *(const f32x4*)(qgain + 64 + i0 + 4);
      float a[8], b[8];
#pragma unroll
      for (int j = 0; j < 8; ++j) { a[j] = b2f(qr[d0][j]) * rstd * (j < 4 ? ga0[j & 3] : ga1[j & 3]); b[j] = b2f(qr[d0 + 4][j]) * rstd * (j < 4 ? gb0[j & 3] : gb1[j & 3]); }
      if (rope_cs) {
        const float* cp = rope_cs + (long)(wid * QBLK + r32) * 64 + i0;
        const f32x4 c0 = *(const f32x4*)cp, c1 = *(const f32x4*)(cp + 4), s0 = *(const f32x4*)(cp + 2048 * 64), s1 = *(const f32x4*)(cp + 2048 * 64 + 4);
#pragma unroll
        for (int j = 0; j < 8; ++j) { const float c = j < 4 ? c0[j & 3] : c1[j & 3], s = j < 4 ? s0[j & 3] : s1[j & 3]; const float na = a[j] * c - b[j] * s, nb = b[j] * c + a[j] * s; a[j] = na; b[j] = nb; }
      }
      u32x4 wa = {cvtpk(a[0], a[1]), cvtpk(a[2], a[3]), cvtpk(a[4], a[5]), cvtpk(a[6], a[7])}, wb = {cvtpk(b[0], b[1]), cvtpk(b[2], b[3]), cvtpk(b[4], b[5]), cvtpk(b[6], b[7])};
      qr[d0] = *reinterpret_cast<bf16x8*>(&wa); qr[d0 + 4] = *reinterpret_cast<bf16x8*>(&wb);
    }
  }
  const int sr = tid >> 4, sc = (tid & 15) * 8, vst0 = v_st(sr, sc), vst1 = v_st(32 + sr, sc);
  const int vb0 = (int)(uintptr_t)V_lds + v_rd_base(lane);
  struct { bf16x8 vs0, vs1, ks0, ks1; } sr_[SDEPTH];
#define SLOAD(i, tile) do { const int tl_ = (tile); const bf16_t* kp_ = tl_ < n0 ? K0 + (long)tl_ * KVBLK * ldk : K1 + (long)(tl_ - n0) * KVBLK * ldk; \
    const bf16_t* vp_ = tl_ < n0 ? V0 + (long)tl_ * KVBLK * ldv : V1 + (long)(tl_ - n0) * KVBLK * ldv; \
    sr_[i].vs0 = ld8(vp_ + (long)sr * ldv + sc); sr_[i].vs1 = ld8(vp_ + (long)(32 + sr) * ldv + sc); \
    sr_[i].ks0 = ld8(kp_ + (long)sr * ldk + sc); sr_[i].ks1 = ld8(kp_ + (long)(32 + sr) * ldk + sc); } while (0)
#define SWRITE(b, i) do { *(bf16x8*)((char*)V_lds + (b) * SHM_V + vst0) = sr_[i].vs0;          \
    *(bf16x8*)((char*)V_lds + (b) * SHM_V + vst1) = sr_[i].vs1; int kc = sc * 2;               \
    *(bf16x8*)((char*)K_lds + (b) * SHM_K + KSWZ(sr, kc)) = sr_[i].ks0;                       \
    *(bf16x8*)((char*)K_lds + (b) * SHM_K + KSWZ(32 + sr, kc)) = sr_[i].ks1; } while (0)
#define SWAIT() asm volatile("s_waitcnt vmcnt(4)" ::: "memory")
#define RESC(a) do { if (__any((a) < 1.f)) { if (hi == 0) al_l[r32] = (a); asm volatile("s_waitcnt lgkmcnt(0)" ::: "memory"); \
    for (int d = 0; d < 4; ++d) for (int r = 0; r < 16; ++r) o[d][r] *= al_l[crow(r, hi)]; } } while (0)
  f32x16 pA0, pA1, pB0, pB1; float mnA, mnB, alA, alB; bf16x8 pa0, pa1, pa2, pa3;
  constexpr int SE = 0, SO = SDEPTH - 1;
  SLOAD(SE, 0); asm volatile("s_waitcnt vmcnt(0)" ::: "memory"); SWRITE(0, SE); __syncthreads();
  qkt(pA0, pA1, K_lds, qr, r32, hi); partialSM(pA0, pA1, m_reg, mnA, alA);
  SLOAD(SO, 1); if (2 < NT) SLOAD(SE, 2);
  SWAIT(); SWRITE(1, SO); __syncthreads();
  for (int j = 1; j + 1 < NT; j += 2) {
    SBAR(); qkt(pB0, pB1, (bf16_t*)((char*)K_lds + SHM_K), qr, r32, hi);
    finishSM(pA0, pA1, alA, l_reg, pa0, pa1, pa2, pa3); SBAR();
    SLOAD(SO, j + SDEPTH); SBAR();
    pv_d0(o, vb0, pa0, pa1, pa2, pa3); partialSM(pB0, pB1, m_reg, mnB, alB);
    __syncthreads(); SWAIT(); SWRITE(0, SE);
    RESC(alB); __syncthreads();
    SBAR(); qkt(pA0, pA1, K_lds, qr, r32, hi);
    finishSM(pB0, pB1, alB, l_reg, pa0, pa1, pa2, pa3); SBAR();
    if (j + 3 < NT) SLOAD(SE, j + 1 + SDEPTH); SBAR();
    pv_d0(o, vb0 + (int)SHM_V, pa0, pa1, pa2, pa3); partialSM(pA0, pA1, m_reg, mnA, alA);
    __syncthreads(); SWAIT(); SWRITE(1, SO);
    RESC(alA); __syncthreads();
  }
  SBAR(); qkt(pB0, pB1, (bf16_t*)((char*)K_lds + SHM_K), qr, r32, hi);
  finishSM(pA0, pA1, alA, l_reg, pa0, pa1, pa2, pa3); SBAR();
  pv_d0(o, vb0, pa0, pa1, pa2, pa3); partialSM(pB0, pB1, m_reg, mnB, alB);
  __syncthreads(); RESC(alB);
  finishSM(pB0, pB1, alB, l_reg, pa0, pa1, pa2, pa3); SBAR();
  pv_d0(o, vb0 + (int)SHM_V, pa0, pa1, pa2, pa3);
  if (hi == 0) li_l[r32] = l_reg; asm volatile("s_waitcnt lgkmcnt(0)" ::: "memory");
  float rli[16];
#pragma unroll
  for (int r = 0; r < 16; ++r) rli[r] = __builtin_amdgcn_rcpf(li_l[crow(r, hi)]);
  bf16_t* Ow = Ob + (long)(wid * QBLK) * ldo;
  {
    char* stg = lds + SHM_ATTN + wid * 8704;
#pragma unroll
    for (int r = 0; r < 16; ++r) { const int orow = crow(r, hi);
#pragma unroll
      for (int d0 = 0; d0 < 4; ++d0) *(bf16_t*)(stg + orow * 272 + (d0 * 32 + r32) * 2) = (bf16_t)(cvtpk(o[d0][r] * rli[r], 0.f) & 0xffffu); }
    asm volatile("s_waitcnt lgkmcnt(0)" ::: "memory");
#pragma unroll
    for (int i = 0; i < 8; ++i) { const int row = i * 4 + (lane >> 4), ch = lane & 15; const u32x4 v = *(const u32x4*)(stg + row * 272 + ch * 16); *(u32x4*)(Ow + (long)row * ldo + ch * 8) = v; }
  }
#undef SLOAD
#undef SWRITE
#undef SWAIT
#undef RESC
  __syncthreads();
}
#undef KSWZ
#undef SBAR
}

constexpr int NWAVES = 8;
constexpr int DM = 2048, NB = 8, SEQ = 2048, DEPTH = 4, CTXL = 256, DBR = 1024, DFF = 5632;
constexpr int ML = NB * SEQ, MC = NB * CTXL, MT = ML + MC;
constexpr int LDY = 4608, YQ = 0, YK = 1024, YV = 1280, YUX = 1536, YUG = 2560, YUF = 3584;
constexpr int LDG = 6144;
constexpr float NEPS = 1e-6f;
constexpr size_t MiB = 1u << 20;
constexpr size_t WS_CTL = 0, CTL_ZERO_BYTES = 1 * MiB;
constexpr size_t WS_MOD = 1 * MiB, WS_ROPE = 3 * MiB, WS_WLT = 4 * MiB, WS_CST = 6 * MiB, WS_SPT = 6 * MiB + 131072, WS_DFTC = 7 * MiB, WS_DFTL = 8 * MiB, WS_TW = 9 * MiB;
constexpr size_t WS_W = 24 * MiB, W_LAYER = 128 * MiB, WO_W1 = 0, WO_W8 = (size_t)4608 * 2048 * 2  , WO_WB = 42 * MiB, WO_WO = 54 * MiB, WO_WFI = 62 * MiB, WO_WFO = 106 * MiB;
constexpr size_t WS_X = 536 * MiB, WS_H = 680 * MiB, WS_Y1 = 752 * MiB, WS_G = 914 * MiB, WS_ACT = WS_G, WS_KN = 1130 * MiB;
constexpr size_t WS_PTL = 1139 * MiB, WS_BRS = WS_PTL, WS_PTC = 1203 * MiB, WS_ATT = 1211 * MiB, WS_REC = 1247 * MiB, WS_FOU = 1283 * MiB, WS_MG = 1319 * MiB, WS_SLAB = 1391 * MiB, WS_WBR = 1455 * MiB, WS_END = 1471 * MiB;
static_assert((size_t)MT * DBR * 2 == 36 * MiB && (size_t)MT * LDY * 2 == 162 * MiB && (size_t)MT * LDG * 2 == 216 * MiB && (size_t)MT * DM * 4 == 144 * MiB, "ws map");
constexpr int CMAX_L = 6144 + 4608;
constexpr size_t WO_UF8 = (size_t)1536 * 2048;
constexpr size_t WS_CMAX = 256 * 1024  , WS_SH = 512 * 1024  ;
constexpr size_t WS_H8 = WS_MG;
constexpr int CW_BAR = 4096;
constexpr int RING_BYTES = 147456;
constexpr int LDSCTL_OFF = RING_BYTES, MISC_OFF = LDSCTL_OFF + 320;
constexpr int LDS_BYTES = RING_BYTES + 1024;

#define GAS __attribute__((address_space(1)))
#define LAS __attribute__((address_space(3)))
typedef unsigned short bf16;
typedef unsigned v4u __attribute__((ext_vector_type(4)));
typedef float f32x4 __attribute__((ext_vector_type(4)));
typedef short bf16x8 __attribute__((ext_vector_type(8)));
typedef GAS unsigned gu32;
typedef GAS unsigned long long gu64;
#define RLX_AGENT __ATOMIC_RELAXED, __HIP_MEMORY_SCOPE_AGENT
#define LDS_WAIT() asm volatile("s_waitcnt lgkmcnt(0)" ::: "memory")
#define VM_WAIT() asm volatile("s_waitcnt vmcnt(0)" ::: "memory")
__device__ __forceinline__ unsigned long long rt() { return __builtin_amdgcn_s_memrealtime(); }
__device__ __forceinline__ unsigned f2bf(float f) { unsigned u = __builtin_bit_cast(unsigned, f); return (u + 0x7fffu + ((u >> 16) & 1u)) >> 16; }
__device__ __forceinline__ unsigned pk2(float lo, float hi) { return f2bf(lo) | (f2bf(hi) << 16); }

#define XB_TMO      128
#define XB_XCNT(j)  (256  + 64 * (j))
#define XB_XSUB(j)  (1280 + 64 * (j))
#define XB_XGEN(j)  (2304 + 64 * (j))
#define XB_TOP      3328
#define XB_TOPGEN   3392
#define XCD_BAR_WORDS 3456
#define XB_SPIN_CAP (1u << 18)

__device__ __forceinline__ unsigned xb_ld(unsigned* p)              { return __hip_atomic_load(p, __ATOMIC_RELAXED, __HIP_MEMORY_SCOPE_AGENT); }
__device__ __forceinline__ unsigned xb_add(unsigned* p, unsigned v) { return __hip_atomic_fetch_add(p, v, __ATOMIC_RELAXED, __HIP_MEMORY_SCOPE_AGENT); }
__device__ __forceinline__ unsigned xb_xcc_id() { return (unsigned)__builtin_amdgcn_s_getreg((3 << 11) | 20) & 0xFu; }
#define XB_SPIN(cond, bar) do { unsigned _sp = 0; while (cond) { __builtin_amdgcn_s_sleep(1); \
    if ((++_sp & 255u) == 0u) { if (xb_ld(&(bar)[XB_TMO])) break; if (_sp > XB_SPIN_CAP) { atomicAdd(&(bar)[XB_TMO], 1u); break; } } } } while (0)

struct XcdBarrier {
    unsigned* bar; unsigned x;
    volatile LAS unsigned* st;
};

__device__ __forceinline__ XcdBarrier xcd_barrier_post(unsigned* bar, volatile LAS unsigned* st) {
    XcdBarrier b; b.bar = bar; b.x = xb_xcc_id(); b.st = st;
    if (threadIdx.x == 0) (void)xb_add(&bar[XB_XCNT(b.x)], 1u);
    return b;
}
__device__ __forceinline__ void xcd_barrier_complete(unsigned* bar, unsigned x, unsigned& nloc, unsigned& nx) {
    const unsigned G = gridDim.x * gridDim.y * gridDim.z;
    unsigned sum, cnt, mine, sp = 0u;
    for (;;) {
        sum = 0u; cnt = 0u; mine = 0u;
#pragma unroll
        for (unsigned j = 0; j < 16; ++j) { const unsigned c = xb_ld(&bar[XB_XCNT(j)]); sum += c; cnt += (c > 0u) ? 1u : 0u; mine = (j == x) ? c : mine; }
        if (sum == G) break;
        __builtin_amdgcn_s_sleep(1);
        if ((++sp & 255u) == 0u) { if (xb_ld(&bar[XB_TMO])) break; if (sp > XB_SPIN_CAP) { atomicAdd(&bar[XB_TMO], 1u); break; } }
    }
    nloc = mine > 0u ? mine : 1u; nx = cnt > 0u ? cnt : 1u;
}

__device__ __forceinline__ void xcd_barrier(const XcdBarrier& b, const bool is_thread0) {
    asm volatile("s_waitcnt vmcnt(0)" ::: "memory");
    __syncthreads();
    if (is_thread0) {
        unsigned* bar = b.bar;
        __builtin_amdgcn_s_waitcnt(0);
        unsigned nloc = b.st[0], nx = b.st[1];
        if (nloc == 0u) { xcd_barrier_complete(bar, b.x, nloc, nx); b.st[0] = nloc; b.st[1] = nx; }
        const unsigned old = xb_add(&bar[XB_XSUB(b.x)], 1u);
        const unsigned gen = old / nloc;
        if (old + 1u == (gen + 1u) * nloc) {
            __builtin_amdgcn_fence(__ATOMIC_RELEASE, "agent");
            asm volatile("s_waitcnt vmcnt(0)" ::: "memory");
            const unsigned og = xb_add(&bar[XB_TOP], 1u);
            const unsigned tg = og / nx;
            if (og + 1u == (tg + 1u) * nx) xb_add(&bar[XB_TOPGEN], 1u);
            else XB_SPIN(xb_ld(&bar[XB_TOPGEN]) == tg, bar);
            __builtin_amdgcn_fence(__ATOMIC_ACQUIRE, "agent");
            xb_add(&bar[XB_XGEN(b.x)], 1u);
            asm volatile("s_waitcnt vmcnt(0)" ::: "memory");
        } else {
            XB_SPIN(xb_ld(&bar[XB_XGEN(b.x)]) == gen, bar);
            __builtin_amdgcn_fence(__ATOMIC_ACQUIRE, "agent");
            asm volatile("s_waitcnt vmcnt(0)" ::: "memory");
        }
    }
    __syncthreads();
}

using pg8::bf2f; using pg8::cvt_pk_bf16; using pg8::sigm; using pg8::bflo; using pg8::bfhi;
typedef float f32x16 __attribute__((ext_vector_type(16)));
typedef unsigned u32x2 __attribute__((ext_vector_type(2)));
__device__ __forceinline__ float dpp_f(float v, const int ctrl_sel) {
    const int x = __builtin_bit_cast(int, v); int r;
    if (ctrl_sel == 0) r = __builtin_amdgcn_mov_dpp(x, 0xB1, 0xF, 0xF, false); else if (ctrl_sel == 1) r = __builtin_amdgcn_mov_dpp(x, 0x4E, 0xF, 0xF, false);
    else if (ctrl_sel == 2) r = __builtin_amdgcn_mov_dpp(x, 0x141, 0xF, 0xF, false); else r = __builtin_amdgcn_mov_dpp(x, 0x140, 0xF, 0xF, false);
    return __builtin_bit_cast(float, r);
}
__device__ __forceinline__ float wave_max(float v) {
    v = fmaxf(v, dpp_f(v, 0)); v = fmaxf(v, dpp_f(v, 1)); v = fmaxf(v, dpp_f(v, 2)); v = fmaxf(v, dpp_f(v, 3));
    const int x = __builtin_bit_cast(int, v);
    const float r0 = __builtin_bit_cast(float, __builtin_amdgcn_readlane(x, 0)), r1 = __builtin_bit_cast(float, __builtin_amdgcn_readlane(x, 16));
    const float r2 = __builtin_bit_cast(float, __builtin_amdgcn_readlane(x, 32)), r3 = __builtin_bit_cast(float, __builtin_amdgcn_readlane(x, 48));
    return fmaxf(fmaxf(r0, r1), fmaxf(r2, r3));
}
__device__ __forceinline__ unsigned pack_i8x4(float a, float b, float c, float d, float inv) {
    const unsigned fa = __float_as_uint(fmaf(a, inv, 12582912.0f)), fb = __float_as_uint(fmaf(b, inv, 12582912.0f)), fc = __float_as_uint(fmaf(c, inv, 12582912.0f)), fd = __float_as_uint(fmaf(d, inv, 12582912.0f));
    const unsigned p01 = __builtin_amdgcn_perm(fb, fa, 0x0c0c0400u), p23 = __builtin_amdgcn_perm(fd, fc, 0x0c0c0400u);
    return __builtin_amdgcn_perm(p23, p01, 0x05040100u);
}
__device__ __forceinline__ float wave_sum(float v) {
    v += dpp_f(v, 0); v += dpp_f(v, 1); v += dpp_f(v, 2); v += dpp_f(v, 3);
    const int x = __builtin_bit_cast(int, v);
    const float r0 = __builtin_bit_cast(float, __builtin_amdgcn_readlane(x, 0)), r1 = __builtin_bit_cast(float, __builtin_amdgcn_readlane(x, 16));
    const float r2 = __builtin_bit_cast(float, __builtin_amdgcn_readlane(x, 32)), r3 = __builtin_bit_cast(float, __builtin_amdgcn_readlane(x, 48));
    return (r0 + r1) + (r2 + r3);
}
__device__ __forceinline__ float silu_f(float x) { return x / (1.0f + __expf(-x)); }
__device__ __forceinline__ float gelu_tanh(float x) { return x * sigm(1.5957691216057308f * (x + 0.044715f * x * x * x)); }

struct Params {
    const float *x, *c, *ctx, *c_ctx, *w_mod, *b_mod, *g_norm1, *g_norm2, *w_in, *q_gain, *k_gain, *conv_w, *conv_b, *lru_w_r, *lru_b_r, *lru_w_i, *lru_b_i, *lru_lambda,
                *w_branch, *w_gate, *b_gate, *w_out, *w_ffn_in, *w_ffn_out, *g_final;
    float* out; unsigned char* ws; int ph_lo, ph_hi;
};
typedef const __attribute__((address_space(4))) Params* KP;
__device__ __forceinline__ KP fresh_kp() { KP p = (KP)__builtin_amdgcn_kernarg_segment_ptr(); asm volatile("" : "+s"(p)); return p; }

__device__ __forceinline__ void tr_item(const float* W, int ldn, bf16* WT, int ldk, int k0, int n0, int drow0, LAS float* scr, int lane, bool rev = false) {
#pragma unroll 8
    for (int i = 0; i < 32; ++i) { const int kk = 2 * i + (lane >> 5); const int ks = k0 + kk, sr = rev ? ((ks & ~127) | ((128 - (ks & 127)) & 127)) : ks;
        scr[kk * 33 + (lane & 31)] = W[(size_t)sr * ldn + n0 + (lane & 31)]; }
    LDS_WAIT(); asm volatile("" ::: "memory");
    const int c = lane & 7;
#pragma unroll
    for (int j = 0; j < 4; ++j) { const int n = (lane >> 3) + 8 * j; const LAS float* s = scr + (8 * c) * 33 + n;
        v4u o; o.x = pk2(s[0 * 33], s[1 * 33]); o.y = pk2(s[2 * 33], s[3 * 33]); o.z = pk2(s[4 * 33], s[5 * 33]); o.w = pk2(s[6 * 33], s[7 * 33]);
        *(v4u*)(WT + (size_t)(drow0 + n) * ldk + k0 + 8 * c) = o; }
    LDS_WAIT(); asm volatile("" ::: "memory");
}

__device__ __forceinline__ void p0_prologue(KP P, LAS unsigned char* lds, int tid, int lane, int wave, int vcu, int G, int dupA, int dupB, int dupC) {
    unsigned char* ws = P->ws;
    {
        LAS float* SC = (LAS float*)lds;
        LAS float* red = (LAS float*)(lds + 73728);
        for (int i = tid; i < 9 * 2048; i += 512) { const int r = i >> 11, k = i & 2047; const float v = r < 8 ? P->c[r * 2048 + k] : P->c_ctx[k]; SC[i] = silu_f(v); }
        __syncthreads();
        float* MOD = (float*)(ws + WS_MOD);
        for (int unit_ = vcu; unit_ < 4 * 192 * dupA; unit_ += G) { const int unit = unit_ % 768;
            const int l = unit / 192, n0 = (unit % 192) * 64;
            const float* wp = P->w_mod + ((size_t)l * 2048 + wave * 256) * 12288 + n0 + lane;
            float acc[9];
#pragma unroll
            for (int r = 0; r < 9; ++r) acc[r] = 0.f;
            for (int k8 = 0; k8 < 256; k8 += 32) {
                float wv[32];
#pragma unroll
                for (int j = 0; j < 32; ++j) wv[j] = wp[(size_t)(k8 + j) * 12288];
#pragma unroll
                for (int j = 0; j < 32; ++j)
#pragma unroll
                    for (int r = 0; r < 9; ++r) acc[r] += SC[r * 2048 + wave * 256 + k8 + j] * wv[j];
            }
#pragma unroll
            for (int r = 0; r < 9; ++r) red[(wave * 9 + r) * 64 + lane] = acc[r];
            __syncthreads();
            for (int i = tid; i < 9 * 64; i += 512) { const int r = i >> 6, ln = i & 63; float s = 0.f;
#pragma unroll
                for (int w = 0; w < 8; ++w) s += red[(w * 9 + r) * 64 + ln];
                MOD[((size_t)l * 9 + r) * 12288 + n0 + ln] = s + P->b_mod[l * 12288 + n0 + ln]; }
            __syncthreads();
        }
    }
    {
        LAS float* scr = (LAS float*)(lds + wave * 16384);
        const int gw = vcu * NWAVES + wave, NGW = G * NWAVES;
        constexpr int PER_L = 32768 + 1024, NIT = 4 * PER_L + 512;
        for (int it_ = gw; it_ < NIT * dupB; it_ += NGW) { const int it = it_ % NIT;
            if (it < 4 * PER_L) {
                const int l = it / PER_L; int r = it % PER_L;
                unsigned char* wl = ws + WS_W + (size_t)l * W_LAYER;
                if (r < 4608) { const int kb = r / 144, nb = r % 144; if (nb < 48 || nb >= 112) continue;
                    tr_item(P->w_in + (size_t)l * 2048 * 4608, 4608, (bf16*)(wl + WO_W1), 2048, kb * 64, nb * 32, nb * 32, scr, lane); continue; } r -= 4608;
                if (r < 6144) { const int kb = r / 192, nb = r % 192; continue; }        r -= 6144;
                if (r < 3072) { const int br = r / 1024, rr = r % 1024, kb = rr / 64, nb = rr % 64;
                    tr_item(P->w_branch + ((size_t)l * 3 + br) * 1024 * 2048, 2048, (bf16*)(wl + WO_WB) + (size_t)br * 2048 * 1024, 1024, kb * 64, nb * 32, nb * 32, scr, lane); continue; } r -= 3072;
                if (r < 2048) { const int kb = r / 64, nb = r % 64; tr_item(P->w_out + (size_t)l * 2048 * 2048, 2048, (bf16*)(wl + WO_WO), 2048, kb * 64, nb * 32, nb * 32, scr, lane); continue; } r -= 2048;
                if (r < 11264) { const int kb = r / 352, nb = r % 352, n0 = nb * 32, half = n0 / 5632, j = n0 % 5632, pn = j / 128, jj = j % 128;
                    tr_item(P->w_ffn_in + (size_t)l * 2048 * 11264, 11264, (bf16*)(wl + WO_WFI), 2048, kb * 64, n0, pn * 256 + half * 128 + jj, scr, lane); continue; } r -= 11264;
                if (r < 5632) { const int kb = r / 64, nb = r % 64; tr_item(P->w_ffn_out + (size_t)l * 5632 * 2048, 2048, (bf16*)(wl + WO_WFO), 5632, kb * 64, nb * 32, nb * 32, scr, lane); continue; } r -= 5632;
                { const int kb = r / 64, nb = r % 64; tr_item(P->w_branch + ((size_t)l * 3 + 2) * 1024 * 2048, 2048, (bf16*)(ws + WS_WBR + (size_t)l * 4 * MiB), 1024, kb * 64, nb * 32, nb * 32, scr, lane, true); }
            } else {
                const int r = it - 4 * PER_L, mat = r >> 1, nb = r & 1, gate = mat & 1, ldn = mat >> 1;
                const float* W = (gate ? P->lru_w_i : P->lru_w_r) + (size_t)ldn * 4096;
                tr_item(W, 64, (bf16*)(ws + WS_WLT) + (size_t)mat * 4096, 64, 0, nb * 32, nb * 32, scr, lane);
            }
        }
    }
    {
        __syncthreads();
        LAS float* scr = (LAS float*)(lds + wave * 16384);
        LAS float* red = (LAS float*)(lds + 131072);
        unsigned* CM = (unsigned*)(ws + WS_CMAX);
        const int c = lane & 15, rg = lane >> 4;
        for (int it = vcu; it < 4 * (384 + 96 + 64); it += G) {
            const int l = it / 544, r = it % 544; const bool gatew = r < 384, ufw = r >= 480; const int n0 = gatew ? r * 16 : (ufw ? 3584 + (r - 480) * 16 : (r - 384) * 16);
            const int nd = ufw ? (r - 480) * 16 : n0;
            const float* W = gatew ? P->w_gate + (size_t)l * 2048 * 6144 : P->w_in + (size_t)l * 2048 * 4608; const int ldn = gatew ? 6144 : 4608;
            unsigned char* W8 = ws + WS_W + (size_t)l * W_LAYER + (gatew ? WO_W8 : (ufw ? WO_W1 + WO_UF8 : WO_W1));
            const int cidx = l * CMAX_L + (gatew ? 0 : 6144) + n0;
            float r_[64];
#pragma unroll
            for (int i = 0; i < 64; ++i) r_[i] = W[(size_t)(wave * 256 + 4 * i + rg) * ldn + n0 + c];
            float mx = 0.f;
#pragma unroll
            for (int i = 0; i < 64; ++i) mx = fmaxf(mx, fabsf(r_[i]));
            red[wave * 64 + lane] = mx;
            __syncthreads();
            float m = 0.f;
#pragma unroll
            for (int w = 0; w < 8; ++w)
#pragma unroll
                for (int g4 = 0; g4 < 4; ++g4) m = fmaxf(m, red[w * 64 + g4 * 16 + c]);
            m = fmaxf(m, 1e-30f); const float inv = 127.0f / m;
            if (wave == 0 && rg == 0) CM[cidx + c] = __float_as_uint(m);
#pragma unroll
            for (int h = 0; h < 2; ++h) {
#pragma unroll
                for (int i = 0; i < 32; ++i) scr[(4 * i + rg) * 17 + c] = r_[32 * h + i];
                LDS_WAIT(); asm volatile("" ::: "memory");
                const LAS float* sp = scr + (32 * rg) * 17 + c;
                v4u o0, o1;
                o0.x = pack_i8x4(sp[0 * 17], sp[1 * 17], sp[2 * 17], sp[3 * 17], inv); o0.y = pack_i8x4(sp[4 * 17], sp[5 * 17], sp[6 * 17], sp[7 * 17], inv);
                o0.z = pack_i8x4(sp[8 * 17], sp[9 * 17], sp[10 * 17], sp[11 * 17], inv); o0.w = pack_i8x4(sp[12 * 17], sp[13 * 17], sp[14 * 17], sp[15 * 17], inv);
                o1.x = pack_i8x4(sp[16 * 17], sp[17 * 17], sp[18 * 17], sp[19 * 17], inv); o1.y = pack_i8x4(sp[20 * 17], sp[21 * 17], sp[22 * 17], sp[23 * 17], inv);
                o1.z = pack_i8x4(sp[24 * 17], sp[25 * 17], sp[26 * 17], sp[27 * 17], inv); o1.w = pack_i8x4(sp[28 * 17], sp[29 * 17], sp[30 * 17], sp[31 * 17], inv);
                unsigned char* dp = W8 + (size_t)(nd + c) * 2048 + wave * 256 + 128 * h + 32 * rg;
                *(v4u*)dp = o0; *(v4u*)(dp + 16) = o1;
                LDS_WAIT(); asm volatile("" ::: "memory");
            }
            __syncthreads();
        }
    }
    {
        const int gid = vcu * 512 + tid, NT = G * 512;
        float* ROPE = (float*)(ws + WS_ROPE);
        for (int i = gid; i < 2048 * 64; i += NT) { const int t = i >> 6, j = i & 63; const float pos = (float)(j < 32 ? (t >> 6) : (t & 63));
            const float inv = exp2f(-(float)(j & 31) * (13.287712379549449f / 32.0f)); const float ang = pos * inv; ROPE[i] = cosf(ang); ROPE[2048 * 64 + i] = sinf(ang); }
        float* SPT = (float*)(ws + WS_SPT);
        for (int i = gid; i < 4 * 2 * 1024; i += NT) SPT[i] = 8.0f * 1.4426950408889634f * log1pf(__expf(-P->lru_lambda[i]));
        bf16* CST = (bf16*)(ws + WS_CST);
        for (int i = gid; i < 256 * 128; i += NT) { const int col = i >> 7, cc = i & 127, s = col >> 7, m = col & 127; const float a = (float)((m * cc) & 127) * (2.0f / 128.0f);
            CST[i] = (bf16)f2bf(s ? sinpif(a) : cospif(a)); }
        bf16* DFTC = (bf16*)(ws + WS_DFTC);
        for (int i = gid; i < 256 * 512; i += NT) { const int k = i >> 9, cc = i & 511, s = cc >> 8, t = cc & 255; const float a = (float)((k * t) & 255) * (2.0f / 256.0f);
            DFTC[i] = (bf16)f2bf(s ? -sinpif(a) : cospif(a)); }
        bf16* DFTN = (bf16*)(ws + WS_DFTL);
        for (int i_ = gid; i_ < 256 * 1024 * dupC; i_ += NT) { const int i = i_ & (256 * 1024 - 1); const int k2 = i >> 10, cc = i & 1023, s = cc >> 9, t2 = cc & 511; const float a = (float)((k2 * t2) & 511) * (2.0f / 512.0f);
            DFTN[i] = (bf16)f2bf(s ? sinpif(a) : cospif(a)); }
        float* TW = (float*)(ws + WS_TW);
        for (int i = gid; i < 3 * 512; i += NT) { const int k1 = i / 512 + 1, t2 = i % 512; const float a = (float)(k1 * t2) * (2.0f / 2048.0f); TW[2 * i] = cospif(a); TW[2 * i + 1] = sinpif(a); }
    }
}

__device__ __forceinline__ void norm_rows(KP P, int l, int which, int nrows, bool slab, int lane, int wave, int vcu, int G, int dup) {
    unsigned char* ws = P->ws; bf16* X = (bf16*)(ws + WS_X); bf16* H = (bf16*)(ws + WS_H); const float* MOD = (const float*)(ws + WS_MOD);
    const float* gn = (which ? P->g_norm2 : P->g_norm1) + l * 2048;
    const bool first = (l == 0 && which == 0);
    const int gw = vcu * NWAVES + wave, NGW = G * NWAVES;
    f32x4 gq[8];
#pragma unroll
    for (int j = 0; j < 8; ++j) gq[j] = *(const f32x4*)(gn + ((j >> 1) * 64 + lane) * 8 + (j & 1) * 4);
    for (int m_ = gw; m_ < nrows * dup; m_ += NGW) { const int m = m_ % nrows;
        const int rsel = m < ML ? (m >> 11) : 8;
        const float* mv = MOD + ((size_t)l * 9 + rsel) * 12288 + (which ? 3 * 2048 : 0);
        f32x4 v[8], shq[8], scq[8]; float ss = 0.f;
        if (first) { const float* src = m < ML ? P->x + (size_t)m * DM : P->ctx + (size_t)(m - ML) * DM;
#pragma unroll
            for (int j = 0; j < 8; ++j) v[j] = *(const f32x4*)(src + ((j >> 1) * 64 + lane) * 8 + (j & 1) * 4);
        } else { const bf16* src = X + (size_t)m * DM;
            v4u xw[4];
#pragma unroll
            for (int jj = 0; jj < 4; ++jj) xw[jj] = *(const v4u*)(src + (jj * 64 + lane) * 8);
#pragma unroll
            for (int jj = 0; jj < 4; ++jj) { v[2 * jj] = (f32x4){bflo(xw[jj].x), bfhi(xw[jj].x), bflo(xw[jj].y), bfhi(xw[jj].y)}; v[2 * jj + 1] = (f32x4){bflo(xw[jj].z), bfhi(xw[jj].z), bflo(xw[jj].w), bfhi(xw[jj].w)}; }
        }
#pragma unroll
        for (int j = 0; j < 8; ++j) { const int col = ((j >> 1) * 64 + lane) * 8 + (j & 1) * 4; shq[j] = *(const f32x4*)(mv + col); scq[j] = *(const f32x4*)(mv + 2048 + col); }
        asm volatile("" ::: "memory");
#pragma unroll
        for (int j = 0; j < 8; ++j) ss += (v[j].x * v[j].x + v[j].y * v[j].y) + (v[j].z * v[j].z + v[j].w * v[j].w);
        const bool addslab = slab && m >= ML && m_ < nrows;
        if (addslab) { const float* SL = (const float*)(ws + WS_SLAB) + (size_t)(m - ML) * DM; ss = 0.f;
#pragma unroll
            for (int j = 0; j < 8; ++j) { const int col = ((j >> 1) * 64 + lane) * 8 + (j & 1) * 4;
                v[j] = (((v[j] + *(const f32x4*)(SL + col)) + *(const f32x4*)(SL + (size_t)2048 * 2048 + col)) + *(const f32x4*)(SL + (size_t)2 * 2048 * 2048 + col)) + *(const f32x4*)(SL + (size_t)3 * 2048 * 2048 + col);
                ss += (v[j].x * v[j].x + v[j].y * v[j].y) + (v[j].z * v[j].z + v[j].w * v[j].w); } }
        const float rstd = 1.0f / sqrtf(wave_sum(ss) * (1.0f / DM) + NEPS);
        f32x4 oq[8]; float amax = 0.f;
#pragma unroll
        for (int jj = 0; jj < 4; ++jj) { const int col = (jj * 64 + lane) * 8;
            if (first || addslab) { v4u xo; xo.x = cvt_pk_bf16(v[2 * jj].x, v[2 * jj].y); xo.y = cvt_pk_bf16(v[2 * jj].z, v[2 * jj].w); xo.z = cvt_pk_bf16(v[2 * jj + 1].x, v[2 * jj + 1].y); xo.w = cvt_pk_bf16(v[2 * jj + 1].z, v[2 * jj + 1].w);
                *(v4u*)(X + (size_t)m * DM + col) = xo; }
            const f32x4 o0 = v[2 * jj] * rstd * gq[2 * jj] * (scq[2 * jj] + 1.0f) + shq[2 * jj], o1 = v[2 * jj + 1] * rstd * gq[2 * jj + 1] * (scq[2 * jj + 1] + 1.0f) + shq[2 * jj + 1];
            v4u w; w.x = cvt_pk_bf16(o0.x, o0.y); w.y = cvt_pk_bf16(o0.z, o0.w); w.z = cvt_pk_bf16(o1.x, o1.y); w.w = cvt_pk_bf16(o1.z, o1.w);
            *(v4u*)(H + (size_t)m * DM + col) = w;
            oq[2 * jj] = o0; oq[2 * jj + 1] = o1;
            amax = fmaxf(amax, fmaxf(fmaxf(fmaxf(fabsf(o0.x), fabsf(o0.y)), fmaxf(fabsf(o0.z), fabsf(o0.w))), fmaxf(fmaxf(fabsf(o1.x), fabsf(o1.y)), fmaxf(fabsf(o1.z), fabsf(o1.w))))); }
        if (!which) {
            const float rmax = fmaxf(wave_max(amax), 1e-20f); const float inv = 127.0f / rmax;
#pragma unroll
            for (int jj = 0; jj < 4; ++jj) { u32x2 w8; w8.x = pack_i8x4(oq[2 * jj].x, oq[2 * jj].y, oq[2 * jj].z, oq[2 * jj].w, inv); w8.y = pack_i8x4(oq[2 * jj + 1].x, oq[2 * jj + 1].y, oq[2 * jj + 1].z, oq[2 * jj + 1].w, inv);
                *(u32x2*)(ws + WS_H8 + (size_t)m * DM + (jj * 64 + lane) * 8) = w8; }
            if (lane == 0) ((float*)(ws + WS_SH))[m] = rmax * (1.0f / 127.0f);
        }
    }
}
__device__ __forceinline__ void final_norm(KP P, int lane, int wave, int vcu, int G) {
    const bf16* X = (const bf16*)(P->ws + WS_X);
    const int gw = vcu * NWAVES + wave, NGW = G * NWAVES;
    for (int m = gw; m < ML; m += NGW) {
        const bf16* src = X + (size_t)m * DM; f32x4 v[8]; float ss = 0.f;
#pragma unroll
        for (int jj = 0; jj < 4; ++jj) { const v4u xw = *(const v4u*)(src + (jj * 64 + lane) * 8);
            v[2 * jj] = (f32x4){bflo(xw.x), bfhi(xw.x), bflo(xw.y), bfhi(xw.y)}; v[2 * jj + 1] = (f32x4){bflo(xw.z), bfhi(xw.z), bflo(xw.w), bfhi(xw.w)}; }
#pragma unroll
        for (int j = 0; j < 8; ++j) ss += (v[j].x * v[j].x + v[j].y * v[j].y) + (v[j].z * v[j].z + v[j].w * v[j].w);
        const float rstd = 1.0f / sqrtf(wave_sum(ss) * (1.0f / DM) + NEPS);
#pragma unroll
        for (int j = 0; j < 8; ++j) { const int col = ((j >> 1) * 64 + lane) * 8 + (j & 1) * 4; *(f32x4*)(P->out + (size_t)m * DM + col) = v[j] * rstd * *(const f32x4*)(P->g_final + col); }
    }
}

__device__ __forceinline__ void f1_units(KP P, bool last, LAS unsigned char* lds, int tid, int lane, int wave, int vcu, int G, int dup) {
    unsigned char* ws = P->ws; const bf16* Y1 = (const bf16*)(ws + WS_Y1); bf16* PTN = (bf16*)(ws + WS_PTL); bf16* PTC = (bf16*)(ws + WS_PTC);
    { const v4u* src = (const v4u*)(ws + WS_CST);
      for (int i = tid; i < 256 * 16; i += 512) { const int row = i >> 4, ch = i & 15; v4u t_ = src[i]; asm volatile("" : "+v"(t_)); *(LAS v4u*)(lds + row * 272 + ch * 16) = t_; } }
    __syncthreads();
    const int r = lane & 31, h = lane >> 5;
    const int gw = vcu * NWAVES + wave, NGW = G * NWAVES;
    const float* TW = (const float*)(ws + WS_TW);
    for (int wu_ = gw; wu_ < 4096 * dup; wu_ += NGW) {
        const int wu = wu_ & 4095; const int b = wu >> 9, tb = (wu >> 3) & 63, g = wu & 7;
        const bf16* ap = Y1 + (size_t)(b * 2048 + 512 * (r >> 3) + 8 * tb + (r & 7)) * LDY + YUF + g * 128 + h * 8;
        bf16x8 Af[8];
#pragma unroll
        for (int kk = 0; kk < 8; ++kk) Af[kk] = *(const bf16x8*)(ap + kk * 16);
        float twc[3][4], tws[3][4];
#pragma unroll
        for (int k1 = 0; k1 < 3; ++k1) { const f32x4 w0 = *(const f32x4*)(TW + 2 * (k1 * 512 + 8 * tb + 4 * h)), w1 = *(const f32x4*)(TW + 2 * (k1 * 512 + 8 * tb + 4 * h) + 4);
            twc[k1][0] = w0.x; tws[k1][0] = w0.y; twc[k1][1] = w0.z; tws[k1][1] = w0.w; twc[k1][2] = w1.x; tws[k1][2] = w1.y; twc[k1][3] = w1.z; tws[k1][3] = w1.w; }
#pragma unroll 1
        for (int cp = 0; cp < 4; ++cp) {
            f32x16 ac = {}, as = {};
#pragma unroll
            for (int kk = 0; kk < 8; ++kk) { const bf16x8 Bc = *(const LAS bf16x8*)(lds + (cp * 32 + r) * 272 + (kk * 16 + h * 8) * 2), Bs = *(const LAS bf16x8*)(lds + ((cp + 4) * 32 + r) * 272 + (kk * 16 + h * 8) * 2);
                ac = __builtin_amdgcn_mfma_f32_32x32x16_bf16(Af[kk], Bc, ac, 0, 0, 0); as = __builtin_amdgcn_mfma_f32_32x32x16_bf16(Af[kk], Bs, as, 0, 0, 0); }
            float ore[4][4], oim[4][4];
#pragma unroll
            for (int i = 0; i < 4; ++i) {
                const float z0r = ac[i], z1r = ac[4 + i], z2r = ac[8 + i], z3r = ac[12 + i], z0i = -as[i], z1i = -as[4 + i], z2i = -as[8 + i], z3i = -as[12 + i];
                const float ar = z0r + z2r, ai = z0i + z2i, br = z1r + z3r, bi = z1i + z3i, cr = z0r - z2r, ci = z0i - z2i, dr = z1r - z3r, di = z1i - z3i;
                ore[0][i] = ar + br; oim[0][i] = ai + bi;
                { const float wr = cr + di, wi = ci - dr; ore[1][i] = wr * twc[0][i] + wi * tws[0][i]; oim[1][i] = wi * twc[0][i] - wr * tws[0][i]; }
                { const float wr = ar - br, wi = ai - bi; ore[2][i] = wr * twc[1][i] + wi * tws[1][i]; oim[2][i] = wi * twc[1][i] - wr * tws[1][i]; }
                { const float wr = cr - di, wi = ci + dr; ore[3][i] = wr * twc[2][i] + wi * tws[2][i]; oim[3][i] = wi * twc[2][i] - wr * tws[2][i]; }
            }
            const int m = cp * 32 + r;
            bf16* dp = PTN + ((size_t)((b * 8 + g) * 128 + m)) * 1024 + 8 * tb + 4 * h;
#pragma unroll
            for (int k1 = 0; k1 < 4; ++k1) { u32x2 w; w.x = cvt_pk_bf16(ore[k1][0], ore[k1][1]); w.y = cvt_pk_bf16(ore[k1][2], ore[k1][3]); *(u32x2*)(dp + (size_t)k1 * 8192 * 1024) = w;
                u32x2 v; v.x = cvt_pk_bf16(oim[k1][0], oim[k1][1]); v.y = cvt_pk_bf16(oim[k1][2], oim[k1][3]); *(u32x2*)(dp + (size_t)k1 * 8192 * 1024 + 512) = v; }
        }
    }
    if (!last) {
    for (int wu_ = gw; wu_ < 512 * dup; wu_ += NGW) {
        const int wu = wu_ & 511; const int tt = 512 + (wu >> 3), g = wu & 7, m0 = tt * 32;
        const bf16* ap = Y1 + (size_t)(m0 + r) * LDY + YUF + g * 128 + h * 8;
        bf16x8 Af[8];
#pragma unroll
        for (int kk = 0; kk < 8; ++kk) Af[kk] = *(const bf16x8*)(ap + kk * 16);
        const int mc = m0 - ML, b = mc >> 8, t0 = mc & 255; bf16* base = PTC + (size_t)((b * 8 + g) * 128) * 512 + t0;
#pragma unroll 1
        for (int ct = 0; ct < 8; ++ct) {
            f32x16 acc = {};
#pragma unroll
            for (int kk = 0; kk < 8; ++kk) { const bf16x8 Bf = *(const LAS bf16x8*)(lds + (ct * 32 + r) * 272 + (kk * 16 + h * 8) * 2); acc = __builtin_amdgcn_mfma_f32_32x32x16_bf16(Af[kk], Bf, acc, 0, 0, 0); }
            const int s = ct >> 2, m = (ct & 3) * 32 + r;
            bf16* dp = base + (size_t)m * 512 + s * 256 + 4 * h;
#pragma unroll
            for (int q4 = 0; q4 < 4; ++q4) { u32x2 w; w.x = cvt_pk_bf16(acc[4 * q4], acc[4 * q4 + 1]); w.y = cvt_pk_bf16(acc[4 * q4 + 2], acc[4 * q4 + 3]); *(u32x2*)(dp + 8 * q4) = w; }
        }
    }
    }
}
__device__ __forceinline__ void knorm_units(KP P, int l, int lane, int wave, int vcu, int G, int dup) {
    unsigned char* ws = P->ws; const bf16* Y1 = (const bf16*)(ws + WS_Y1); bf16* KN = (bf16*)(ws + WS_KN); const float* ROPE = (const float*)(ws + WS_ROPE);
    const float g1 = P->k_gain[l * 128 + lane], g2 = P->k_gain[l * 128 + 64 + lane];
    const int gw = vcu * NWAVES + wave, NGW = G * NWAVES;
    for (int it0 = gw; it0 < MT * 2 * dup; it0 += 3 * NGW) {
        float k1[3], k2[3]; int mm[3], hh[3];
#pragma unroll
        for (int q = 0; q < 3; ++q) { const int it_ = it0 + q * NGW; const int it = (it_ < MT * 2 * dup ? it_ : gw) % (MT * 2); mm[q] = it >> 1; hh[q] = it & 1;
            const bf16* kp = Y1 + (size_t)mm[q] * LDY + YK + hh[q] * 128; k1[q] = bf2f(kp[lane]); k2[q] = bf2f(kp[64 + lane]); }
#pragma unroll
        for (int q = 0; q < 3; ++q) { if (it0 + q * NGW >= MT * 2 * dup) break;
            const int m = mm[q];
            const float rstd = 1.0f / sqrtf(wave_sum(k1[q] * k1[q] + k2[q] * k2[q]) * (1.0f / 128.0f) + NEPS);
            float a = k1[q] * rstd * g1, b = k2[q] * rstd * g2;
            if (m < ML) { const int t = m & 2047; const float c = ROPE[t * 64 + lane], s = ROPE[2048 * 64 + t * 64 + lane]; const float na = a * c - b * s, nb = b * c + a * s; a = na; b = nb; }
            bf16* op = KN + (size_t)m * 256 + hh[q] * 128;
            op[lane] = (bf16)(cvt_pk_bf16(a, 0.f) & 0xffffu); op[64 + lane] = (bf16)(cvt_pk_bf16(b, 0.f) & 0xffffu); }
    }
}
template <int D>
__device__ __forceinline__ void lru_sweep(const int b, const int nb, const int hc, LAS unsigned char* lds, const int lane, const int wave,
                                          const void* pY, const void* pR, const void* pF,
                                          const float cw0, const float cw1, const float cw2, const float cw3, const float cb, const float br, const float bi, const float sp) {
    const int j = lane & 31, hi = lane >> 5;
#define LRU_UNI(p_) ((void*)(((unsigned long long)(unsigned)__builtin_amdgcn_readfirstlane((int)(unsigned)((unsigned long long)(p_) >> 32)) << 32) | (unsigned long long)(unsigned)__builtin_amdgcn_readfirstlane((int)(unsigned)(unsigned long long)(p_))))
    const __amdgpu_buffer_rsrc_t rsY = __builtin_amdgcn_make_buffer_rsrc(LRU_UNI(pY), (short)0, (int)((size_t)MT * LDY * 2), 0x00020000);
    const __amdgpu_buffer_rsrc_t rsR = __builtin_amdgcn_make_buffer_rsrc(LRU_UNI(pR), (short)0, (int)((size_t)MT * 1024 * 2), 0x00020000);
    const __amdgpu_buffer_rsrc_t rsF = __builtin_amdgcn_make_buffer_rsrc(LRU_UNI(pF), (short)0, (int)((size_t)MT * 1024 * 2), 0x00020000);
#undef LRU_UNI
    LAS bf16* uS = (LAS bf16*)(lds + wave * 4608);
    LAS unsigned char* BL = lds + 36864;
    typedef float f32x2 __attribute__((ext_vector_type(2)));
    LAS f32x2* SUMS = (LAS f32x2*)(lds + 55296);
    const int chin = nb * 64 + lane, cho = nb * 64 + hc * 32 + j;
    constexpr float L2E = 1.4426950408889634f;
    const int arow = ((j >> 2) & 1) * 16 + (j & 3) + 4 * (j >> 3);
    const int voX = (YUX + chin) * 2, voG = (hi * 16 * LDY + YUG + cho) * 2, voR = (hi * 16 * 1024 + cho) * 2, voF = (hi * 16 * 1024 + cho) * 2;
#define LRU_GEOM(s_) const int q_ = (s_) * 8 + wave; const bool isc_ = q_ < 8; const int rowbase = isc_ ? ML + b * 256 : b * 2048, Lq = isc_ ? 256 : 2048, T0 = isc_ ? 32 * q_ : 32 * (q_ - 8)
#define LRU_ROWOFF(row_) ({ int rr_ = (row_); rr_ = rr_ < 0 ? 0 : (rr_ > MT - 1 ? MT - 1 : rr_); __builtin_amdgcn_readfirstlane(rr_ * (LDY * 2)); })
#define LRU_XLOAD(dst, s_) do { LRU_GEOM(s_); const int r0_ = rowbase + T0 - 2; \
        _Pragma("unroll") for (int i = 0; i < 35; ++i) dst[i] = __builtin_amdgcn_raw_buffer_load_b16(rsY, voX, LRU_ROWOFF(r0_ + i), 0); } while (0)
#define LRU_STEP(si_) (D == 0 ? (si_) : ((si_) == 0 ? 0 : 9 - (si_)))
    unsigned short xr[35];
    LRU_XLOAD(xr, LRU_STEP(0));
    float cstep = 0.f; int buf = 0;
#pragma unroll 1
    for (int si = 0; si < 9; ++si) {
        const int step = LRU_STEP(si);
        LRU_GEOM(step);
        {
          float xin[35];
#pragma unroll
          for (int i = 0; i < 35; ++i) { const int t = T0 - 2 + i; xin[i] = (t >= 0 && t < Lq) ? bf2f(xr[i]) : 0.f; }
#pragma unroll
          for (int i = 0; i < 32; ++i) uS[i * 72 + lane] = (bf16)(cvt_pk_bf16(cb + cw0 * xin[i] + cw1 * xin[i + 1] + cw2 * xin[i + 2] + cw3 * xin[i + 3], 0.f) & 0xffffu); }
        if (si < 8) { LRU_XLOAD(xr, LRU_STEP(si + 1)); }
        unsigned short hfv[16]; unsigned short ugr[16];
        if (D == 1) { const int r0 = rowbase + T0;
#pragma unroll
            for (int r = 0; r < 16; ++r) hfv[r] = __builtin_amdgcn_raw_buffer_load_b16(rsF, voF, __builtin_amdgcn_readfirstlane((r0 + r) * 2048), 0);
#pragma unroll
            for (int r = 0; r < 16; ++r) ugr[r] = __builtin_amdgcn_raw_buffer_load_b16(rsY, voG, __builtin_amdgcn_readfirstlane((r0 + r) * (LDY * 2)), 0); }
        asm volatile("" ::: "memory");
        LDS_WAIT(); asm volatile("" ::: "memory");
        f32x16 acc[2];
#pragma unroll
        for (int tl = 0; tl < 2; ++tl) acc[tl] = (f32x16){};
#pragma unroll
        for (int kk = 0; kk < 4; ++kk) {
            const bf16x8 Af = *(const LAS bf16x8*)(uS + arow * 72 + kk * 16 + hi * 8);
#pragma unroll
            for (int tl = 0; tl < 2; ++tl) acc[tl] = __builtin_amdgcn_mfma_f32_32x32x16_bf16(Af, *(const LAS bf16x8*)(BL + ((2 * D + tl) * 32 + j) * 144 + (kk * 16 + hi * 8) * 2), acc[tl], 0, 0, 0);
        }
        float yl[16], cp[16];
#define LRU_GATES(r0_, r1_, a0_, a1_, x0_, x1_) \
            const f32x2 u_ = {bf2f(uS[(hi * 16 + (r0_)) * 72 + hc * 32 + j]), bf2f(uS[(hi * 16 + (r1_)) * 72 + hc * 32 + j])}; \
            f32x2 e0_ = (f32x2){acc[0][r0_], acc[0][r1_]} * (-L2E) + br, e1_ = (f32x2){acc[1][r0_], acc[1][r1_]} * (-L2E) + bi; \
            e0_ = (f32x2){__builtin_amdgcn_exp2f(e0_.x), __builtin_amdgcn_exp2f(e0_.y)} + 1.0f; e1_ = (f32x2){__builtin_amdgcn_exp2f(e1_.x), __builtin_amdgcn_exp2f(e1_.y)} + 1.0f; \
            const f32x2 p_ = e0_ * e1_; const f32x2 ip_ = {__builtin_amdgcn_rcpf(p_.x), __builtin_amdgcn_rcpf(p_.y)}; \
            const f32x2 rg_ = ip_ * e1_, ig_ = ip_ * e0_, la_ = rg_ * (-sp); \
            const f32x2 av_ = {__builtin_amdgcn_exp2f(la_.x), __builtin_amdgcn_exp2f(la_.y)}; \
            f32x2 s_ = 1.0f - av_ * av_; s_ = (f32x2){__builtin_amdgcn_sqrtf(fmaxf(s_.x, 0.f)), __builtin_amdgcn_sqrtf(fmaxf(s_.y, 0.f))}; \
            const f32x2 xv_ = s_ * ig_ * u_; const float a0_ = av_.x, a1_ = av_.y, x0_ = xv_.x, x1_ = xv_.y
        float A = 1.f, Hs = 0.f;
        if (D == 0) {
#pragma unroll
            for (int r = 0; r < 16; r += 2) { LRU_GATES(r, r + 1, a0, a1, x0, x1);
                Hs = a0 * Hs + x0; A *= a0; yl[r] = Hs; cp[r] = A; Hs = a1 * Hs + x1; A *= a1; yl[r + 1] = Hs; cp[r + 1] = A; }
        } else {
#pragma unroll
            for (int r = 14; r >= 0; r -= 2) { LRU_GATES(r + 1, r, a0, a1, x0, x1);
                Hs = a0 * Hs + x0; A *= a0; yl[r + 1] = Hs; cp[r + 1] = A; Hs = a1 * Hs + x1; A *= a1; yl[r] = Hs; cp[r] = A; }
        }
#undef LRU_GATES
        const int myb = 2 * wave + hi;
        SUMS[(buf * 16 + myb) * 32 + j] = (f32x2){A, Hs};
        asm volatile("s_waitcnt lgkmcnt(0)" ::: "memory"); __builtin_amdgcn_s_barrier(); asm volatile("" ::: "memory");
        float c = cstep, cin = 0.f;
#pragma unroll
        for (int bq = 0; bq < 16; ++bq) { const int bb = D == 0 ? bq : 15 - bq; const f32x2 sv = SUMS[(buf * 16 + bb) * 32 + j]; cin = (bb == myb) ? c : cin; c = sv.x * c + sv.y; }
        cstep = c; buf ^= 1;
        const int r0 = rowbase + T0;
        if (D == 0) {
#pragma unroll
            for (int r = 0; r < 16; ++r) __builtin_amdgcn_raw_buffer_store_b16((unsigned short)(cvt_pk_bf16(yl[r] + cp[r] * cin, 0.f) & 0xffffu), rsF, voF, __builtin_amdgcn_readfirstlane((r0 + r) * 2048), 0);
        } else {
#pragma unroll
            for (int r = 0; r < 16; ++r) { const float y = bf2f(hfv[r]) + (yl[r] + cp[r] * cin); const float ug = bf2f(ugr[r]);
                __builtin_amdgcn_raw_buffer_store_b16((unsigned short)(cvt_pk_bf16(y * gelu_tanh(ug), 0.f) & 0xffffu), rsR, voR, __builtin_amdgcn_readfirstlane((r0 + r) * 2048), 0); }
        }
        LDS_WAIT(); asm volatile("" ::: "memory");
    }
#undef LRU_GEOM
#undef LRU_XLOAD
#undef LRU_ROWOFF
#undef LRU_STEP
}
__device__ __forceinline__ void lru_unit(KP P, int l, int b, int nb, int hc, LAS unsigned char* lds, int lane, int wave) {
    unsigned char* ws = P->ws; const bf16* Y1 = (const bf16*)(ws + WS_Y1); bf16* REC = (bf16*)(ws + WS_REC);
    const int j = lane & 31;
    LAS unsigned char* BL = lds + 36864;
    const int chin = nb * 64 + lane, cho = nb * 64 + hc * 32 + j;
    const float cw0 = P->conv_w[(l * 4 + 0) * 1024 + chin], cw1 = P->conv_w[(l * 4 + 1) * 1024 + chin], cw2 = P->conv_w[(l * 4 + 2) * 1024 + chin], cw3 = P->conv_w[(l * 4 + 3) * 1024 + chin];
    const float cb = P->conv_b[l * 1024 + chin];
    constexpr float L2E = 1.4426950408889634f;
    const float brf = -L2E * P->lru_b_r[(l * 2 + 0) * 1024 + cho], bif = -L2E * P->lru_b_i[(l * 2 + 0) * 1024 + cho], brb = -L2E * P->lru_b_r[(l * 2 + 1) * 1024 + cho], bib = -L2E * P->lru_b_i[(l * 2 + 1) * 1024 + cho];
    const float spf = ((const float*)(ws + WS_SPT))[(l * 2 + 0) * 1024 + cho], spb = ((const float*)(ws + WS_SPT))[(l * 2 + 1) * 1024 + cho];
    {
        const bf16* WLT = (const bf16*)(ws + WS_WLT); const int tid_ = wave * 64 + lane;
#pragma unroll
        for (int rep = 0; rep < 2; ++rep) { const int c16 = tid_ + rep * 512, row = c16 >> 3, ch = c16 & 7, tl = row >> 5, col = row & 31;
            const int mat = (((l * 2 + (tl >> 1)) * 16 + nb) * 2 + (tl & 1));
            v4u t_ = *(const v4u*)(WLT + (size_t)mat * 4096 + (hc * 32 + col) * 64 + ch * 8); asm volatile("" : "+v"(t_));
            *(LAS v4u*)(BL + row * 144 + ch * 16) = t_; }
        __syncthreads();
    }
    lru_sweep<0>(b, nb, hc, lds, lane, wave, (const void*)Y1, (const void*)REC, (const void*)(ws + WS_H), cw0, cw1, cw2, cw3, cb, brf, bif, spf);
    asm volatile("s_waitcnt vmcnt(0)" ::: "memory"); __syncthreads();
    lru_sweep<1>(b, nb, hc, lds, lane, wave, (const void*)Y1, (const void*)REC, (const void*)(ws + WS_H), cw0, cw1, cw2, cw3, cb, brb, bib, spb);
    __syncthreads();
}

struct MapAB { const char* A; const char* B; size_t astep, bstep; int pm0, pn0;
    __device__ __forceinline__ void operator()(pg8::Unit& u) const { u.pm += pm0; u.pn += pn0; u.A = A + (size_t)u.pm * astep; u.B = B + (size_t)u.pn * bstep; } };
struct MapBr { const char* A; const char* B; const char* BR;
    __device__ __forceinline__ void operator()(pg8::Unit& u) const { u.A = A + (size_t)u.aux * (36 * MiB) + (size_t)u.pm * (256 * 1024 * 2);
        const bool mir = u.aux == 2 && u.pm < 64 && (u.pm & 7) >= 4;
        u.B = (mir ? BR : B + (size_t)u.aux * (2048 * 1024 * 2)) + (size_t)u.pn * (256 * 1024 * 2); } };
__device__ __forceinline__ void nyquist_rows(unsigned char* ws, int lane, int wave, int vcu, int G) {
    const bf16* PTN = (const bf16*)(ws + WS_PTL); bf16* FOU = (bf16*)(ws + WS_FOU);
    const int gw = vcu * NWAVES + wave, NGW = G * NWAVES;
    for (int r = gw; r < 8192; r += NGW) {
        const v4u w = *(const v4u*)(PTN + (size_t)r * 1024 + lane * 8);
        float s = (bflo(w.x) - bfhi(w.x)) + (bflo(w.y) - bfhi(w.y)) + (bflo(w.z) - bfhi(w.z)) + (bflo(w.w) - bfhi(w.w));
        s = wave_sum(s) * 0.001953125f;
        if (lane == 0) FOU[(size_t)((r >> 10) * 2048 + 1024) * 1024 + (r & 1023)] = (bf16)(cvt_pk_bf16(s, 0.f) & 0xffffu);
    }
}
struct MapF2 { const char* A; const char* B;
    __device__ __forceinline__ void operator()(pg8::Unit& u) const { u.A = A; u.B = B + (size_t)u.pm * ((size_t)8192 * 1024 * 2) + (size_t)u.pn * (256 * 1024 * 2); } };

__global__ void __launch_bounds__(NWAVES * 64, 2) fwd_kernel(Params Pv) {
    extern __shared__ __attribute__((aligned(16))) unsigned char lds_raw[];
    LAS unsigned char* lds = (LAS unsigned char*)lds_raw;
    volatile LAS unsigned* MISC = (volatile LAS unsigned*)(lds + MISC_OFF);
    const int wave0 = __builtin_amdgcn_readfirstlane((int)threadIdx.x >> 6);
#define FRESH_TID() const KP P = fresh_kp(); (void)P; int wave = wave0; asm volatile("" : "+s"(wave)); int lane; asm volatile("v_mbcnt_lo_u32_b32 %0, -1, 0\n\tv_mbcnt_hi_u32_b32 %0, -1, %0" : "=v"(lane)); const int tid = (wave << 6) | lane; (void)tid
    const int G = gridDim.x; int vcu; { const int bx = blockIdx.x; vcu = (G % 8 == 0) ? (bx % 8) * (G / 8) + bx / 8 : bx; }
    unsigned char* ws = fresh_kp()->ws;
    gu32* ctl = (gu32*)(ws + WS_CTL);
    for (int u = (int)threadIdx.x; u < (LDS_BYTES - LDSCTL_OFF) / 4; u += NWAVES * 64) ((LAS unsigned*)(lds + LDSCTL_OFF))[u] = 0u;
    __syncthreads();
    XcdBarrier bar = xcd_barrier_post((unsigned*)(ctl + CW_BAR), MISC + 8);
#define GRID_BAR() do { XcdBarrier b2_ = bar; asm volatile("" : "+s"(b2_.bar), "+s"(b2_.x)); { FRESH_TID(); xcd_barrier(b2_, tid == 0); } } while (0)

#define H ((bf16*)(ws + WS_H))
#define Y1 ((bf16*)(ws + WS_Y1))
#define Gt ((bf16*)(ws + WS_G))
#define ACT ((bf16*)(ws + WS_ACT))
#define KN ((bf16*)(ws + WS_KN))
#define ATT ((bf16*)(ws + WS_ATT))
#define FOU ((bf16*)(ws + WS_FOU))
#define MG ((bf16*)(ws + WS_MG))
#define X ((bf16*)(ws + WS_X))
#define MOD ((const float*)(ws + WS_MOD))
#define ROPE ((const float*)(ws + WS_ROPE))

    const int ph_lo = fresh_kp()->ph_lo, ph_hi = fresh_kp()->ph_hi;
#define DUP(bit) ((((PROBE_MASK) >> (bit)) & 1) + 1)
#define IN(k) (ph_lo <= (k) && (k) < ph_hi)
#define SEAM(k) do { if (IN(k) && IN((k) + 1)) { GRID_BAR(); if (DUP(14) > 1) GRID_BAR(); } } while (0)
    if (IN(0)) { FRESH_TID(); p0_prologue(P, lds, tid, lane, wave, vcu, G, DUP(8), DUP(9), DUP(10)); }
    SEAM(0);

#pragma unroll 1
    for (int l = 0; l < DEPTH; ++l) {
        const bool last = (l == DEPTH - 1);
        const int nMt = last ? 64 : 72;
        const unsigned char* wl = ws + WS_W + (size_t)l * W_LAYER;
        const int pb = 1 + 9 * l;
        if (IN(pb + 0)) { FRESH_TID(); norm_rows(P, l, 0, MT, l > 0, lane, wave, vcu, G, DUP(11)); }
        SEAM(pb + 0);
        if (IN(pb + 1)) {
            pg8::EpiG1T<false> E{Y1, Gt, fresh_kp()->b_gate + l * 6144, (const float*)(ws + WS_SH), (const unsigned*)(ws + WS_CMAX) + l * CMAX_L};
            pg8::EpiG1T<true> EG{Y1, Gt, fresh_kp()->b_gate + l * 6144, (const float*)(ws + WS_SH), (const unsigned*)(ws + WS_CMAX) + l * CMAX_L};
            pg8::EpiG1T<false, true> EQ{Y1, Gt, fresh_kp()->b_gate + l * 6144, (const float*)(ws + WS_SH), (const unsigned*)(ws + WS_CMAX) + l * CMAX_L};
            const int bx = (int)blockIdx.x;
            if (!last) {
                pg8::TileOrder<MapAB> S; S.map = MapAB{(const char*)H, (const char*)(wl + WO_W1), (size_t)256 * 2048 * 2, (size_t)256 * 2048 * 2, 0, 6}; S.init(72, 8, G, bx, 1, DUP(1));
                { FRESH_TID(); pg8::gemm_phase<pg8::EpiG1T<false>, pg8::TileOrder<MapAB>, true, true>(lds, pg8::Gemm{2048, 2048, 2048}, S, E, tid); }
            } else {
                pg8::TileOrder<MapAB> S; S.map = MapAB{(const char*)H, (const char*)(wl + WO_W1), (size_t)256 * 2048 * 2, (size_t)256 * 2048 * 2, 0, 6}; S.init(64, 8, G, bx, 1, DUP(1));
                { FRESH_TID(); pg8::gemm_phase<pg8::EpiG1T<false>, pg8::TileOrder<MapAB>, true, true>(lds, pg8::Gemm{2048, 2048, 2048}, S, E, tid); }
                pg8::TileOrder<MapAB> S2; S2.map = MapAB{(const char*)H, (const char*)(wl + WO_W1), (size_t)256 * 2048 * 2, (size_t)256 * 2048 * 2, 64, 6}; S2.init(8, 4, G, (bx + G / 2) % G, 1, 1);
                { FRESH_TID(); pg8::gemm_phase<pg8::EpiG1T<false>, pg8::TileOrder<MapAB>, true, true>(lds, pg8::Gemm{2048, 2048, 2048}, S2, E, tid); }
            }
            {
                pg8::TileOrder<MapAB> SQ; SQ.map = MapAB{(const char*)(ws + WS_H8), (const char*)(wl + WO_W1), (size_t)256 * 2048, (size_t)256 * 2048, 0, 0};
                SQ.init(72, 6, G, G == 256 ? (bx + 96) % G : bx, 1, 1);
                { FRESH_TID(); pg8::gemm_phase<pg8::EpiG1T<false, true>, pg8::TileOrder<MapAB>, true, true, 2>(lds, pg8::Gemm{1024, 1024, 1024}, SQ, EQ, tid); }
            }
            {
                pg8::TileOrder<MapAB> SU; SU.map = MapAB{(const char*)(ws + WS_H8), (const char*)(wl + WO_W1 + WO_UF8) - (size_t)14 * 256 * 2048, (size_t)256 * 2048, (size_t)256 * 2048, 0, 14};
                SU.init(last ? 64 : 72, 4, G, G == 256 ? (bx + 40) % G : bx, 1, 1);
                { FRESH_TID(); pg8::gemm_phase<pg8::EpiG1T<false, true>, pg8::TileOrder<MapAB>, true, true, 2>(lds, pg8::Gemm{1024, 1024, 1024}, SU, EQ, tid); }
            }
            {
                pg8::TileOrder<MapAB> S8; S8.map = MapAB{(const char*)(ws + WS_H8), (const char*)(wl + WO_W8) - (size_t)18 * 256 * 2048, (size_t)256 * 2048, (size_t)256 * 2048, 0, 18};
                S8.init(last ? 64 : 72, 24, G, G == 256 ? (bx + 192) % G : bx, 1, DUP(1));
                { FRESH_TID(); pg8::gemm_phase<pg8::EpiG1T<true>, pg8::TileOrder<MapAB>, true, true, 2>(lds, pg8::Gemm{1024, 1024, 1024}, S8, EG, tid); }
            }
        }
        SEAM(pb + 1);
        if (IN(pb + 2)) {
        { FRESH_TID(); f1_units(P, last, lds, tid, lane, wave, vcu, G, DUP(2)); }
        { FRESH_TID(); knorm_units(P, l, lane, wave, vcu, G, DUP(2)); }
        __syncthreads();
        { FRESH_TID(); for (int u_ = vcu; u_ < 256 * DUP(6); u_ += G) { const int u = u_ & 255; lru_unit(P, l, u >> 5, (u >> 1) & 15, u & 1, lds, lane, wave); } }
        }
        SEAM(pb + 2);
        if (IN(pb + 3)) {
            const bool evn = (vcu & 1) == 0; const int pr = vcu >> 1;
            { FRESH_TID(); if (G != 256) nyquist_rows(ws, lane, wave, vcu, G); else if (!evn) nyquist_rows(ws, lane, wave, pr, 128); }
            { FRESH_TID();
            const int nctx = (G == 256) ? ((!evn && !last && pr < 64) ? 1 : 0) : 0;
            const int ntot = (G == 256) ? 2 + nctx : 0;
            for (int ui_ = 0; ui_ < ntot * DUP(3); ++ui_) { const int ui = ui_ % ntot;
                const int U = ui < 2 ? 2 * vcu + ui : 512 + pr;
                const bf16 *Qb, *K0, *K1, *V0, *V1; bf16* Ob; int n0, NT; const float* rope;
                if (U < 512) { const int bh = U >> 3, qb = U & 7, b = bh >> 3, h = bh & 7, kvh = h >> 2; const size_t r0 = (size_t)b * 2048, rc = (size_t)ML + b * 256;
                    Qb = Y1 + (r0 + qb * 256) * LDY + YQ + h * 128; K0 = KN + r0 * 256 + kvh * 128; K1 = KN + rc * 256 + kvh * 128;
                    V0 = Y1 + r0 * LDY + YV + kvh * 128; V1 = Y1 + rc * LDY + YV + kvh * 128; n0 = 32; NT = 36; Ob = ATT + (r0 + qb * 256) * 1024 + h * 128; rope = ROPE + (size_t)qb * 256 * 64; }
                else { const int uc = U - 512, b = uc >> 3, h = uc & 7, kvh = h >> 2; const size_t rc = (size_t)ML + b * 256;
                    Qb = Y1 + rc * LDY + YQ + h * 128; K0 = KN + rc * 256 + kvh * 128; K1 = K0; V0 = Y1 + rc * LDY + YV + kvh * 128; V1 = V0; n0 = 4; NT = 4; Ob = ATT + rc * 1024 + h * 128; rope = nullptr; }
                att::attn_unit(Qb, LDY, K0, K1, V0, V1, n0, NT, 256, LDY, Ob, 1024, P->q_gain + l * 128, rope, (char*)lds_raw, tid);
            }
            if (G != 256) {
                const int nun = last ? 512 : 576;
                for (int U = vcu; U < nun; U += G) {
                    const bf16 *Qb, *K0, *K1, *V0, *V1; bf16* Ob; int n0, NT; const float* rope;
                    if (U < 512) { const int bh = U >> 3, qb = U & 7, b = bh >> 3, h = bh & 7, kvh = h >> 2; const size_t r0 = (size_t)b * 2048, rc = (size_t)ML + b * 256;
                        Qb = Y1 + (r0 + qb * 256) * LDY + YQ + h * 128; K0 = KN + r0 * 256 + kvh * 128; K1 = KN + rc * 256 + kvh * 128;
                        V0 = Y1 + r0 * LDY + YV + kvh * 128; V1 = Y1 + rc * LDY + YV + kvh * 128; n0 = 32; NT = 36; Ob = ATT + (r0 + qb * 256) * 1024 + h * 128; rope = ROPE + (size_t)qb * 256 * 64; }
                    else { const int uc = U - 512, b = uc >> 3, h = uc & 7, kvh = h >> 2; const size_t rc = (size_t)ML + b * 256;
                        Qb = Y1 + rc * LDY + YQ + h * 128; K0 = KN + rc * 256 + kvh * 128; K1 = K0; V0 = Y1 + rc * LDY + YV + kvh * 128; V1 = V0; n0 = 4; NT = 4; Ob = ATT + rc * 1024 + h * 128; rope = nullptr; }
                    att::attn_unit(Qb, LDY, K0, K1, V0, V1, n0, NT, 256, LDY, Ob, 1024, P->q_gain + l * 128, rope, (char*)lds_raw, tid);
                }
            }
            }
            __syncthreads();
            const int cF = (G == 256) ? (evn ? pr : 1 << 20) : (int)blockIdx.x;
            {
                pg8::TileOrder<MapF2> S; S.map = MapF2{(const char*)(ws + WS_DFTL), (const char*)(ws + WS_PTL)}; S.init(4, 32, G, cF, 1, DUP(5));
                pg8::EpiF2 E{FOU, 2048, 0, 1, 0.001953125f, 1};
                { FRESH_TID(); pg8::gemm_phase<pg8::EpiF2, pg8::TileOrder<MapF2>, true, true>(lds, pg8::Gemm{1024, 1024, 1024}, S, E, tid); }
            }
            if (!last) {
                pg8::TileOrder<MapAB> S; S.map = MapAB{(const char*)(ws + WS_DFTC), (const char*)(ws + WS_PTC), (size_t)256 * 512 * 2, (size_t)256 * 512 * 2, 0, 0}; S.init(1, 32, G, (G == 256) ? (!evn && pr >= 64 && pr < 96 ? pr - 64 : 1 << 20) : (int)blockIdx.x, 1, DUP(5));
                pg8::EpiF2 E{FOU, 256, ML, 0, 0.005524271728019903f, 0};
                { FRESH_TID(); pg8::gemm_phase<pg8::EpiF2, pg8::TileOrder<MapAB>, true, true>(lds, pg8::Gemm{512, 512, 512}, S, E, tid); }
            }
        }
        SEAM(pb + 3);
        if (IN(pb + 4)) {
            pg8::TileOrder<MapBr> S; S.map = MapBr{(const char*)ATT, (const char*)(wl + WO_WB), (const char*)(ws + WS_WBR + (size_t)l * 4 * MiB)}; S.init(nMt, 8, G, (int)blockIdx.x, 3, DUP(4));
            pg8::EpiBr E{Gt, MG};
            { FRESH_TID(); pg8::gemm_phase<pg8::EpiBr, pg8::TileOrder<MapBr>, true, true>(lds, pg8::Gemm{1024, 1024, 1024}, S, E, tid); }
        }
        SEAM(pb + 4);
        if (IN(pb + 5)) {
            pg8::TileOrder<MapAB> S; S.map = MapAB{(const char*)MG, (const char*)(wl + WO_WO), (size_t)256 * 2048 * 2, (size_t)256 * 2048 * 2, 0, 0}; S.init(64, 8, G, (int)blockIdx.x, 1, DUP(12));
            pg8::EpiRes E{X, MOD + (size_t)l * 9 * 12288 + 2 * 2048, (bf16*)(ws + WS_Y1)};
            { FRESH_TID(); pg8::gemm_phase<pg8::EpiRes, pg8::TileOrder<MapAB>, true, true>(lds, pg8::Gemm{2048, 2048, 2048}, S, E, tid); }
            if (!last) {
                pg8::QuarterOrder Q{G, (int)blockIdx.x, (const char*)MG, (const char*)(wl + WO_WO), (size_t)256 * 2048 * 2, (size_t)256 * 2048 * 2, (size_t)512 * 2};
                pg8::EpiResSlab EA{(float*)(ws + WS_SLAB), MOD + (size_t)l * 9 * 12288 + 2 * 2048};
                { FRESH_TID(); pg8::gemm_phase<pg8::EpiResSlab, pg8::QuarterOrder, true, true>(lds, pg8::Gemm{512, 2048, 2048}, Q, EA, tid); }
            }
        }
        SEAM(pb + 5);
        if (IN(pb + 6)) { FRESH_TID(); norm_rows(P, l, 1, nMt * 256, true, lane, wave, vcu, G, DUP(11)); }
        SEAM(pb + 6);
        if (IN(pb + 7)) {
            pg8::TileOrder<MapAB> S; S.map = MapAB{(const char*)H, (const char*)(wl + WO_WFI), (size_t)256 * 2048 * 2, (size_t)256 * 2048 * 2, 0, 0}; S.init(nMt, 44, G, (int)blockIdx.x, 1, DUP(7));
            pg8::EpiSwi E{ACT};
            { FRESH_TID(); pg8::gemm_phase<pg8::EpiSwi, pg8::TileOrder<MapAB>, true, true>(lds, pg8::Gemm{2048, 2048, 2048}, S, E, tid); }
        }
        SEAM(pb + 7);
        if (IN(pb + 8)) {
            pg8::TileOrder<MapAB> S; S.map = MapAB{(const char*)ACT, (const char*)(wl + WO_WFO), (size_t)256 * 5632 * 2, (size_t)256 * 5632 * 2, 0, 0}; S.init(64, 8, G, (int)blockIdx.x, 1, DUP(13));
            pg8::EpiRes E{X, MOD + (size_t)l * 9 * 12288 + 5 * 2048, (bf16*)(ws + WS_Y1)};
            { FRESH_TID(); pg8::gemm_phase<pg8::EpiRes, pg8::TileOrder<MapAB>, true, true>(lds, pg8::Gemm{5632, 5632, 5632}, S, E, tid); }
            if (!last) {
                pg8::QuarterOrder Q{G, (int)blockIdx.x, (const char*)ACT, (const char*)(wl + WO_WFO), (size_t)256 * 5632 * 2, (size_t)256 * 5632 * 2, (size_t)1408 * 2};
                pg8::EpiResSlab EA{(float*)(ws + WS_SLAB), MOD + (size_t)l * 9 * 12288 + 5 * 2048};
                { FRESH_TID(); pg8::gemm_phase<pg8::EpiResSlab, pg8::QuarterOrder, true, true>(lds, pg8::Gemm{1408, 5632, 5632}, Q, EA, tid); }
            }
        }
        SEAM(pb + 8);
    }
    if (IN(37)) { FRESH_TID(); final_norm(P, lane, wave, vcu, G); }
#undef IN
#undef SEAM
#undef GRID_BAR
#undef H
#undef Y1
#undef Gt
#undef ACT
#undef KN
#undef ATT
#undef FOU
#undef MG
#undef X
#undef MOD
#undef ROPE
}

extern "C" void kernel_launch(void* const* d_in, const int* in_sizes, int n_in, void* d_out, int out_size, void* d_ws, size_t ws_size, hipStream_t stream) {
    static int grid = 0;
    if (grid == 0) {
        if (n_in != 25 || out_size != ML * DM || ws_size < WS_END) { fprintf(stderr, "kernel_launch: unexpected shapes (n_in %d out %d ws %zu, need %zu)\n", n_in, out_size, ws_size, (size_t)WS_END); grid = -1; return; }
        int dev = 0, cus = 0, per_cu = 0;
        if (hipGetDevice(&dev) != hipSuccess || hipDeviceGetAttribute(&cus, hipDeviceAttributeMultiprocessorCount, dev) != hipSuccess) { grid = -1; return; }
        if (hipFuncSetAttribute((const void*)fwd_kernel, hipFuncAttributeMaxDynamicSharedMemorySize, LDS_BYTES) != hipSuccess) { fprintf(stderr, "kernel_launch: hipFuncSetAttribute failed\n"); grid = -1; return; }
        if (hipOccupancyMaxActiveBlocksPerMultiprocessor(&per_cu, (const void*)fwd_kernel, NWAVES * 64, LDS_BYTES) != hipSuccess || per_cu < 1) fprintf(stderr, "kernel_launch: occupancy query reports %d\n", per_cu);
        (void)hipGetLastError();
        grid = cus > 256 ? 256 : cus;
    }
    if (grid < 0) return;
    if (hipMemsetAsync((char*)d_ws + WS_CTL, 0, CTL_ZERO_BYTES, stream) != hipSuccess) return;
    Params p{};
    const float** pf = (const float**)&p;
    for (int i = 0; i < 25; ++i) pf[i] = (const float*)d_in[i];
    p.out = (float*)d_out; p.ws = (unsigned char*)d_ws;
#ifndef MK_CUT_EVERY
#define MK_CUT_EVERY 0
#endif
    constexpr int NPH = 38;
    for (int lo = 0; lo < NPH;) {
        const int hi = MK_CUT_EVERY ? lo + 1 : NPH;
        p.ph_lo = lo; p.ph_hi = hi;
        if (lo > 0 && hipMemsetAsync((char*)d_ws + WS_CTL, 0, CTL_ZERO_BYTES, stream) != hipSuccess) return;
        hipLaunchKernelGGL(fwd_kernel, dim3(grid), dim3(NWAVES * 64), LDS_BYTES, stream, p);
        const hipError_t le = hipPeekAtLastError();
        if (le != hipSuccess) { fprintf(stderr, "kernel_launch: launch failed: %s\n", hipGetErrorName(le)); return; }
        lo = hi;
    }
}
```

```cpp
#include <hip/hip_runtime.h>
#include <cstdio>
#include <cstdint>
#ifndef PROBE_MASK
#define PROBE_MASK 0
#endif

namespace pg8 {
#define PG8_LAS __attribute__((address_space(3)))
typedef unsigned short bf16_t;
typedef short bf16x8 __attribute__((ext_vector_type(8)));
typedef float f32x4 __attribute__((ext_vector_type(4)));
typedef float f32x2 __attribute__((ext_vector_type(2)));
typedef unsigned u32x4 __attribute__((ext_vector_type(4)));
typedef unsigned u32x2 __attribute__((ext_vector_type(2)));
typedef int i32x4 __attribute__((ext_vector_type(4)));
constexpr int BM = 256, BK = 64, HALF = 128, HTB = HALF * BK * 2  , STAGE_BYTES = 8 * HTB, NXCD = 8, WGM = 4;

__host__ __device__ __forceinline__ int lds_byte(int r, int c) { const int st = (r >> 4) * 2 + (c >> 5), rr = r & 15, cc = c & 31, ob = rr * 64 + cc * 2; return st * 1024 + (ob ^ (((ob >> 9) & 1) << 5)); }
__host__ __device__ __forceinline__ void stage_rc(int b, int& R, int& C) { const int st = b / 1024, sb = b % 1024, swz = sb ^ (((sb >> 9) & 1) << 5); R = (st >> 1) * 16 + swz / 64; C = (st & 1) * 32 + (swz % 64) / 2; }
__host__ __device__ __forceinline__ int perm32(int rho) { const int n = rho >> 4, i = rho & 15; return 8 * (i >> 2) + 4 * n + (i & 3); }

struct Unit { int pm, pn, aux, dupv; const char* A; const char* B; };
struct Gemm { int K, lda, ldb; };

template <class Map> struct TileOrder {
    int nM, nN, nwg, G, c, rep, dup; Map map;
    __device__ __forceinline__ void init(int nM_, int nN_, int G_, int c_, int rep_ = 1, int dup_ = 1) { nM = nM_; nN = nN_; nwg = nM * nN; G = G_; c = c_; rep = rep_; dup = dup_; }
    __device__ __forceinline__ bool next(int i, Unit& u) const {
        const int round = i / rep, kb = i - round * rep;
#if PROBE_MASK
        const long L = (long)round * G + c; if (L >= (long)nwg * dup) return false;
        int wgid = (int)(L % nwg); u.dupv = L >= nwg;
#else
        const long L = (long)round * G + c; if (L >= nwg) return false;
        int wgid = (int)L; u.dupv = 0;
#endif
        { const int q = nwg / NXCD, r = nwg % NXCD, xcd = wgid % NXCD, off = wgid / NXCD; wgid = (xcd < r ? xcd * (q + 1) : r * (q + 1) + (xcd - r) * q) + off; }
        const int nig = WGM * nN, gid = wgid / nig, fm = gid * WGM, gsz = (nM - fm) < WGM ? (nM - fm) : WGM;
        u.pm = fm + ((wgid % nig) % gsz); u.pn = (wgid % nig) / gsz; u.aux = kb; map(u); return true;
    }
    __device__ __forceinline__ void a_ready(const Unit&) const {}
    __device__ __forceinline__ void done(const Unit&) const {}
};

typedef float f32x2_cv __attribute__((ext_vector_type(2))); typedef __bf16 bf16x2_cv __attribute__((ext_vector_type(2)));
__device__ __forceinline__ unsigned cvt_pk_bf16(float lo, float hi) { const f32x2_cv v = {lo, hi}; const bf16x2_cv b = __builtin_convertvector(v, bf16x2_cv); return __builtin_bit_cast(unsigned, b); }
__device__ __forceinline__ float bf2f(unsigned short v) { return __uint_as_float((unsigned)v << 16); }
__device__ __forceinline__ float bflo(unsigned w) { return __uint_as_float(w << 16); }
__device__ __forceinline__ float bfhi(unsigned w) { return __uint_as_float(w & 0xffff0000u); }
__device__ __forceinline__ unsigned pk_u8x4(float a, float b, float c, float d, float sc) {
    const unsigned fa = __float_as_uint(fmaf(a, sc, 12582912.0f)), fb = __float_as_uint(fmaf(b, sc, 12582912.0f)), fc = __float_as_uint(fmaf(c, sc, 12582912.0f)), fd = __float_as_uint(fmaf(d, sc, 12582912.0f));
    const unsigned p01 = __builtin_amdgcn_perm(fb, fa, 0x0c0c0400u), p23 = __builtin_amdgcn_perm(fd, fc, 0x0c0c0400u);
    return __builtin_amdgcn_perm(p23, p01, 0x05040100u);
}
__device__ __forceinline__ float sigm(float x) { return __builtin_amdgcn_rcpf(1.0f + __builtin_amdgcn_exp2f(-1.4426950408889634f * x)); }


template <bool GATE, bool QI = GATE> struct EpiG1T {
    static constexpr bool PERM = true, AFTER_DRAIN = false, KEEP = false;
    bf16_t* Y1; bf16_t* G; const float* bgate; const float* sH; const unsigned* cmax;
    __device__ __forceinline__ void operator()(const f32x4 (&acc)[2][2][4][2], const Unit& u, int wr, int wc, int fr, int fq) const {
        asm volatile("" : "+v"(fr), "+v"(fq));
        const int row0 = u.pm * BM + wr * 64 + fr; constexpr bool gate = GATE;
        bf16_t* base = gate ? G : Y1; const int ldc = gate ? 6144 : 4608; const int colt = gate ? (u.pn - 18) * BM : u.pn * BM;
        const int col0 = colt + wc * 32 + 8 * fq;
        f32x4 bv[2][2], cs[2][2]; float rs[2][4];
#pragma unroll
        for (int bj = 0; bj < 2; ++bj)
#pragma unroll
            for (int n = 0; n < 2; ++n) { bv[bj][n] = gate ? *(const f32x4*)(bgate + col0 + bj * HALF + 4 * n) : (f32x4){0.f, 0.f, 0.f, 0.f};
                const u32x4 cm = QI ? *(const u32x4*)(cmax + (gate ? 0 : 6144) + col0 + bj * HALF + 4 * n) : (u32x4){0u, 0u, 0u, 0u};
                cs[bj][n] = (f32x4){__uint_as_float(cm.x), __uint_as_float(cm.y), __uint_as_float(cm.z), __uint_as_float(cm.w)} * (gate ? -1.4426950408889634f / 127.0f : 1.0f / 127.0f);
                if (gate) bv[bj][n] = bv[bj][n] * (-1.4426950408889634f); }
#pragma unroll
        for (int ai = 0; ai < 2; ++ai)
#pragma unroll
            for (int m = 0; m < 4; ++m) rs[ai][m] = QI ? sH[row0 + ai * HALF + m * 16] : 0.f;
#pragma unroll
        for (int ai = 0; ai < 2; ++ai)
#pragma unroll
            for (int m = 0; m < 4; ++m) { bf16_t* rowp = base + (size_t)(row0 + ai * HALF + m * 16) * ldc + col0;
#pragma unroll
                for (int bj = 0; bj < 2; ++bj) { f32x4 v0 = acc[ai][bj][m][0] + bv[bj][0], v1 = acc[ai][bj][m][1] + bv[bj][1];
                    if (gate) {
                        const i32x4 a0 = __builtin_bit_cast(i32x4, acc[ai][bj][m][0]), a1 = __builtin_bit_cast(i32x4, acc[ai][bj][m][1]);
                        const f32x4 f0 = {(float)a0[0], (float)a0[1], (float)a0[2], (float)a0[3]}, f1 = {(float)a1[0], (float)a1[1], (float)a1[2], (float)a1[3]};
                        v0 = f0 * rs[ai][m] * cs[bj][0] + bv[bj][0]; v1 = f1 * rs[ai][m] * cs[bj][1] + bv[bj][1];
                        v0 = (f32x4){__builtin_amdgcn_exp2f(v0[0]), __builtin_amdgcn_exp2f(v0[1]), __builtin_amdgcn_exp2f(v0[2]), __builtin_amdgcn_exp2f(v0[3])} + 1.0f; v1 = (f32x4){__builtin_amdgcn_exp2f(v1[0]), __builtin_amdgcn_exp2f(v1[1]), __builtin_amdgcn_exp2f(v1[2]), __builtin_amdgcn_exp2f(v1[3])} + 1.0f; }
                    if (QI && !gate) { const i32x4 a0 = __builtin_bit_cast(i32x4, acc[ai][bj][m][0]), a1 = __builtin_bit_cast(i32x4, acc[ai][bj][m][1]);
                        v0 = (f32x4){(float)a0[0], (float)a0[1], (float)a0[2], (float)a0[3]} * rs[ai][m] * cs[bj][0]; v1 = (f32x4){(float)a1[0], (float)a1[1], (float)a1[2], (float)a1[3]} * rs[ai][m] * cs[bj][1]; }
                    if (gate) {
                        const f32x4 g0 = {__builtin_amdgcn_rcpf(v0[0]), __builtin_amdgcn_rcpf(v0[1]), __builtin_amdgcn_rcpf(v0[2]), __builtin_amdgcn_rcpf(v0[3])}, g1 = {__builtin_amdgcn_rcpf(v1[0]), __builtin_amdgcn_rcpf(v1[1]), __builtin_amdgcn_rcpf(v1[2]), __builtin_amdgcn_rcpf(v1[3])};
                        u32x2 w8; w8.x = pk_u8x4(fmaxf(g0[0], 0.00393f), fmaxf(g0[1], 0.00393f), fmaxf(g0[2], 0.00393f), fmaxf(g0[3], 0.00393f), 255.0f);
                        w8.y = pk_u8x4(fmaxf(g1[0], 0.00393f), fmaxf(g1[1], 0.00393f), fmaxf(g1[2], 0.00393f), fmaxf(g1[3], 0.00393f), 255.0f);
                        *(u32x2*)((unsigned char*)G + (size_t)(row0 + ai * HALF + m * 16) * 6144 + col0 + bj * HALF) = w8;
                    } else {
                    u32x4 w; w.x = cvt_pk_bf16(v0[0], v0[1]); w.y = cvt_pk_bf16(v0[2], v0[3]); w.z = cvt_pk_bf16(v1[0], v1[1]); w.w = cvt_pk_bf16(v1[2], v1[3]);
                    *(u32x4*)(rowp + bj * HALF) = w; } } }
    }
};
struct EpiF2 {
    static constexpr bool PERM = true, AFTER_DRAIN = false, KEEP = false;
    bf16_t* FOU; int rows_per_b, row_off, mirror; float scale; int r4;
    __device__ __forceinline__ void operator()(const f32x4 (&acc)[2][2][4][2], const Unit& u, int wr, int wc, int fr, int fq) const {
        asm volatile("" : "+v"(fr), "+v"(fq));
        const int b = u.pn >> 2, q = u.pn & 3;
        const int k0 = (r4 ? 0 : u.pm * BM) + wr * 64 + fr, col0 = q * BM + wc * 32 + 8 * fq;
        bf16_t* base = FOU + (size_t)(row_off + b * rows_per_b) * 1024 + col0;
#pragma unroll
        for (int ai = 0; ai < 2; ++ai)
#pragma unroll
            for (int m = 0; m < 4; ++m) { const int kk = r4 ? u.pm + 4 * (k0 + ai * HALF + m * 16) : k0 + ai * HALF + m * 16; bf16_t* rowp = base + (size_t)kk * 1024; bf16_t* rowm = base + (size_t)(rows_per_b - kk) * 1024;
#pragma unroll
                for (int bj = 0; bj < 2; ++bj) { const f32x4 v0 = acc[ai][bj][m][0] * scale, v1 = acc[ai][bj][m][1] * scale;
                    u32x4 w; w.x = cvt_pk_bf16(v0[0], v0[1]); w.y = cvt_pk_bf16(v0[2], v0[3]); w.z = cvt_pk_bf16(v1[0], v1[1]); w.w = cvt_pk_bf16(v1[2], v1[3]);
                    *(u32x4*)(rowp + bj * HALF) = w; if (mirror && kk > 0) *(u32x4*)(rowm + bj * HALF) = w; } }
    }
};
struct EpiBr {
    static constexpr bool PERM = true, AFTER_DRAIN = false, KEEP = true;
    const bf16_t* G; bf16_t* MG;
    __device__ __forceinline__ void operator()(f32x4 (&acc)[2][2][4][2], const Unit& u, int wr, int wc, int fr, int fq) const {
        asm volatile("" : "+v"(fr), "+v"(fq));
        const int kb = u.aux, row0 = u.pm * BM + wr * 64 + fr, col0 = u.pn * BM + wc * 32 + 8 * fq;
        const unsigned char* G8 = (const unsigned char*)G;
#define BR_U8(w) (f32x4){(float)((w) & 0xffu), (float)(((w) >> 8) & 0xffu), (float)(((w) >> 16) & 0xffu), (float)((w) >> 24)}
        const __amdgpu_buffer_rsrc_t rsG = __builtin_amdgcn_make_buffer_rsrc((void*)(((unsigned long long)(unsigned)__builtin_amdgcn_readfirstlane((int)(unsigned)((unsigned long long)G8 >> 32)) << 32) | (unsigned long long)(unsigned)__builtin_amdgcn_readfirstlane((int)(unsigned)(unsigned long long)G8)), (short)0, (int)((size_t)18432 * 6144), 0x00020000);
        const int voff = row0 * 6144 + kb * 2048 + col0;
#define BR_LD(ai, m, bj, extra) __builtin_bit_cast(u32x2, __builtin_amdgcn_raw_buffer_load_b64(rsG, voff, ((ai) * HALF + (m) * 16) * 6144 + (bj) * HALF + (extra), 0))
        u32x2 gw[2][4][2];
#pragma unroll
        for (int ai = 0; ai < 2; ++ai)
#pragma unroll
            for (int m = 0; m < 4; ++m)
#pragma unroll
                for (int bj = 0; bj < 2; ++bj) gw[ai][m][bj] = BR_LD(ai, m, bj, 0);
        if (kb < 2) {
            u32x2 hw[2][4][2];
#pragma unroll
            for (int ai = 0; ai < 2; ++ai)
#pragma unroll
                for (int m = 0; m < 4; ++m)
#pragma unroll
                    for (int bj = 0; bj < 2; ++bj) hw[ai][m][bj] = BR_LD(ai, m, bj, 2048);
            asm volatile("" ::: "memory");
#pragma unroll
            for (int ai = 0; ai < 2; ++ai)
#pragma unroll
                for (int m = 0; m < 4; ++m)
#pragma unroll
                    for (int bj = 0; bj < 2; ++bj) {
                        asm volatile("" : "+v"(gw[ai][m][bj].x), "+v"(gw[ai][m][bj].y), "+v"(hw[ai][m][bj].x), "+v"(hw[ai][m][bj].y));
                        const f32x4 n0 = BR_U8(gw[ai][m][bj].x), n1 = BR_U8(gw[ai][m][bj].y), d0 = BR_U8(hw[ai][m][bj].x), d1 = BR_U8(hw[ai][m][bj].y);
                        const f32x4 s0 = n0 * (f32x4){__builtin_amdgcn_rcpf(d0[0]), __builtin_amdgcn_rcpf(d0[1]), __builtin_amdgcn_rcpf(d0[2]), __builtin_amdgcn_rcpf(d0[3])};
                        const f32x4 s1 = n1 * (f32x4){__builtin_amdgcn_rcpf(d1[0]), __builtin_amdgcn_rcpf(d1[1]), __builtin_amdgcn_rcpf(d1[2]), __builtin_amdgcn_rcpf(d1[3])};
                        acc[ai][bj][m][0] = acc[ai][bj][m][0] * s0; acc[ai][bj][m][1] = acc[ai][bj][m][1] * s1;
                        asm volatile("" : "+v"(acc[ai][bj][m][0]), "+v"(acc[ai][bj][m][1])); }
        } else {
            asm volatile("" ::: "memory");
#pragma unroll
            for (int ai = 0; ai < 2; ++ai)
#pragma unroll
                for (int m = 0; m < 4; ++m)
#pragma unroll
                    for (int bj = 0; bj < 2; ++bj) { asm volatile("" : "+v"(gw[ai][m][bj].x), "+v"(gw[ai][m][bj].y));
                        const f32x4 v0 = acc[ai][bj][m][0] * (BR_U8(gw[ai][m][bj].x) * (1.0f / 255.0f)), v1 = acc[ai][bj][m][1] * (BR_U8(gw[ai][m][bj].y) * (1.0f / 255.0f));
                        u32x4 w; w.x = cvt_pk_bf16(v0[0], v0[1]); w.y = cvt_pk_bf16(v0[2], v0[3]); w.z = cvt_pk_bf16(v1[0], v1[1]); w.w = cvt_pk_bf16(v1[2], v1[3]);
                        *(u32x4*)(MG + (size_t)(row0 + ai * HALF + m * 16) * 2048 + col0 + bj * HALF) = w; }
        }
        asm volatile("" ::: "memory");
#undef BR_U8
#undef BR_LD
    }
};
struct EpiRes {
    static constexpr bool PERM = true, AFTER_DRAIN = false, KEEP = false;
    bf16_t* X; const float* gv; bf16_t* Xdup;
    __device__ __forceinline__ void operator()(const f32x4 (&acc)[2][2][4][2], const Unit& u, int wr, int wc, int fr, int fq) const {
        asm volatile("" : "+v"(fr), "+v"(fq));
        const int rsel = u.pm < 64 ? (u.pm >> 3) : 8; const float* gr = gv + (size_t)rsel * 12288;
        const int row0 = u.pm * BM + wr * 64 + fr, col0 = u.pn * BM + wc * 32 + 8 * fq;
        f32x4 gvv[2][2];
#pragma unroll
        for (int bj = 0; bj < 2; ++bj)
#pragma unroll
            for (int n = 0; n < 2; ++n) gvv[bj][n] = *(const f32x4*)(gr + col0 + bj * HALF + n * 4);
        u32x4 xw[2][4][2];
#pragma unroll
        for (int ai = 0; ai < 2; ++ai)
#pragma unroll
            for (int m = 0; m < 4; ++m)
#pragma unroll
                for (int bj = 0; bj < 2; ++bj) xw[ai][m][bj] = *(const u32x4*)(X + (size_t)(row0 + ai * HALF + m * 16) * 2048 + col0 + bj * HALF);
#pragma unroll
        for (int ai = 0; ai < 2; ++ai)
#pragma unroll
            for (int m = 0; m < 4; ++m) { bf16_t* rowp = X + (size_t)(row0 + ai * HALF + m * 16) * 2048 + col0;
#pragma unroll
                for (int bj = 0; bj < 2; ++bj) { bf16_t* p = rowp + bj * HALF; bf16_t* pw = PROBE_MASK ? (u.dupv ? Xdup + (p - X) : p) : p;
                    const u32x4 x = xw[ai][m][bj];
                    const f32x4 v0 = (f32x4){bflo(x.x), bfhi(x.x), bflo(x.y), bfhi(x.y)} + gvv[bj][0] * acc[ai][bj][m][0];
                    const f32x4 v1 = (f32x4){bflo(x.z), bfhi(x.z), bflo(x.w), bfhi(x.w)} + gvv[bj][1] * acc[ai][bj][m][1];
                    u32x4 w; w.x = cvt_pk_bf16(v0[0], v0[1]); w.y = cvt_pk_bf16(v0[2], v0[3]); w.z = cvt_pk_bf16(v1[0], v1[1]); w.w = cvt_pk_bf16(v1[2], v1[3]);
                    *(u32x4*)pw = w; } }
    }
};
struct EpiResSlab {
    static constexpr bool PERM = false, AFTER_DRAIN = false, KEEP = false;
    float* SL; const float* gv;
    __device__ __forceinline__ void operator()(const f32x4 (&acc)[2][2][4][2], const Unit& u, int wr, int wc, int fr, int fq) const {
        asm volatile("" : "+v"(fr), "+v"(fq));
        const float* gr = gv + (size_t)8 * 12288;
        const int row0 = (u.pm - 64) * BM + wr * 64 + fr, col0 = u.pn * BM + wc * 32 + 4 * fq;
        float* base = SL + (size_t)u.aux * 2048 * 2048;
        f32x4 gvv[2][2];
#pragma unroll
        for (int bj = 0; bj < 2; ++bj)
#pragma unroll
            for (int n = 0; n < 2; ++n) gvv[bj][n] = *(const f32x4*)(gr + col0 + bj * HALF + n * 16);
#pragma unroll
        for (int ai = 0; ai < 2; ++ai)
#pragma unroll
            for (int m = 0; m < 4; ++m) { float* rowp = base + (size_t)(row0 + ai * HALF + m * 16) * 2048 + col0;
#pragma unroll
                for (int bj = 0; bj < 2; ++bj)
#pragma unroll
                    for (int n = 0; n < 2; ++n) *(f32x4*)(rowp + bj * HALF + n * 16) = gvv[bj][n] * acc[ai][bj][m][n]; }
    }
};
struct QuarterOrder {
    int G, c; const char* A; const char* B; size_t astep, bstep, kbytes;
    __device__ __forceinline__ bool next(int i, Unit& u) const {
        const int L = i * G + c; if (L >= 256) return false;
        u.pm = 64 + (L >> 5); u.pn = (L >> 2) & 7; u.aux = L & 3; u.dupv = 0;
        u.A = A + (size_t)u.pm * astep + (size_t)u.aux * kbytes; u.B = B + (size_t)u.pn * bstep + (size_t)u.aux * kbytes; return true;
    }
    __device__ __forceinline__ void a_ready(const Unit&) const {}
    __device__ __forceinline__ void done(const Unit&) const {}
};
struct EpiSwi {
    static constexpr bool PERM = true, AFTER_DRAIN = false, KEEP = false;
    bf16_t* ACT;
    __device__ __forceinline__ void operator()(const f32x4 (&acc)[2][2][4][2], const Unit& u, int wr, int wc, int fr, int fq) const {
        asm volatile("" : "+v"(fr), "+v"(fq));
        const int row0 = u.pm * BM + wr * 64 + fr, col0 = u.pn * HALF + wc * 32 + 8 * fq;
#pragma unroll
        for (int ai = 0; ai < 2; ++ai)
#pragma unroll
            for (int m = 0; m < 4; ++m) { bf16_t* rowp = ACT + (size_t)(row0 + ai * HALF + m * 16) * 5632 + col0;
                f32x4 o[2];
#pragma unroll
                for (int n = 0; n < 2; ++n) { const f32x4 g = acc[ai][0][m][n], up = acc[ai][1][m][n];
                    o[n] = (f32x4){g[0] * sigm(g[0]) * up[0], g[1] * sigm(g[1]) * up[1], g[2] * sigm(g[2]) * up[2], g[3] * sigm(g[3]) * up[3]}; }
                u32x4 w; w.x = cvt_pk_bf16(o[0][0], o[0][1]); w.y = cvt_pk_bf16(o[0][2], o[0][3]); w.z = cvt_pk_bf16(o[1][0], o[1][1]); w.w = cvt_pk_bf16(o[1][2], o[1][3]);
                *(u32x4*)rowp = w; }
    }
};

struct EpiSwi8 {
    static constexpr bool PERM = true, AFTER_DRAIN = false, KEEP = false;
    bf16_t* ACT; const float* sH; const unsigned* cmax;
    __device__ __forceinline__ void operator()(const f32x4 (&acc)[2][2][4][2], const Unit& u, int wr, int wc, int fr, int fq) const {
        asm volatile("" : "+v"(fr), "+v"(fq));
        const int row0 = u.pm * BM + wr * 64 + fr, col0 = u.pn * HALF + wc * 32 + 8 * fq, t0 = u.pn * BM + wc * 32 + 8 * fq;
        f32x4 cg[2], cu[2]; float rs[2][4];
#pragma unroll
        for (int n = 0; n < 2; ++n) { const u32x4 a = *(const u32x4*)(cmax + t0 + 4 * n), b = *(const u32x4*)(cmax + t0 + HALF + 4 * n);
            cg[n] = (f32x4){__uint_as_float(a.x), __uint_as_float(a.y), __uint_as_float(a.z), __uint_as_float(a.w)} * (1.0f / 127.0f);
            cu[n] = (f32x4){__uint_as_float(b.x), __uint_as_float(b.y), __uint_as_float(b.z), __uint_as_float(b.w)} * (1.0f / 127.0f); }
#pragma unroll
        for (int ai = 0; ai < 2; ++ai)
#pragma unroll
            for (int m = 0; m < 4; ++m) rs[ai][m] = sH[row0 + ai * HALF + m * 16];
#pragma unroll
        for (int ai = 0; ai < 2; ++ai)
#pragma unroll
            for (int m = 0; m < 4; ++m) { bf16_t* rowp = ACT + (size_t)(row0 + ai * HALF + m * 16) * 5632 + col0;
                f32x4 o[2];
#pragma unroll
                for (int n = 0; n < 2; ++n) { const i32x4 ag = __builtin_bit_cast(i32x4, acc[ai][0][m][n]), au = __builtin_bit_cast(i32x4, acc[ai][1][m][n]);
                    const f32x4 g = (f32x4){(float)ag[0], (float)ag[1], (float)ag[2], (float)ag[3]} * rs[ai][m] * cg[n], up = (f32x4){(float)au[0], (float)au[1], (float)au[2], (float)au[3]} * rs[ai][m] * cu[n];
                    o[n] = (f32x4){g[0] * sigm(g[0]) * up[0], g[1] * sigm(g[1]) * up[1], g[2] * sigm(g[2]) * up[2], g[3] * sigm(g[3]) * up[3]}; }
                u32x4 w; w.x = cvt_pk_bf16(o[0][0], o[0][1]); w.y = cvt_pk_bf16(o[0][2], o[0][3]); w.z = cvt_pk_bf16(o[1][0], o[1][1]); w.w = cvt_pk_bf16(o[1][2], o[1][3]);
                *(u32x4*)rowp = w; }
    }
};

template <class Epi, class Sched, bool ALIGN_EPI = false, bool SP2 = false, int QM = 0>
__device__ __forceinline__ void gemm_phase(PG8_LAS unsigned char* lds, const Gemm g, const Sched& S, const Epi& E, const int tid) {
    { unsigned l32_ = (unsigned)(unsigned long long)lds; asm volatile("" : "+s"(l32_)); lds = (PG8_LAS unsigned char*)(unsigned long long)l32_; }
    const int wid = __builtin_amdgcn_readfirstlane(tid >> 6), lane = tid & 63, wr = wid >> 2, wc = wid & 3, fr = lane & 15, fq = lane >> 4;
    const int K = g.K, nt = K / BK;
    unsigned voffA, voffB;
    { int R, C; stage_rc(tid * 16, R, C); const int Rb = Epi::PERM ? ((R & ~31) + perm32(R & 31)) : R;
        voffA = (unsigned)(R * g.lda + C) * 2u; voffB = (unsigned)(Rb * g.ldb + C) * 2u; }
    const size_t rstepA = (size_t)64 * g.lda * 2, rstepB = (size_t)64 * g.ldb * 2;
    const size_t kstep = (size_t)(BK * 2);
    const size_t hstepA = (size_t)HALF * g.lda * 2, hstepB = (size_t)HALF * g.ldb * 2;
    const unsigned ldsw = (unsigned)wid * 1024u;
    const int aoff = lds_byte(wr * 64 + fr, fq * 8), boff = lds_byte(wc * 32 + fr, fq * 8);
#define PG8_SA(b, h) (((b) * 2 + (h)) * HTB)
#define PG8_SB(b, h) ((4 + (b) * 2 + (h)) * HTB)
#define PG8_STAGE(bufoff, gbase, voff) do { _Pragma("unroll") for (int _i = 0; _i < 2; ++_i) \
        __builtin_amdgcn_global_load_lds((const unsigned*)((const char*)(gbase) + (size_t)_i * rstep_##voff + (voff)), (PG8_LAS unsigned*)(lds + (bufoff) + ldsw + _i * 8192), 16, 0, 0); } while (0)
#define rstep_voffA rstepA
#define rstep_voffB rstepB
#define PG8_LDA(dst, b, h) do { _Pragma("unroll") for (int m = 0; m < 4; ++m) _Pragma("unroll") for (int k = 0; k < 2; ++k) dst[m][k] = *(const PG8_LAS bf16x8*)(lds + PG8_SA(b, h) + aoff + m * 2048 + k * 1024); } while (0)
#define PG8_LDB(dst, b, h) do { _Pragma("unroll") for (int n = 0; n < 2; ++n) _Pragma("unroll") for (int k = 0; k < 2; ++k) dst[n][k] = *(const PG8_LAS bf16x8*)(lds + PG8_SB(b, h) + boff + n * 2048 + k * 1024); } while (0)
#define PG8_CAT(x, y) __builtin_shufflevector(__builtin_bit_cast(i32x4, x), __builtin_bit_cast(i32x4, y), 0, 1, 2, 3, 4, 5, 6, 7)
#define PG8_MMA(ai, bj, At, Bt) do { __builtin_amdgcn_s_setprio(1); \
        if constexpr (QM == 1) { _Pragma("unroll") for (int m = 0; m < 4; ++m) _Pragma("unroll") for (int n = 0; n < 2; ++n) \
            acc[ai][bj][m][n] = __builtin_amdgcn_mfma_scale_f32_16x16x128_f8f6f4(PG8_CAT(Bt[n][0], Bt[n][1]), PG8_CAT(At[m][0], At[m][1]), acc[ai][bj][m][n], 0, 0, 0, 0x7f7f7f7f, 0, 0x7f7f7f7f); } \
        else if constexpr (QM == 2) { _Pragma("unroll") for (int m = 0; m < 4; ++m) _Pragma("unroll") for (int n = 0; n < 2; ++n) _Pragma("unroll") for (int k = 0; k < 2; ++k) \
            acc[ai][bj][m][n] = __builtin_bit_cast(f32x4, __builtin_amdgcn_mfma_i32_16x16x64_i8(__builtin_bit_cast(i32x4, Bt[n][k]), __builtin_bit_cast(i32x4, At[m][k]), __builtin_bit_cast(i32x4, acc[ai][bj][m][n]), 0, 0, 0)); } \
        else { _Pragma("unroll") for (int m = 0; m < 4; ++m) _Pragma("unroll") for (int n = 0; n < 2; ++n) _Pragma("unroll") for (int k = 0; k < 2; ++k) \
            acc[ai][bj][m][n] = __builtin_amdgcn_mfma_f32_16x16x32_bf16(Bt[n][k], At[m][k], acc[ai][bj][m][n], 0, 0, 0); } \
        __builtin_amdgcn_s_setprio(0); } while (0)
#define PG8_WAIT_V(n) asm volatile("s_waitcnt vmcnt(" #n ")" ::: "memory")
#define PG8_WAIT_L(n) asm volatile("s_waitcnt lgkmcnt(" #n ")" ::: "memory")
#define PG8_BAR __builtin_amdgcn_s_barrier()
#define PG8_SCHED __builtin_amdgcn_sched_barrier(0)
    Unit cur, nxt; int ui = 0;
    if (!S.next(0, cur)) return;
    f32x4 acc[2][2][4][2];
#pragma unroll
    for (int a = 0; a < 2; ++a)
#pragma unroll
        for (int b = 0; b < 2; ++b)
#pragma unroll
            for (int m = 0; m < 4; ++m)
#pragma unroll
                for (int n = 0; n < 2; ++n) acc[a][b][m][n] = (f32x4){0.f, 0.f, 0.f, 0.f};
    bf16x8 At[4][2], B0[2][2], B1[2][2];
    const char* cA = cur.A; const char* cB = cur.B;
    S.a_ready(cur);
    if constexpr (SP2) {
        PG8_STAGE(PG8_SB(0, 0), cB, voffB); PG8_STAGE(PG8_SB(0, 1), cB + hstepB, voffB); PG8_STAGE(PG8_SA(0, 0), cA, voffA); PG8_STAGE(PG8_SA(0, 1), cA + hstepA, voffA);
        if (wr == 1) PG8_BAR;
        PG8_WAIT_V(2); PG8_BAR;
        PG8_STAGE(PG8_SB(1, 0), cB + kstep, voffB); PG8_STAGE(PG8_SA(1, 0), cA + kstep, voffA); PG8_STAGE(PG8_SB(1, 1), cB + hstepB + kstep, voffB);
        PG8_WAIT_V(6); PG8_BAR;
    } else {
        PG8_STAGE(PG8_SB(0, 0), cB, voffB); PG8_STAGE(PG8_SA(0, 0), cA, voffA); PG8_STAGE(PG8_SB(0, 1), cB + hstepB, voffB); PG8_STAGE(PG8_SA(0, 1), cA + hstepA, voffA);
        if (wr == 1) PG8_BAR;
        PG8_WAIT_V(4); PG8_BAR;
        PG8_STAGE(PG8_SB(1, 0), cB + kstep, voffB); PG8_STAGE(PG8_SA(1, 0), cA + kstep, voffA); PG8_STAGE(PG8_SB(1, 1), cB + hstepB + kstep, voffB);
        PG8_WAIT_V(6); PG8_BAR;
    }
    for (;;) {
        const bool has_next = S.next(ui + 1, nxt);
        const char* nA = has_next ? nxt.A : cA; const char* nB = has_next ? nxt.B : cB;
        for (int t = 0; t < nt; t += 2) {
            const bool last = (t == nt - 2);
            const char* a1 = cA + (size_t)(t + 1) * kstep;
            const char* a2 = last ? nA : cA + (size_t)(t + 2) * kstep; const char* b2 = last ? nB : cB + (size_t)(t + 2) * kstep;
            const char* a3 = a2 + kstep; const char* b3 = b2 + kstep;
            if (last && has_next) S.a_ready(nxt);
            if constexpr (SP2) {
            PG8_LDB(B0, 0, 0); PG8_LDB(B1, 0, 1); PG8_SCHED; PG8_LDA(At, 0, 0); PG8_STAGE(PG8_SA(1, 1), a1 + hstepA, voffA);
            PG8_WAIT_V(8); PG8_WAIT_L(0); PG8_BAR; PG8_MMA(0, 0, At, B0); PG8_MMA(0, 1, At, B1); PG8_BAR; PG8_SCHED;
            PG8_LDA(At, 0, 1); PG8_STAGE(PG8_SB(0, 0), b2, voffB); PG8_STAGE(PG8_SB(0, 1), b2 + hstepB, voffB); PG8_STAGE(PG8_SA(0, 0), a2, voffA);
            PG8_WAIT_V(8); PG8_WAIT_L(0); PG8_BAR; PG8_MMA(1, 0, At, B0); PG8_MMA(1, 1, At, B1); PG8_BAR; PG8_SCHED;
            PG8_LDB(B0, 1, 0); PG8_LDB(B1, 1, 1); PG8_SCHED; PG8_LDA(At, 1, 0); PG8_STAGE(PG8_SA(0, 1), a2 + hstepA, voffA);
            PG8_WAIT_V(8); PG8_WAIT_L(0); PG8_BAR; PG8_MMA(0, 0, At, B0); PG8_MMA(0, 1, At, B1); PG8_BAR; PG8_SCHED;
            PG8_LDA(At, 1, 1); PG8_STAGE(PG8_SB(1, 0), b3, voffB); PG8_STAGE(PG8_SB(1, 1), b3 + hstepB, voffB); PG8_STAGE(PG8_SA(1, 0), a3, voffA);
            PG8_WAIT_V(8); PG8_WAIT_L(0); PG8_BAR; PG8_MMA(1, 0, At, B0); PG8_MMA(1, 1, At, B1); PG8_BAR; PG8_SCHED;
            } else {
            PG8_LDB(B0, 0, 0); PG8_SCHED; PG8_LDA(At, 0, 0); PG8_STAGE(PG8_SA(1, 1), a1 + hstepA, voffA);
            PG8_WAIT_L(8); PG8_BAR; PG8_WAIT_L(0); PG8_MMA(0, 0, At, B0); PG8_BAR; PG8_SCHED;
            PG8_LDB(B1, 0, 1); PG8_STAGE(PG8_SB(0, 0), b2, voffB);
            PG8_BAR; PG8_WAIT_L(0); PG8_MMA(0, 1, At, B1); PG8_BAR;
            PG8_LDA(At, 0, 1); PG8_STAGE(PG8_SA(0, 0), a2, voffA);
            PG8_BAR; PG8_WAIT_L(0); PG8_MMA(1, 0, At, B0); PG8_BAR; PG8_SCHED;
            PG8_STAGE(PG8_SB(0, 1), b2 + hstepB, voffB);
            PG8_WAIT_V(6); PG8_BAR; PG8_MMA(1, 1, At, B1); PG8_BAR;
            PG8_LDB(B0, 1, 0); PG8_SCHED; PG8_LDA(At, 1, 0); PG8_STAGE(PG8_SA(0, 1), a2 + hstepA, voffA);
            PG8_WAIT_L(8); PG8_BAR; PG8_WAIT_L(0); PG8_MMA(0, 0, At, B0); PG8_BAR; PG8_SCHED;
            PG8_LDB(B1, 1, 1); PG8_STAGE(PG8_SB(1, 0), b3, voffB);
            PG8_BAR; PG8_WAIT_L(0); PG8_MMA(0, 1, At, B1); PG8_BAR;
            PG8_LDA(At, 1, 1); PG8_STAGE(PG8_SA(1, 0), a3, voffA);
            PG8_BAR; PG8_WAIT_L(0); PG8_MMA(1, 0, At, B0); PG8_BAR; PG8_SCHED;
            PG8_STAGE(PG8_SB(1, 1), b3 + hstepB, voffB);
            PG8_WAIT_V(6); PG8_BAR; PG8_MMA(1, 1, At, B1); PG8_BAR;
            }
        }
        if constexpr (ALIGN_EPI) { if (wr == 0) PG8_BAR; }
        if constexpr (!Epi::AFTER_DRAIN) { int l2_; asm volatile("v_mbcnt_lo_u32_b32 %0, -1, 0\n\tv_mbcnt_hi_u32_b32 %0, -1, %0" : "=v"(l2_)); E(acc, cur, wr, wc, l2_ & 15, l2_ >> 4); S.done(cur); }
        if (!has_next) break;
        if (!(Epi::KEEP && cur.aux < 2)) {
#pragma unroll
        for (int a = 0; a < 2; ++a)
#pragma unroll
            for (int b = 0; b < 2; ++b)
#pragma unroll
                for (int m = 0; m < 4; ++m)
#pragma unroll
                    for (int n = 0; n < 2; ++n) acc[a][b][m][n] = (f32x4){0.f, 0.f, 0.f, 0.f};
        }
        cur = nxt; cA = nA; cB = nB; ++ui;
        if constexpr (ALIGN_EPI) { if (wr == 1) PG8_BAR; }
    }
    PG8_WAIT_V(0);
    if constexpr (!ALIGN_EPI) { if (wr == 0) PG8_BAR; }
    PG8_BAR;
    if constexpr (Epi::AFTER_DRAIN) { E.fused(acc, cur, wr, wc, fr, fq, lds, wid, lane); S.done(cur); }
#undef PG8_SA
#undef PG8_SB
#undef PG8_STAGE
#undef rstep_voffA
#undef rstep_voffB
#undef PG8_LDA
#undef PG8_LDB
#undef PG8_MMA
#undef PG8_CAT
#undef PG8_WAIT_V
#undef PG8_WAIT_L
#undef PG8_BAR
#undef PG8_SCHED
}
}

namespace att {
typedef unsigned short bf16_t;
using bf16x8 = __attribute__((ext_vector_type(8))) short;
using s16x4  = __attribute__((ext_vector_type(4))) short;
using f32x16 = __attribute__((ext_vector_type(16))) float;
using f32x4  = __attribute__((ext_vector_type(4))) float;
using u32x4  = __attribute__((ext_vector_type(4))) unsigned;
constexpr int D = 128, NW = 8, QBLK = 32, KVBLK = 64;
constexpr float SCALE = 0.088388347648318440f;
constexpr float THR = 8.f;
constexpr int SDEPTH = 2;
constexpr size_t SHM_V = KVBLK * D * 2, SHM_K = KVBLK * D * 2, SHM_ATTN = 2 * SHM_V + 2 * SHM_K + NW * 64 * 4;
#define KSWZ(row, colB) ((row) * 256 + ((colB) ^ (((row) & 7) << 4)))
#define SBAR() __builtin_amdgcn_sched_barrier(0)
__device__ __forceinline__ int crow(int r, int hi) { return (r & 3) + 8 * (r >> 2) + 4 * hi; }
__device__ __forceinline__ unsigned cvtpk(float lo, float hi) { unsigned r; asm volatile("v_cvt_pk_bf16_f32 %0, %1, %2" : "=v"(r) : "v"(lo), "v"(hi)); return r; }
__device__ __forceinline__ bf16x8 ld8(const bf16_t* p) { return *reinterpret_cast<const bf16x8*>(p); }
__device__ __forceinline__ float b2f(short v) { return __uint_as_float(((unsigned)(unsigned short)v) << 16); }

__device__ __forceinline__ void partialSM(f32x16& p0, f32x16& p1, float& m_reg, float& mn, float& alpha) {
  constexpr float C = SCALE * 1.4426950408889634f;
  float pmax = p0[0]; for (int r = 1; r < 16; ++r) pmax = fmaxf(pmax, p0[r]); for (int r = 0; r < 16; ++r) pmax = fmaxf(pmax, p1[r]);
  { auto rr = __builtin_amdgcn_permlane32_swap(__float_as_uint(pmax), __float_as_uint(pmax), false, false);
    pmax = fmaxf(__uint_as_float(rr[0]), __uint_as_float(rr[1])); }
  if (__builtin_expect(__all(pmax - m_reg <= THR / SCALE), 1)) { mn = m_reg; alpha = 1.f; }
  else { mn = fmaxf(m_reg, pmax); alpha = __builtin_amdgcn_exp2f((m_reg - mn) * C); m_reg = mn; }
  float mnC = -mn * C;
  for (int r = 0; r < 16; ++r) p0[r] = fmaf(p0[r], C, mnC); for (int r = 0; r < 16; ++r) p1[r] = fmaf(p1[r], C, mnC);
  for (int r = 0; r < 16; ++r) p0[r] = __builtin_amdgcn_exp2f(p0[r]);
}
__device__ __forceinline__ void finishSM(f32x16& p0, f32x16& p1, float alpha, float& l_reg, bf16x8& pa0, bf16x8& pa1, bf16x8& pa2, bf16x8& pa3) {
  for (int r = 0; r < 16; ++r) p1[r] = __builtin_amdgcn_exp2f(p1[r]);
  float ps = 0; for (int r = 0; r < 16; ++r) ps += p0[r]; for (int r = 0; r < 16; ++r) ps += p1[r];
  { auto rr = __builtin_amdgcn_permlane32_swap(__float_as_uint(ps), __float_as_uint(ps), false, false);
    ps = __uint_as_float(rr[0]) + __uint_as_float(rr[1]); }
  l_reg = l_reg * alpha + ps;
#define PK4(P, BASE, OUT) do { unsigned a0 = cvtpk(P[BASE + 0], P[BASE + 1]), a1 = cvtpk(P[BASE + 2], P[BASE + 3]);   \
    unsigned b0 = cvtpk(P[BASE + 4], P[BASE + 5]), b1 = cvtpk(P[BASE + 6], P[BASE + 7]);                              \
    auto r0 = __builtin_amdgcn_permlane32_swap(a0, b0, false, false); auto r1 = __builtin_amdgcn_permlane32_swap(a1, b1, false, false); \
    u32x4 w = {r0[0], r1[0], r0[1], r1[1]}; OUT = *reinterpret_cast<bf16x8*>(&w); } while (0)
  PK4(p0, 0, pa0); PK4(p0, 8, pa1); PK4(p1, 0, pa2); PK4(p1, 8, pa3);
#undef PK4
}
__device__ __forceinline__ void qkt(f32x16& p0, f32x16& p1, const bf16_t* Ks, const bf16x8* qr, int r32, int hi) {
  p0 = f32x16{}; p1 = f32x16{};
  for (int d0 = 0; d0 < 8; ++d0) { int cb = (d0 * 16 + hi * 8) * 2;
    bf16x8 b0 = *reinterpret_cast<const bf16x8*>((const char*)Ks + KSWZ(r32, cb));
    bf16x8 b1 = *reinterpret_cast<const bf16x8*>((const char*)Ks + KSWZ(32 + r32, cb));
    p0 = __builtin_amdgcn_mfma_f32_32x32x16_bf16(b0, qr[d0], p0, 0, 0, 0);
    p1 = __builtin_amdgcn_mfma_f32_32x32x16_bf16(b1, qr[d0], p1, 0, 0, 0); }
}
__device__ __forceinline__ int v_st(int k, int c) { const int kk = (k & ~0xC) | ((k & 4) << 1) | ((k & 8) >> 1); return ((kk >> 3) * 4 + (c >> 5)) * 512 + ((kk & 7) * 32 + (c & 31)) * 2; }
__device__ __forceinline__ int v_rd_base(int lane) { return ((lane & 3) << 3) | (((lane >> 2) & 3) << 6) | (((lane >> 4) & 1) << 5) | (((lane >> 5) & 1) << 8); }
constexpr int v_rd_off(int d0, int ks, int half) { return d0 * 512 + ks * 4096 + half * 2048; }
template <int OFF> __device__ __forceinline__ s16x4 tr_read(int vb) {
  s16x4 r; asm volatile("ds_read_b64_tr_b16 %0, %1 offset:%2" : "=&v"(r) : "v"(vb), "i"(OFF) : "memory"); return r;
}
template <int D0> __device__ __forceinline__ void pv_one(f32x16& od, int vb, bf16x8 pa0, bf16x8 pa1, bf16x8 pa2, bf16x8 pa3) {
  const s16x4 l0 = tr_read<v_rd_off(D0, 0, 0)>(vb), h0 = tr_read<v_rd_off(D0, 0, 1)>(vb), l1 = tr_read<v_rd_off(D0, 1, 0)>(vb), h1 = tr_read<v_rd_off(D0, 1, 1)>(vb);
  const s16x4 l2 = tr_read<v_rd_off(D0, 2, 0)>(vb), h2 = tr_read<v_rd_off(D0, 2, 1)>(vb), l3 = tr_read<v_rd_off(D0, 3, 0)>(vb), h3 = tr_read<v_rd_off(D0, 3, 1)>(vb);
  asm volatile("s_waitcnt lgkmcnt(0)" ::: "memory"); SBAR();
#define PK(L, H) (bf16x8){L[0], L[1], L[2], L[3], H[0], H[1], H[2], H[3]}
  od = __builtin_amdgcn_mfma_f32_32x32x16_bf16(pa0, PK(l0, h0), od, 0, 0, 0);
  od = __builtin_amdgcn_mfma_f32_32x32x16_bf16(pa1, PK(l1, h1), od, 0, 0, 0);
  od = __builtin_amdgcn_mfma_f32_32x32x16_bf16(pa2, PK(l2, h2), od, 0, 0, 0);
  od = __builtin_amdgcn_mfma_f32_32x32x16_bf16(pa3, PK(l3, h3), od, 0, 0, 0);
#undef PK
}
__device__ __forceinline__ void pv_d0(f32x16* o, int vb, bf16x8 pa0, bf16x8 pa1, bf16x8 pa2, bf16x8 pa3) {
  pv_one<0>(o[0], vb, pa0, pa1, pa2, pa3); pv_one<1>(o[1], vb, pa0, pa1, pa2, pa3); pv_one<2>(o[2], vb, pa0, pa1, pa2, pa3); pv_one<3>(o[3], vb, pa0, pa1, pa2, pa3);
}

__device__ __forceinline__ void attn_unit(const bf16_t* __restrict__ Qb, int ldq, const bf16_t* __restrict__ K0, const bf16_t* __restrict__ K1, const bf16_t* __restrict__ V0, const bf16_t* __restrict__ V1,
                                          int n0, int NT, int ldk, int ldv, bf16_t* __restrict__ Ob, int ldo, const float* __restrict__ qgain, const float* __restrict__ rope_cs, char* lds, int tid) {
  asm volatile("" : "+v"(tid));
  const int wid = tid >> 6, lane = tid & 63, r32 = lane & 31, hi = lane >> 5;
  bf16_t* V_lds = (bf16_t*)lds; bf16_t* K_lds = (bf16_t*)(lds + 2 * SHM_V);
  float* ws = (float*)(lds + 2 * SHM_V + 2 * SHM_K) + wid * 64; float* li_l = ws; float* al_l = ws + 32;
  float m_reg = -1e30f, l_reg = 0; f32x16 o[4] = {}; bf16x8 qr[8];
  const bf16_t* Qw = Qb + (long)(wid * QBLK + r32) * ldq + hi * 8;
#pragma unroll
  for (int d0 = 0; d0 < 8; ++d0) qr[d0] = ld8(Qw + d0 * 16);
  {
    float ss = 0.f;
#pragma unroll
    for (int d0 = 0; d0 < 8; ++d0)
#pragma unroll
      for (int j = 0; j < 8; ++j) { const float f = b2f(qr[d0][j]); ss += f * f; }
    { auto rr = __builtin_amdgcn_permlane32_swap(__float_as_uint(ss), __float_as_uint(ss), false, false); ss = __uint_as_float(rr[0]) + __uint_as_float(rr[1]); }
    const float rstd = 1.0f / sqrtf(ss * (1.0f / 128.0f) + 1e-6f);
#pragma unroll
    for (int d0 = 0; d0 < 4; ++d0) {
      const int i0 = d0 * 16 + hi * 8;
      const f32x4 ga0 = *(const f32x4*)(qgain + i0), ga1 = *(const f32x4*)(qgain + i0 + 4), gb0 = *(const f32x4*)(qgain + 64 + i0), gb1 = *(const f32x4*)(qgain + 64 + i0 + 4);
      float a[8], b[8];
#pragma unroll
      for (int j = 0; j < 8; ++j) { a[j] = b2f(qr[d0][j]) * rstd * (j < 4 ? ga0[j & 3] : ga1[j & 3]); b[j] = b2f(qr[d0 + 4][j]) * rstd * (j < 4 ? gb0[j & 3] : gb1[j & 3]); }
      if (rope_cs) {
        const float* cp = rope_cs + (long)(wid * QBLK + r32) * 64 + i0;
        const f32x4 c0 = *(const f32x4*)cp, c1 = *(const f32x4*)(cp + 4), s0 = *(const f32x4*)(cp + 2048 * 64), s1 = *(const f32x4*)(cp + 2048 * 64 + 4);
#pragma unroll
        for (int j = 0; j < 8; ++j) { const float c = j < 4 ? c0[j & 3] : c1[j & 3], s = j < 4 ? s0[j & 3] : s1[j & 3]; const float na = a[j] * c - b[j] * s, nb = b[j] * c + a[j] * s; a[j] = na; b[j] = nb; }
      }
      u32x4 wa = {cvtpk(a[0], a[1]), cvtpk(a[2], a[3]), cvtpk(a[4], a[5]), cvtpk(a[6], a[7])}, wb = {cvtpk(b[0], b[1]), cvtpk(b[2], b[3]), cvtpk(b[4], b[5]), cvtpk(b[6], b[7])};
      qr[d0] = *reinterpret_cast<bf16x8*>(&wa); qr[d0 + 4] = *reinterpret_cast<bf16x8*>(&wb);
    }
  }
  const int sr = tid >> 4, sc = (tid & 15) * 8, vst0 = v_st(sr, sc), vst1 = v_st(32 + sr, sc);
  const int vb0 = (int)(uintptr_t)V_lds + v_rd_base(lane);
  struct { bf16x8 vs0, vs1, ks0, ks1; } sr_[SDEPTH];
#define SLOAD(i, tile) do { const int tl_ = (tile); const bf16_t* kp_ = tl_ < n0 ? K0 + (long)tl_ * KVBLK * ldk : K1 + (long)(tl_ - n0) * KVBLK * ldk; \
    const bf16_t* vp_ = tl_ < n0 ? V0 + (long)tl_ * KVBLK * ldv : V1 + (long)(tl_ - n0) * KVBLK * ldv; \
    sr_[i].vs0 = ld8(vp_ + (long)sr * ldv + sc); sr_[i].vs1 = ld8(vp_ + (long)(32 + sr) * ldv + sc); \
    sr_[i].ks0 = ld8(kp_ + (long)sr * ldk + sc); sr_[i].ks1 = ld8(kp_ + (long)(32 + sr) * ldk + sc); } while (0)
#define SWRITE(b, i) do { *(bf16x8*)((char*)V_lds + (b) * SHM_V + vst0) = sr_[i].vs0;          \
    *(bf16x8*)((char*)V_lds + (b) * SHM_V + vst1) = sr_[i].vs1; int kc = sc * 2;               \
    *(bf16x8*)((char*)K_lds + (b) * SHM_K + KSWZ(sr, kc)) = sr_[i].ks0;                       \
    *(bf16x8*)((char*)K_lds + (b) * SHM_K + KSWZ(32 + sr, kc)) = sr_[i].ks1; } while (0)
#define SWAIT() asm volatile("s_waitcnt vmcnt(4)" ::: "memory")
#define RESC(a) do { if (__any((a) < 1.f)) { if (hi == 0) al_l[r32] = (a); asm volatile("s_waitcnt lgkmcnt(0)" ::: "memory"); \
    for (int d = 0; d < 4; ++d) for (int r = 0; r < 16; ++r) o[d][r] *= al_l[crow(r, hi)]; } } while (0)
  f32x16 pA0, pA1, pB0, pB1; float mnA, mnB, alA, alB; bf16x8 pa0, pa1, pa2, pa3;
  constexpr int SE = 0, SO = SDEPTH - 1;
  SLOAD(SE, 0); asm volatile("s_waitcnt vmcnt(0)" ::: "memory"); SWRITE(0, SE); __syncthreads();
  qkt(pA0, pA1, K_lds, qr, r32, hi); partialSM(pA0, pA1, m_reg, mnA, alA);
  SLOAD(SO, 1); if (2 < NT) SLOAD(SE, 2);
  SWAIT(); SWRITE(1, SO); __syncthreads();
  for (int j = 1; j + 1 < NT; j += 2) {
    SBAR(); qkt(pB0, pB1, (bf16_t*)((char*)K_lds + SHM_K), qr, r32, hi);
    finishSM(pA0, pA1, alA, l_reg, pa0, pa1, pa2, pa3); SBAR();
    SLOAD(SO, j + SDEPTH); SBAR();
    pv_d0(o, vb0, pa0, pa1, pa2, pa3); partialSM(pB0, pB1, m_reg, mnB, alB);
    __syncthreads(); SWAIT(); SWRITE(0, SE);
    RESC(alB); __syncthreads();
    SBAR(); qkt(pA0, pA1, K_lds, qr, r32, hi);
    finishSM(pB0, pB1, alB, l_reg, pa0, pa1, pa2, pa3); SBAR();
    if (j + 3 < NT) SLOAD(SE, j + 1 + SDEPTH); SBAR();
    pv_d0(o, vb0 + (int)SHM_V, pa0, pa1, pa2, pa3); partialSM(pA0, pA1, m_reg, mnA, alA);
    __syncthreads(); SWAIT(); SWRITE(1, SO);
    RESC(alA); __syncthreads();
  }
  SBAR(); qkt(pB0, pB1, (bf16_t*)((char*)K_lds + SHM_K), qr, r32, hi);
  finishSM(pA0, pA1, alA, l_reg, pa0, pa1, pa2, pa3); SBAR();
  pv_d0(o, vb0, pa0, pa1, pa2, pa3); partialSM(pB0, pB1, m_reg, mnB, alB);
  __syncthreads(); RESC(alB);
  finishSM(pB0, pB1, alB, l_reg, pa0, pa1, pa2, pa3); SBAR();
  pv_d0(o, vb0 + (int)SHM_V, pa0, pa1, pa2, pa3);
  if (hi == 0) li_l[r32] = l_reg; asm volatile("s_waitcnt lgkmcnt(0)" ::: "memory");
  float rli[16];
#pragma unroll
  for (int r = 0; r < 16; ++r) rli[r] = __builtin_amdgcn_rcpf(li_l[crow(r, hi)]);
  bf16_t* Ow = Ob + (long)(wid * QBLK) * ldo;
  {
    char* stg = lds + SHM_ATTN + wid * 8704;
#pragma unroll
    for (int r = 0; r < 16; ++r) { const int orow = crow(r, hi);
#pragma unroll
      for (int d0 = 0; d0 < 4; ++d0) *(bf16_t*)(stg + orow * 272 + (d0 * 32 + r32) * 2) = (bf16_t)(cvtpk(o[d0][r] * rli[r], 0.f) & 0xffffu); }
    asm volatile("s_waitcnt lgkmcnt(0)" ::: "memory");
#pragma unroll
    for (int i = 0; i < 8; ++i) { const int row = i * 4 + (lane >> 4), ch = lane & 15; const u32x4 v = *(const u32x4*)(stg + row * 272 + ch * 16); *(u32x4*)(Ow + (long)row * ldo + ch * 8) = v; }
  }
#undef SLOAD
#undef SWRITE
#undef SWAIT
#undef RESC
  __syncthreads();
}
#undef KSWZ
#undef SBAR
}

constexpr int NWAVES = 8;
constexpr int DM = 2048, NB = 8, SEQ = 2048, DEPTH = 4, CTXL = 256, DBR = 1024, DFF = 5632;
constexpr int ML = NB * SEQ, MC = NB * CTXL, MT = ML + MC;
constexpr int LDY = 4608, YQ = 0, YK = 1024, YV = 1280, YUX = 1536, YUG = 2560, YUF = 3584;
constexpr int LDG = 6144;
constexpr float NEPS = 1e-6f;
constexpr size_t MiB = 1u << 20;
constexpr size_t WS_CTL = 0, CTL_ZERO_BYTES = 1 * MiB;
constexpr size_t WS_MOD = 1 * MiB, WS_ROPE = 3 * MiB, WS_WLT = 4 * MiB, WS_CST = 6 * MiB, WS_SPT = 6 * MiB + 131072, WS_DFTC = 7 * MiB, WS_DFTL = 8 * MiB, WS_TW = 9 * MiB;
constexpr size_t WS_W = 24 * MiB, W_LAYER = 128 * MiB, WO_W1 = 0, WO_W8 = (size_t)4608 * 2048 * 2  , WO_WB = 42 * MiB, WO_WO = 54 * MiB, WO_WFI = 62 * MiB, WO_WFO = 106 * MiB;
constexpr size_t WS_X = 536 * MiB, WS_H = 680 * MiB, WS_Y1 = 752 * MiB, WS_G = 914 * MiB, WS_ACT = WS_G, WS_KN = 1130 * MiB;
constexpr size_t WS_PTL = 1139 * MiB, WS_BRS = WS_PTL, WS_PTC = 1203 * MiB, WS_ATT = 1211 * MiB, WS_REC = 1247 * MiB, WS_FOU = 1283 * MiB, WS_MG = 1319 * MiB, WS_SLAB = 1391 * MiB, WS_WBR = 1455 * MiB, WS_END = 1471 * MiB;
static_assert((size_t)MT * DBR * 2 == 36 * MiB && (size_t)MT * LDY * 2 == 162 * MiB && (size_t)MT * LDG * 2 == 216 * MiB && (size_t)MT * DM * 4 == 144 * MiB, "ws map");
constexpr int CMAX_FF = 6144 + 4608;
constexpr int CMAX_L = 6144 + 4608 + 11264;
constexpr size_t WO_UF8 = (size_t)1536 * 2048;
constexpr size_t WS_CMAX = 256 * 1024  , WS_SH = 640 * 1024  ;
constexpr size_t WS_H8 = WS_MG;
constexpr int CW_BAR = 4096;
constexpr int RING_BYTES = 147456;
constexpr int LDSCTL_OFF = RING_BYTES, MISC_OFF = LDSCTL_OFF + 320;
constexpr int LDS_BYTES = RING_BYTES + 1024;

#define GAS __attribute__((address_space(1)))
#define LAS __attribute__((address_space(3)))
typedef unsigned short bf16;
typedef unsigned v4u __attribute__((ext_vector_type(4)));
typedef float f32x4 __attribute__((ext_vector_type(4)));
typedef short bf16x8 __attribute__((ext_vector_type(8)));
typedef GAS unsigned gu32;
typedef GAS unsigned long long gu64;
#define RLX_AGENT __ATOMIC_RELAXED, __HIP_MEMORY_SCOPE_AGENT
#define LDS_WAIT() asm volatile("s_waitcnt lgkmcnt(0)" ::: "memory")
#define VM_WAIT() asm volatile("s_waitcnt vmcnt(0)" ::: "memory")
__device__ __forceinline__ unsigned long long rt() { return __builtin_amdgcn_s_memrealtime(); }
__device__ __forceinline__ unsigned f2bf(float f) { unsigned u = __builtin_bit_cast(unsigned, f); return (u + 0x7fffu + ((u >> 16) & 1u)) >> 16; }
__device__ __forceinline__ unsigned pk2(float lo, float hi) { return f2bf(lo) | (f2bf(hi) << 16); }

#define XB_TMO      128
#define XB_XCNT(j)  (256  + 64 * (j))
#define XB_XSUB(j)  (1280 + 64 * (j))
#define XB_XGEN(j)  (2304 + 64 * (j))
#define XB_TOP      3328
#define XB_TOPGEN   3392
#define XCD_BAR_WORDS 3456
#define XB_SPIN_CAP (1u << 18)

__device__ __forceinline__ unsigned xb_ld(unsigned* p)              { return __hip_atomic_load(p, __ATOMIC_RELAXED, __HIP_MEMORY_SCOPE_AGENT); }
__device__ __forceinline__ unsigned xb_add(unsigned* p, unsigned v) { return __hip_atomic_fetch_add(p, v, __ATOMIC_RELAXED, __HIP_MEMORY_SCOPE_AGENT); }
__device__ __forceinline__ unsigned xb_xcc_id() { return (unsigned)__builtin_amdgcn_s_getreg((3 << 11) | 20) & 0xFu; }
#define XB_SPIN(cond, bar) do { unsigned _sp = 0; while (cond) { __builtin_amdgcn_s_sleep(1); \
    if ((++_sp & 255u) == 0u) { if (xb_ld(&(bar)[XB_TMO])) break; if (_sp > XB_SPIN_CAP) { atomicAdd(&(bar)[XB_TMO], 1u); break; } } } } while (0)

struct XcdBarrier {
    unsigned* bar; unsigned x;
    volatile LAS unsigned* st;
};

__device__ __forceinline__ XcdBarrier xcd_barrier_post(unsigned* bar, volatile LAS unsigned* st) {
    XcdBarrier b; b.bar = bar; b.x = xb_xcc_id(); b.st = st;
    if (threadIdx.x == 0) (void)xb_add(&bar[XB_XCNT(b.x)], 1u);
    return b;
}
__device__ __forceinline__ void xcd_barrier_complete(unsigned* bar, unsigned x, unsigned& nloc, unsigned& nx) {
    const unsigned G = gridDim.x * gridDim.y * gridDim.z;
    unsigned sum, cnt, mine, sp = 0u;
    for (;;) {
        sum = 0u; cnt = 0u; mine = 0u;
#pragma unroll
        for (unsigned j = 0; j < 16; ++j) { const unsigned c = xb_ld(&bar[XB_XCNT(j)]); sum += c; cnt += (c > 0u) ? 1u : 0u; mine = (j == x) ? c : mine; }
        if (sum == G) break;
        __builtin_amdgcn_s_sleep(1);
        if ((++sp & 255u) == 0u) { if (xb_ld(&bar[XB_TMO])) break; if (sp > XB_SPIN_CAP) { atomicAdd(&bar[XB_TMO], 1u); break; } }
    }
    nloc = mine > 0u ? mine : 1u; nx = cnt > 0u ? cnt : 1u;
}

__device__ __forceinline__ void xcd_barrier(const XcdBarrier& b, const bool is_thread0) {
    asm volatile("s_waitcnt vmcnt(0)" ::: "memory");
    __syncthreads();
    if (is_thread0) {
        unsigned* bar = b.bar;
        __builtin_amdgcn_s_waitcnt(0);
        unsigned nloc = b.st[0], nx = b.st[1];
        if (nloc == 0u) { xcd_barrier_complete(bar, b.x, nloc, nx); b.st[0] = nloc; b.st[1] = nx; }
        const unsigned old = xb_add(&bar[XB_XSUB(b.x)], 1u);
        const unsigned gen = old / nloc;
        if (old + 1u == (gen + 1u) * nloc) {
            __builtin_amdgcn_fence(__ATOMIC_RELEASE, "agent");
            asm volatile("s_waitcnt vmcnt(0)" ::: "memory");
            const unsigned og = xb_add(&bar[XB_TOP], 1u);
            const unsigned tg = og / nx;
            if (og + 1u == (tg + 1u) * nx) xb_add(&bar[XB_TOPGEN], 1u);
            else XB_SPIN(xb_ld(&bar[XB_TOPGEN]) == tg, bar);
            __builtin_amdgcn_fence(__ATOMIC_ACQUIRE, "agent");
            xb_add(&bar[XB_XGEN(b.x)], 1u);
            asm volatile("s_waitcnt vmcnt(0)" ::: "memory");
        } else {
            XB_SPIN(xb_ld(&bar[XB_XGEN(b.x)]) == gen, bar);
            __builtin_amdgcn_fence(__ATOMIC_ACQUIRE, "agent");
            asm volatile("s_waitcnt vmcnt(0)" ::: "memory");
        }
    }
    __syncthreads();
}

using pg8::bf2f; using pg8::cvt_pk_bf16; using pg8::sigm; using pg8::bflo; using pg8::bfhi;
typedef float f32x16 __attribute__((ext_vector_type(16)));
typedef unsigned u32x2 __attribute__((ext_vector_type(2)));
__device__ __forceinline__ float dpp_f(float v, const int ctrl_sel) {
    const int x = __builtin_bit_cast(int, v); int r;
    if (ctrl_sel == 0) r = __builtin_amdgcn_mov_dpp(x, 0xB1, 0xF, 0xF, false); else if (ctrl_sel == 1) r = __builtin_amdgcn_mov_dpp(x, 0x4E, 0xF, 0xF, false);
    else if (ctrl_sel == 2) r = __builtin_amdgcn_mov_dpp(x, 0x141, 0xF, 0xF, false); else r = __builtin_amdgcn_mov_dpp(x, 0x140, 0xF, 0xF, false);
    return __builtin_bit_cast(float, r);
}
__device__ __forceinline__ float wave_max(float v) {
    v = fmaxf(v, dpp_f(v, 0)); v = fmaxf(v, dpp_f(v, 1)); v = fmaxf(v, dpp_f(v, 2)); v = fmaxf(v, dpp_f(v, 3));
    const int x = __builtin_bit_cast(int, v);
    const float r0 = __builtin_bit_cast(float, __builtin_amdgcn_readlane(x, 0)), r1 = __builtin_bit_cast(float, __builtin_amdgcn_readlane(x, 16));
    const float r2 = __builtin_bit_cast(float, __builtin_amdgcn_readlane(x, 32)), r3 = __builtin_bit_cast(float, __builtin_amdgcn_readlane(x, 48));
    return fmaxf(fmaxf(r0, r1), fmaxf(r2, r3));
}
__device__ __forceinline__ unsigned pack_i8x4(float a, float b, float c, float d, float inv) {
    const unsigned fa = __float_as_uint(fmaf(a, inv, 12582912.0f)), fb = __float_as_uint(fmaf(b, inv, 12582912.0f)), fc = __float_as_uint(fmaf(c, inv, 12582912.0f)), fd = __float_as_uint(fmaf(d, inv, 12582912.0f));
    const unsigned p01 = __builtin_amdgcn_perm(fb, fa, 0x0c0c0400u), p23 = __builtin_amdgcn_perm(fd, fc, 0x0c0c0400u);
    return __builtin_amdgcn_perm(p23, p01, 0x05040100u);
}
__device__ __forceinline__ float wave_sum(float v) {
    v += dpp_f(v, 0); v += dpp_f(v, 1); v += dpp_f(v, 2); v += dpp_f(v, 3);
    const int x = __builtin_bit_cast(int, v);
    const float r0 = __builtin_bit_cast(float, __builtin_amdgcn_readlane(x, 0)), r1 = __builtin_bit_cast(float, __builtin_amdgcn_readlane(x, 16));
    const float r2 = __builtin_bit_cast(float, __builtin_amdgcn_readlane(x, 32)), r3 = __builtin_bit_cast(float, __builtin_amdgcn_readlane(x, 48));
    return (r0 + r1) + (r2 + r3);
}
__device__ __forceinline__ float silu_f(float x) { return x / (1.0f + __expf(-x)); }
__device__ __forceinline__ float gelu_tanh(float x) { return x * sigm(1.5957691216057308f * (x + 0.044715f * x * x * x)); }

struct Params {
    const float *x, *c, *ctx, *c_ctx, *w_mod, *b_mod, *g_norm1, *g_norm2, *w_in, *q_gain, *k_gain, *conv_w, *conv_b, *lru_w_r, *lru_b_r, *lru_w_i, *lru_b_i, *lru_lambda,
                *w_branch, *w_gate, *b_gate, *w_out, *w_ffn_in, *w_ffn_out, *g_final;
    float* out; unsigned char* ws; int ph_lo, ph_hi;
};
typedef const __attribute__((address_space(4))) Params* KP;
__device__ __forceinline__ KP fresh_kp() { KP p = (KP)__builtin_amdgcn_kernarg_segment_ptr(); asm volatile("" : "+s"(p)); return p; }

__device__ __forceinline__ void tr_item(const float* W, int ldn, bf16* WT, int ldk, int k0, int n0, int drow0, LAS float* scr, int lane, bool rev = false) {
#pragma unroll 8
    for (int i = 0; i < 32; ++i) { const int kk = 2 * i + (lane >> 5); const int ks = k0 + kk, sr = rev ? ((ks & ~127) | ((128 - (ks & 127)) & 127)) : ks;
        scr[kk * 33 + (lane & 31)] = W[(size_t)sr * ldn + n0 + (lane & 31)]; }
    LDS_WAIT(); asm volatile("" ::: "memory");
    const int c = lane & 7;
#pragma unroll
    for (int j = 0; j < 4; ++j) { const int n = (lane >> 3) + 8 * j; const LAS float* s = scr + (8 * c) * 33 + n;
        v4u o; o.x = pk2(s[0 * 33], s[1 * 33]); o.y = pk2(s[2 * 33], s[3 * 33]); o.z = pk2(s[4 * 33], s[5 * 33]); o.w = pk2(s[6 * 33], s[7 * 33]);
        *(v4u*)(WT + (size_t)(drow0 + n) * ldk + k0 + 8 * c) = o; }
    LDS_WAIT(); asm volatile("" ::: "memory");
}

__device__ __forceinline__ void p0_prologue(KP P, LAS unsigned char* lds, int tid, int lane, int wave, int vcu, int G, int dupA, int dupB, int dupC) {
    unsigned char* ws = P->ws;
    {
        LAS float* SC = (LAS float*)lds;
        LAS float* red = (LAS float*)(lds + 73728);
        for (int i = tid; i < 9 * 2048; i += 512) { const int r = i >> 11, k = i & 2047; const float v = r < 8 ? P->c[r * 2048 + k] : P->c_ctx[k]; SC[i] = silu_f(v); }
        __syncthreads();
        float* MOD = (float*)(ws + WS_MOD);
        for (int unit_ = vcu; unit_ < 4 * 192 * dupA; unit_ += G) { const int unit = unit_ % 768;
            const int l = unit / 192, n0 = (unit % 192) * 64;
            const float* wp = P->w_mod + ((size_t)l * 2048 + wave * 256) * 12288 + n0 + lane;
            float acc[9];
#pragma unroll
            for (int r = 0; r < 9; ++r) acc[r] = 0.f;
            for (int k8 = 0; k8 < 256; k8 += 32) {
                float wv[32];
#pragma unroll
                for (int j = 0; j < 32; ++j) wv[j] = wp[(size_t)(k8 + j) * 12288];
#pragma unroll
                for (int j = 0; j < 32; ++j)
#pragma unroll
                    for (int r = 0; r < 9; ++r) acc[r] += SC[r * 2048 + wave * 256 + k8 + j] * wv[j];
            }
#pragma unroll
            for (int r = 0; r < 9; ++r) red[(wave * 9 + r) * 64 + lane] = acc[r];
            __syncthreads();
            for (int i = tid; i < 9 * 64; i += 512) { const int r = i >> 6, ln = i & 63; float s = 0.f;
#pragma unroll
                for (int w = 0; w < 8; ++w) s += red[(w * 9 + r) * 64 + ln];
                MOD[((size_t)l * 9 + r) * 12288 + n0 + ln] = s + P->b_mod[l * 12288 + n0 + ln]; }
            __syncthreads();
        }
    }
    {
        LAS float* scr = (LAS float*)(lds + wave * 16384);
        const int gw = vcu * NWAVES + wave, NGW = G * NWAVES;
        constexpr int PER_L = 32768 + 1024, NIT = 4 * PER_L + 512;
        for (int it_ = gw; it_ < NIT * dupB; it_ += NGW) { const int it = it_ % NIT;
            if (it < 4 * PER_L) {
                const int l = it / PER_L; int r = it % PER_L;
                unsigned char* wl = ws + WS_W + (size_t)l * W_LAYER;
                if (r < 4608) { const int kb = r / 144, nb = r % 144; if (nb < 48 || nb >= 112) continue;
                    tr_item(P->w_in + (size_t)l * 2048 * 4608, 4608, (bf16*)(wl + WO_W1), 2048, kb * 64, nb * 32, nb * 32, scr, lane); continue; } r -= 4608;
                if (r < 6144) { const int kb = r / 192, nb = r % 192; continue; }        r -= 6144;
                if (r < 3072) { const int br = r / 1024, rr = r % 1024, kb = rr / 64, nb = rr % 64;
                    tr_item(P->w_branch + ((size_t)l * 3 + br) * 1024 * 2048, 2048, (bf16*)(wl + WO_WB) + (size_t)br * 2048 * 1024, 1024, kb * 64, nb * 32, nb * 32, scr, lane); continue; } r -= 3072;
                if (r < 2048) { const int kb = r / 64, nb = r % 64; tr_item(P->w_out + (size_t)l * 2048 * 2048, 2048, (bf16*)(wl + WO_WO), 2048, kb * 64, nb * 32, nb * 32, scr, lane); continue; } r -= 2048;
                if (r < 11264) { continue; }        r -= 11264;
                if (r < 5632) { const int kb = r / 64, nb = r % 64; tr_item(P->w_ffn_out + (size_t)l * 5632 * 2048, 2048, (bf16*)(wl + WO_WFO), 5632, kb * 64, nb * 32, nb * 32, scr, lane); continue; } r -= 5632;
                { const int kb = r / 64, nb = r % 64; tr_item(P->w_branch + ((size_t)l * 3 + 2) * 1024 * 2048, 2048, (bf16*)(ws + WS_WBR + (size_t)l * 4 * MiB), 1024, kb * 64, nb * 32, nb * 32, scr, lane, true); }
            } else {
                const int r = it - 4 * PER_L, mat = r >> 1, nb = r & 1, gate = mat & 1, ldn = mat >> 1;
                const float* W = (gate ? P->lru_w_i : P->lru_w_r) + (size_t)ldn * 4096;
                tr_item(W, 64, (bf16*)(ws + WS_WLT) + (size_t)mat * 4096, 64, 0, nb * 32, nb * 32, scr, lane);
            }
        }
    }
    {
        __syncthreads();
        LAS float* scr = (LAS float*)(lds + wave * 16384);
        LAS float* red = (LAS float*)(lds + 131072);
        unsigned* CM = (unsigned*)(ws + WS_CMAX);
        const int c = lane & 15, rg = lane >> 4;
        for (int it = vcu; it < 4 * (384 + 96 + 64 + 704); it += G) {
            const int l = it / 1248, r = it % 1248; const bool gatew = r < 384, ffw = r >= 544, ufw = !ffw && r >= 480;
            const int n0 = gatew ? r * 16 : (ffw ? (r - 544) * 16 : (ufw ? 3584 + (r - 480) * 16 : (r - 384) * 16));
            int nd = ufw ? (r - 480) * 16 : n0;
            if (ffw) { const int half = n0 / 5632, j = n0 % 5632; nd = (j / 128) * 256 + half * 128 + (j % 128); }
            const float* W = gatew ? P->w_gate + (size_t)l * 2048 * 6144 : (ffw ? P->w_ffn_in + (size_t)l * 2048 * 11264 : P->w_in + (size_t)l * 2048 * 4608); const int ldn = gatew ? 6144 : (ffw ? 11264 : 4608);
            unsigned char* W8 = ws + WS_W + (size_t)l * W_LAYER + (gatew ? WO_W8 : (ffw ? WO_WFI : (ufw ? WO_W1 + WO_UF8 : WO_W1)));
            const int cidx = l * CMAX_L + (gatew ? n0 : (ffw ? CMAX_FF + nd : 6144 + n0));
            float r_[64];
#pragma unroll
            for (int i = 0; i < 64; ++i) r_[i] = W[(size_t)(wave * 256 + 4 * i + rg) * ldn + n0 + c];
            float mx = 0.f;
#pragma unroll
            for (int i = 0; i < 64; ++i) mx = fmaxf(mx, fabsf(r_[i]));
            red[wave * 64 + lane] = mx;
            __syncthreads();
            float m = 0.f;
#pragma unroll
            for (int w = 0; w < 8; ++w)
#pragma unroll
                for (int g4 = 0; g4 < 4; ++g4) m = fmaxf(m, red[w * 64 + g4 * 16 + c]);
            m = fmaxf(m, 1e-30f); const float inv = 127.0f / m;
            if (wave == 0 && rg == 0) CM[cidx + c] = __float_as_uint(m);
#pragma unroll
            for (int h = 0; h < 2; ++h) {
#pragma unroll
                for (int i = 0; i < 32; ++i) scr[(4 * i + rg) * 17 + c] = r_[32 * h + i];
                LDS_WAIT(); asm volatile("" ::: "memory");
                const LAS float* sp = scr + (32 * rg) * 17 + c;
                v4u o0, o1;
                o0.x = pack_i8x4(sp[0 * 17], sp[1 * 17], sp[2 * 17], sp[3 * 17], inv); o0.y = pack_i8x4(sp[4 * 17], sp[5 * 17], sp[6 * 17], sp[7 * 17], inv);
                o0.z = pack_i8x4(sp[8 * 17], sp[9 * 17], sp[10 * 17], sp[11 * 17], inv); o0.w = pack_i8x4(sp[12 * 17], sp[13 * 17], sp[14 * 17], sp[15 * 17], inv);
                o1.x = pack_i8x4(sp[16 * 17], sp[17 * 17], sp[18 * 17], sp[19 * 17], inv); o1.y = pack_i8x4(sp[20 * 17], sp[21 * 17], sp[22 * 17], sp[23 * 17], inv);
                o1.z = pack_i8x4(sp[24 * 17], sp[25 * 17], sp[26 * 17], sp[27 * 17], inv); o1.w = pack_i8x4(sp[28 * 17], sp[29 * 17], sp[30 * 17], sp[31 * 17], inv);
                unsigned char* dp = W8 + (size_t)(nd + c) * 2048 + wave * 256 + 128 * h + 32 * rg;
                *(v4u*)dp = o0; *(v4u*)(dp + 16) = o1;
                LDS_WAIT(); asm volatile("" ::: "memory");
            }
            __syncthreads();
        }
    }
    {
        const int gid = vcu * 512 + tid, NT = G * 512;
        float* ROPE = (float*)(ws + WS_ROPE);
        for (int i = gid; i < 2048 * 64; i += NT) { const int t = i >> 6, j = i & 63; const float pos = (float)(j < 32 ? (t >> 6) : (t & 63));
            const float inv = exp2f(-(float)(j & 31) * (13.287712379549449f / 32.0f)); const float ang = pos * inv; ROPE[i] = cosf(ang); ROPE[2048 * 64 + i] = sinf(ang); }
        float* SPT = (float*)(ws + WS_SPT);
        for (int i = gid; i < 4 * 2 * 1024; i += NT) SPT[i] = 8.0f * 1.4426950408889634f * log1pf(__expf(-P->lru_lambda[i]));
        bf16* CST = (bf16*)(ws + WS_CST);
        for (int i = gid; i < 256 * 128; i += NT) { const int col = i >> 7, cc = i & 127, s = col >> 7, m = col & 127; const float a = (float)((m * cc) & 127) * (2.0f / 128.0f);
            CST[i] = (bf16)f2bf(s ? sinpif(a) : cospif(a)); }
        bf16* DFTC = (bf16*)(ws + WS_DFTC);
        for (int i = gid; i < 256 * 512; i += NT) { const int k = i >> 9, cc = i & 511, s = cc >> 8, t = cc & 255; const float a = (float)((k * t) & 255) * (2.0f / 256.0f);
            DFTC[i] = (bf16)f2bf(s ? -sinpif(a) : cospif(a)); }
        bf16* DFTN = (bf16*)(ws + WS_DFTL);
        for (int i_ = gid; i_ < 256 * 1024 * dupC; i_ += NT) { const int i = i_ & (256 * 1024 - 1); const int k2 = i >> 10, cc = i & 1023, s = cc >> 9, t2 = cc & 511; const float a = (float)((k2 * t2) & 511) * (2.0f / 512.0f);
            DFTN[i] = (bf16)f2bf(s ? sinpif(a) : cospif(a)); }
        float* TW = (float*)(ws + WS_TW);
        for (int i = gid; i < 3 * 512; i += NT) { const int k1 = i / 512 + 1, t2 = i % 512; const float a = (float)(k1 * t2) * (2.0f / 2048.0f); TW[2 * i] = cospif(a); TW[2 * i + 1] = sinpif(a); }
    }
}

__device__ __forceinline__ void norm_rows(KP P, int l, int which, int nrows, bool slab, int lane, int wave, int vcu, int G, int dup) {
    unsigned char* ws = P->ws; bf16* X = (bf16*)(ws + WS_X); bf16* H = (bf16*)(ws + WS_H); const float* MOD = (const float*)(ws + WS_MOD);
    const float* gn = (which ? P->g_norm2 : P->g_norm1) + l * 2048;
    const bool first = (l == 0 && which == 0);
    const int gw = vcu * NWAVES + wave, NGW = G * NWAVES;
    f32x4 gq[8];
#pragma unroll
    for (int j = 0; j < 8; ++j) gq[j] = *(const f32x4*)(gn + ((j >> 1) * 64 + lane) * 8 + (j & 1) * 4);
    for (int m_ = gw; m_ < nrows * dup; m_ += NGW) { const int m = m_ % nrows;
        const int rsel = m < ML ? (m >> 11) : 8;
        const float* mv = MOD + ((size_t)l * 9 + rsel) * 12288 + (which ? 3 * 2048 : 0);
        f32x4 v[8], shq[8], scq[8]; float ss = 0.f;
        if (first) { const float* src = m < ML ? P->x + (size_t)m * DM : P->ctx + (size_t)(m - ML) * DM;
#pragma unroll
            for (int j = 0; j < 8; ++j) v[j] = *(const f32x4*)(src + ((j >> 1) * 64 + lane) * 8 + (j & 1) * 4);
        } else { const bf16* src = X + (size_t)m * DM;
            v4u xw[4];
#pragma unroll
            for (int jj = 0; jj < 4; ++jj) xw[jj] = *(const v4u*)(src + (jj * 64 + lane) * 8);
#pragma unroll
            for (int jj = 0; jj < 4; ++jj) { v[2 * jj] = (f32x4){bflo(xw[jj].x), bfhi(xw[jj].x), bflo(xw[jj].y), bfhi(xw[jj].y)}; v[2 * jj + 1] = (f32x4){bflo(xw[jj].z), bfhi(xw[jj].z), bflo(xw[jj].w), bfhi(xw[jj].w)}; }
        }
#pragma unroll
        for (int j = 0; j < 8; ++j) { const int col = ((j >> 1) * 64 + lane) * 8 + (j & 1) * 4; shq[j] = *(const f32x4*)(mv + col); scq[j] = *(const f32x4*)(mv + 2048 + col); }
        asm volatile("" ::: "memory");
#pragma unroll
        for (int j = 0; j < 8; ++j) ss += (v[j].x * v[j].x + v[j].y * v[j].y) + (v[j].z * v[j].z + v[j].w * v[j].w);
        const bool addslab = slab && m >= ML && m_ < nrows;
        if (addslab) { const float* SL = (const float*)(ws + WS_SLAB) + (size_t)(m - ML) * DM; ss = 0.f;
#pragma unroll
            for (int j = 0; j < 8; ++j) { const int col = ((j >> 1) * 64 + lane) * 8 + (j & 1) * 4;
                v[j] = (((v[j] + *(const f32x4*)(SL + col)) + *(const f32x4*)(SL + (size_t)2048 * 2048 + col)) + *(const f32x4*)(SL + (size_t)2 * 2048 * 2048 + col)) + *(const f32x4*)(SL + (size_t)3 * 2048 * 2048 + col);
                ss += (v[j].x * v[j].x + v[j].y * v[j].y) + (v[j].z * v[j].z + v[j].w * v[j].w); } }
        const float rstd = 1.0f / sqrtf(wave_sum(ss) * (1.0f / DM) + NEPS);
        f32x4 oq[8]; float amax = 0.f;
#pragma unroll
        for (int jj = 0; jj < 4; ++jj) { const int col = (jj * 64 + lane) * 8;
            if (first || addslab) { v4u xo; xo.x = cvt_pk_bf16(v[2 * jj].x, v[2 * jj].y); xo.y = cvt_pk_bf16(v[2 * jj].z, v[2 * jj].w); xo.z = cvt_pk_bf16(v[2 * jj + 1].x, v[2 * jj + 1].y); xo.w = cvt_pk_bf16(v[2 * jj + 1].z, v[2 * jj + 1].w);
                *(v4u*)(X + (size_t)m * DM + col) = xo; }
            const f32x4 o0 = v[2 * jj] * rstd * gq[2 * jj] * (scq[2 * jj] + 1.0f) + shq[2 * jj], o1 = v[2 * jj + 1] * rstd * gq[2 * jj + 1] * (scq[2 * jj + 1] + 1.0f) + shq[2 * jj + 1];
            if (!which) { v4u w; w.x = cvt_pk_bf16(o0.x, o0.y); w.y = cvt_pk_bf16(o0.z, o0.w); w.z = cvt_pk_bf16(o1.x, o1.y); w.w = cvt_pk_bf16(o1.z, o1.w);
                *(v4u*)(H + (size_t)m * DM + col) = w; }
            oq[2 * jj] = o0; oq[2 * jj + 1] = o1;
            amax = fmaxf(amax, fmaxf(fmaxf(fmaxf(fabsf(o0.x), fabsf(o0.y)), fmaxf(fabsf(o0.z), fabsf(o0.w))), fmaxf(fmaxf(fabsf(o1.x), fabsf(o1.y)), fmaxf(fabsf(o1.z), fabsf(o1.w))))); }
        {
            const float rmax = fmaxf(wave_max(amax), 1e-20f); const float inv = 127.0f / rmax;
#pragma unroll
            for (int jj = 0; jj < 4; ++jj) { u32x2 w8; w8.x = pack_i8x4(oq[2 * jj].x, oq[2 * jj].y, oq[2 * jj].z, oq[2 * jj].w, inv); w8.y = pack_i8x4(oq[2 * jj + 1].x, oq[2 * jj + 1].y, oq[2 * jj + 1].z, oq[2 * jj + 1].w, inv);
                *(u32x2*)(ws + WS_H8 + (size_t)m * DM + (jj * 64 + lane) * 8) = w8; }
            if (lane == 0) ((float*)(ws + WS_SH))[m] = rmax * (1.0f / 127.0f);
        }
    }
}
__device__ __forceinline__ void final_norm(KP P, int lane, int wave, int vcu, int G) {
    const bf16* X = (const bf16*)(P->ws + WS_X);
    const int gw = vcu * NWAVES + wave, NGW = G * NWAVES;
    for (int m = gw; m < ML; m += NGW) {
        const bf16* src = X + (size_t)m * DM; f32x4 v[8]; float ss = 0.f;
#pragma unroll
        for (int jj = 0; jj < 4; ++jj) { const v4u xw = *(const v4u*)(src + (jj * 64 + lane) * 8);
            v[2 * jj] = (f32x4){bflo(xw.x), bfhi(xw.x), bflo(xw.y), bfhi(xw.y)}; v[2 * jj + 1] = (f32x4){bflo(xw.z), bfhi(xw.z), bflo(xw.w), bfhi(xw.w)}; }
#pragma unroll
        for (int j = 0; j < 8; ++j) ss += (v[j].x * v[j].x + v[j].y * v[j].y) + (v[j].z * v[j].z + v[j].w * v[j].w);
        const float rstd = 1.0f / sqrtf(wave_sum(ss) * (1.0f / DM) + NEPS);
#pragma unroll
        for (int j = 0; j < 8; ++j) { const int col = ((j >> 1) * 64 + lane) * 8 + (j & 1) * 4; *(f32x4*)(P->out + (size_t)m * DM + col) = v[j] * rstd * *(const f32x4*)(P->g_final + col); }
    }
}

__device__ __forceinline__ void f1_units(KP P, bool last, LAS unsigned char* lds, int tid, int lane, int wave, int vcu, int G, int dup) {
    unsigned char* ws = P->ws; const bf16* Y1 = (const bf16*)(ws + WS_Y1); bf16* PTN = (bf16*)(ws + WS_PTL); bf16* PTC = (bf16*)(ws + WS_PTC);
    { const v4u* src = (const v4u*)(ws + WS_CST);
      for (int i = tid; i < 256 * 16; i += 512) { const int row = i >> 4, ch = i & 15; v4u t_ = src[i]; asm volatile("" : "+v"(t_)); *(LAS v4u*)(lds + row * 272 + ch * 16) = t_; } }
    __syncthreads();
    const int r = lane & 31, h = lane >> 5;
    const int gw = vcu * NWAVES + wave, NGW = G * NWAVES;
    const float* TW = (const float*)(ws + WS_TW);
    for (int wu_ = gw; wu_ < 4096 * dup; wu_ += NGW) {
        const int wu = wu_ & 4095; const int b = wu >> 9, tb = (wu >> 3) & 63, g = wu & 7;
        const bf16* ap = Y1 + (size_t)(b * 2048 + 512 * (r >> 3) + 8 * tb + (r & 7)) * LDY + YUF + g * 128 + h * 8;
        bf16x8 Af[8];
#pragma unroll
        for (int kk = 0; kk < 8; ++kk) Af[kk] = *(const bf16x8*)(ap + kk * 16);
        float twc[3][4], tws[3][4];
#pragma unroll
        for (int k1 = 0; k1 < 3; ++k1) { const f32x4 w0 = *(const f32x4*)(TW + 2 * (k1 * 512 + 8 * tb + 4 * h)), w1 = *(const f32x4*)(TW + 2 * (k1 * 512 + 8 * tb + 4 * h) + 4);
            twc[k1][0] = w0.x; tws[k1][0] = w0.y; twc[k1][1] = w0.z; tws[k1][1] = w0.w; twc[k1][2] = w1.x; tws[k1][2] = w1.y; twc[k1][3] = w1.z; tws[k1][3] = w1.w; }
#pragma unroll 1
        for (int cp = 0; cp < 4; ++cp) {
            f32x16 ac = {}, as = {};
#pragma unroll
            for (int kk = 0; kk < 8; ++kk) { const bf16x8 Bc = *(const LAS bf16x8*)(lds + (cp * 32 + r) * 272 + (kk * 16 + h * 8) * 2), Bs = *(const LAS bf16x8*)(lds + ((cp + 4) * 32 + r) * 272 + (kk * 16 + h * 8) * 2);
                ac = __builtin_amdgcn_mfma_f32_32x32x16_bf16(Af[kk], Bc, ac, 0, 0, 0); as = __builtin_amdgcn_mfma_f32_32x32x16_bf16(Af[kk], Bs, as, 0, 0, 0); }
            float ore[4][4], oim[4][4];
#pragma unroll
            for (int i = 0; i < 4; ++i) {
                const float z0r = ac[i], z1r = ac[4 + i], z2r = ac[8 + i], z3r = ac[12 + i], z0i = -as[i], z1i = -as[4 + i], z2i = -as[8 + i], z3i = -as[12 + i];
                const float ar = z0r + z2r, ai = z0i + z2i, br = z1r + z3r, bi = z1i + z3i, cr = z0r - z2r, ci = z0i - z2i, dr = z1r - z3r, di = z1i - z3i;
                ore[0][i] = ar + br; oim[0][i] = ai + bi;
                { const float wr = cr + di, wi = ci - dr; ore[1][i] = wr * twc[0][i] + wi * tws[0][i]; oim[1][i] = wi * twc[0][i] - wr * tws[0][i]; }
                { const float wr = ar - br, wi = ai - bi; ore[2][i] = wr * twc[1][i] + wi * tws[1][i]; oim[2][i] = wi * twc[1][i] - wr * tws[1][i]; }
                { const float wr = cr - di, wi = ci + dr; ore[3][i] = wr * twc[2][i] + wi * tws[2][i]; oim[3][i] = wi * twc[2][i] - wr * tws[2][i]; }
            }
            const int m = cp * 32 + r;
            bf16* dp = PTN + ((size_t)((b * 8 + g) * 128 + m)) * 1024 + 8 * tb + 4 * h;
#pragma unroll
            for (int k1 = 0; k1 < 4; ++k1) { u32x2 w; w.x = cvt_pk_bf16(ore[k1][0], ore[k1][1]); w.y = cvt_pk_bf16(ore[k1][2], ore[k1][3]); *(u32x2*)(dp + (size_t)k1 * 8192 * 1024) = w;
                u32x2 v; v.x = cvt_pk_bf16(oim[k1][0], oim[k1][1]); v.y = cvt_pk_bf16(oim[k1][2], oim[k1][3]); *(u32x2*)(dp + (size_t)k1 * 8192 * 1024 + 512) = v; }
        }
    }
    if (!last) {
    for (int wu_ = gw; wu_ < 512 * dup; wu_ += NGW) {
        const int wu = wu_ & 511; const int tt = 512 + (wu >> 3), g = wu & 7, m0 = tt * 32;
        const bf16* ap = Y1 + (size_t)(m0 + r) * LDY + YUF + g * 128 + h * 8;
        bf16x8 Af[8];
#pragma unroll
        for (int kk = 0; kk < 8; ++kk) Af[kk] = *(const bf16x8*)(ap + kk * 16);
        const int mc = m0 - ML, b = mc >> 8, t0 = mc & 255; bf16* base = PTC + (size_t)((b * 8 + g) * 128) * 512 + t0;
#pragma unroll 1
        for (int ct = 0; ct < 8; ++ct) {
            f32x16 acc = {};
#pragma unroll
            for (int kk = 0; kk < 8; ++kk) { const bf16x8 Bf = *(const LAS bf16x8*)(lds + (ct * 32 + r) * 272 + (kk * 16 + h * 8) * 2); acc = __builtin_amdgcn_mfma_f32_32x32x16_bf16(Af[kk], Bf, acc, 0, 0, 0); }
            const int s = ct >> 2, m = (ct & 3) * 32 + r;
            bf16* dp = base + (size_t)m * 512 + s * 256 + 4 * h;
#pragma unroll
            for (int q4 = 0; q4 < 4; ++q4) { u32x2 w; w.x = cvt_pk_bf16(acc[4 * q4], acc[4 * q4 + 1]); w.y = cvt_pk_bf16(acc[4 * q4 + 2], acc[4 * q4 + 3]); *(u32x2*)(dp + 8 * q4) = w; }
        }
    }
    }
}
__device__ __forceinline__ void knorm_units(KP P, int l, int lane, int wave, int vcu, int G, int dup) {
    unsigned char* ws = P->ws; const bf16* Y1 = (const bf16*)(ws + WS_Y1); bf16* KN = (bf16*)(ws + WS_KN); const float* ROPE = (const float*)(ws + WS_ROPE);
    const float g1 = P->k_gain[l * 128 + lane], g2 = P->k_gain[l * 128 + 64 + lane];
    const int gw = vcu * NWAVES + wave, NGW = G * NWAVES;
    for (int it0 = gw; it0 < MT * 2 * dup; it0 += 3 * NGW) {
        float k1[3], k2[3]; int mm[3], hh[3];
#pragma unroll
        for (int q = 0; q < 3; ++q) { const int it_ = it0 + q * NGW; const int it = (it_ < MT * 2 * dup ? it_ : gw) % (MT * 2); mm[q] = it >> 1; hh[q] = it & 1;
            const bf16* kp = Y1 + (size_t)mm[q] * LDY + YK + hh[q] * 128; k1[q] = bf2f(kp[lane]); k2[q] = bf2f(kp[64 + lane]); }
#pragma unroll
        for (int q = 0; q < 3; ++q) { if (it0 + q * NGW >= MT * 2 * dup) break;
            const int m = mm[q];
            const float rstd = 1.0f / sqrtf(wave_sum(k1[q] * k1[q] + k2[q] * k2[q]) * (1.0f / 128.0f) + NEPS);
            float a = k1[q] * rstd * g1, b = k2[q] * rstd * g2;
            if (m < ML) { const int t = m & 2047; const float c = ROPE[t * 64 + lane], s = ROPE[2048 * 64 + t * 64 + lane]; const float na = a * c - b * s, nb = b * c + a * s; a = na; b = nb; }
            bf16* op = KN + (size_t)m * 256 + hh[q] * 128;
            op[lane] = (bf16)(cvt_pk_bf16(a, 0.f) & 0xffffu); op[64 + lane] = (bf16)(cvt_pk_bf16(b, 0.f) & 0xffffu); }
    }
}
template <int D>
__device__ __forceinline__ void lru_sweep(const int b, const int nb, const int hc, LAS unsigned char* lds, const int lane, const int wave,
                                          const void* pY, const void* pR, const void* pF,
                                          const float cw0, const float cw1, const float cw2, const float cw3, const float cb, const float br, const float bi, const float sp) {
    const int j = lane & 31, hi = lane >> 5;
#define LRU_UNI(p_) ((void*)(((unsigned long long)(unsigned)__builtin_amdgcn_readfirstlane((int)(unsigned)((unsigned long long)(p_) >> 32)) << 32) | (unsigned long long)(unsigned)__builtin_amdgcn_readfirstlane((int)(unsigned)(unsigned long long)(p_))))
    const __amdgpu_buffer_rsrc_t rsY = __builtin_amdgcn_make_buffer_rsrc(LRU_UNI(pY), (short)0, (int)((size_t)MT * LDY * 2), 0x00020000);
    const __amdgpu_buffer_rsrc_t rsR = __builtin_amdgcn_make_buffer_rsrc(LRU_UNI(pR), (short)0, (int)((size_t)MT * 1024 * 2), 0x00020000);
    const __amdgpu_buffer_rsrc_t rsF = __builtin_amdgcn_make_buffer_rsrc(LRU_UNI(pF), (short)0, (int)((size_t)MT * 1024 * 2), 0x00020000);
#undef LRU_UNI
    LAS bf16* uS = (LAS bf16*)(lds + wave * 4608);
    LAS unsigned char* BL = lds + 36864;
    typedef float f32x2 __attribute__((ext_vector_type(2)));
    LAS f32x2* SUMS = (LAS f32x2*)(lds + 55296);
    const int chin = nb * 64 + lane, cho = nb * 64 + hc * 32 + j;
    constexpr float L2E = 1.4426950408889634f;
    const int arow = ((j >> 2) & 1) * 16 + (j & 3) + 4 * (j >> 3);
    const int voX = (YUX + chin) * 2, voG = (hi * 16 * LDY + YUG + cho) * 2, voR = (hi * 16 * 1024 + cho) * 2, voF = (hi * 16 * 1024 + cho) * 2;
#define LRU_GEOM(s_) const int q_ = (s_) * 8 + wave; const bool isc_ = q_ < 8; const int rowbase = isc_ ? ML + b * 256 : b * 2048, Lq = isc_ ? 256 : 2048, T0 = isc_ ? 32 * q_ : 32 * (q_ - 8)
#define LRU_ROWOFF(row_) ({ int rr_ = (row_); rr_ = rr_ < 0 ? 0 : (rr_ > MT - 1 ? MT - 1 : rr_); __builtin_amdgcn_readfirstlane(rr_ * (LDY * 2)); })
#define LRU_XLOAD(dst, s_) do { LRU_GEOM(s_); const int r0_ = rowbase + T0 - 2; \
        _Pragma("unroll") for (int i = 0; i < 35; ++i) dst[i] = __builtin_amdgcn_raw_buffer_load_b16(rsY, voX, LRU_ROWOFF(r0_ + i), 0); } while (0)
#define LRU_STEP(si_) (D == 0 ? (si_) : ((si_) == 0 ? 0 : 9 - (si_)))
    unsigned short xr[35];
    LRU_XLOAD(xr, LRU_STEP(0));
    float cstep = 0.f; int buf = 0;
#pragma unroll 1
    for (int si = 0; si < 9; ++si) {
        const int step = LRU_STEP(si);
        LRU_GEOM(step);
        {
          float xin[35];
#pragma unroll
          for (int i = 0; i < 35; ++i) { const int t = T0 - 2 + i; xin[i] = (t >= 0 && t < Lq) ? bf2f(xr[i]) : 0.f; }
#pragma unroll
          for (int i = 0; i < 32; ++i) uS[i * 72 + lane] = (bf16)(cvt_pk_bf16(cb + cw0 * xin[i] + cw1 * xin[i + 1] + cw2 * xin[i + 2] + cw3 * xin[i + 3], 0.f) & 0xffffu); }
        if (si < 8) { LRU_XLOAD(xr, LRU_STEP(si + 1)); }
        unsigned short hfv[16]; unsigned short ugr[16];
        if (D == 1) { const int r0 = rowbase + T0;
#pragma unroll
            for (int r = 0; r < 16; ++r) hfv[r] = __builtin_amdgcn_raw_buffer_load_b16(rsF, voF, __builtin_amdgcn_readfirstlane((r0 + r) * 2048), 0);
#pragma unroll
            for (int r = 0; r < 16; ++r) ugr[r] = __builtin_amdgcn_raw_buffer_load_b16(rsY, voG, __builtin_amdgcn_readfirstlane((r0 + r) * (LDY * 2)), 0); }
        asm volatile("" ::: "memory");
        LDS_WAIT(); asm volatile("" ::: "memory");
        f32x16 acc[2];
#pragma unroll
        for (int tl = 0; tl < 2; ++tl) acc[tl] = (f32x16){};
#pragma unroll
        for (int kk = 0; kk < 4; ++kk) {
            const bf16x8 Af = *(const LAS bf16x8*)(uS + arow * 72 + kk * 16 + hi * 8);
#pragma unroll
            for (int tl = 0; tl < 2; ++tl) acc[tl] = __builtin_amdgcn_mfma_f32_32x32x16_bf16(Af, *(const LAS bf16x8*)(BL + ((2 * D + tl) * 32 + j) * 144 + (kk * 16 + hi * 8) * 2), acc[tl], 0, 0, 0);
        }
        float yl[16], cp[16];
#define LRU_GATES(r0_, r1_, a0_, a1_, x0_, x1_) \
            const f32x2 u_ = {bf2f(uS[(hi * 16 + (r0_)) * 72 + hc * 32 + j]), bf2f(uS[(hi * 16 + (r1_)) * 72 + hc * 32 + j])}; \
            f32x2 e0_ = (f32x2){acc[0][r0_], acc[0][r1_]} * (-L2E) + br, e1_ = (f32x2){acc[1][r0_], acc[1][r1_]} * (-L2E) + bi; \
            e0_ = (f32x2){__builtin_amdgcn_exp2f(e0_.x), __builtin_amdgcn_exp2f(e0_.y)} + 1.0f; e1_ = (f32x2){__builtin_amdgcn_exp2f(e1_.x), __builtin_amdgcn_exp2f(e1_.y)} + 1.0f; \
            const f32x2 p_ = e0_ * e1_; const f32x2 ip_ = {__builtin_amdgcn_rcpf(p_.x), __builtin_amdgcn_rcpf(p_.y)}; \
            const f32x2 rg_ = ip_ * e1_, ig_ = ip_ * e0_, la_ = rg_ * (-sp); \
            const f32x2 av_ = {__builtin_amdgcn_exp2f(la_.x), __builtin_amdgcn_exp2f(la_.y)}; \
            f32x2 s_ = 1.0f - av_ * av_; s_ = (f32x2){__builtin_amdgcn_sqrtf(fmaxf(s_.x, 0.f)), __builtin_amdgcn_sqrtf(fmaxf(s_.y, 0.f))}; \
            const f32x2 xv_ = s_ * ig_ * u_; const float a0_ = av_.x, a1_ = av_.y, x0_ = xv_.x, x1_ = xv_.y
        float A = 1.f, Hs = 0.f;
        if (D == 0) {
#pragma unroll
            for (int r = 0; r < 16; r += 2) { LRU_GATES(r, r + 1, a0, a1, x0, x1);
                Hs = a0 * Hs + x0; A *= a0; yl[r] = Hs; cp[r] = A; Hs = a1 * Hs + x1; A *= a1; yl[r + 1] = Hs; cp[r + 1] = A; }
        } else {
#pragma unroll
            for (int r = 14; r >= 0; r -= 2) { LRU_GATES(r + 1, r, a0, a1, x0, x1);
                Hs = a0 * Hs + x0; A *= a0; yl[r + 1] = Hs; cp[r + 1] = A; Hs = a1 * Hs + x1; A *= a1; yl[r] = Hs; cp[r] = A; }
        }
#undef LRU_GATES
        const int myb = 2 * wave + hi;
        SUMS[(buf * 16 + myb) * 32 + j] = (f32x2){A, Hs};
        asm volatile("s_waitcnt lgkmcnt(0)" ::: "memory"); __builtin_amdgcn_s_barrier(); asm volatile("" ::: "memory");
        float c = cstep, cin = 0.f;
#pragma unroll
        for (int bq = 0; bq < 16; ++bq) { const int bb = D == 0 ? bq : 15 - bq; const f32x2 sv = SUMS[(buf * 16 + bb) * 32 + j]; cin = (bb == myb) ? c : cin; c = sv.x * c + sv.y; }
        cstep = c; buf ^= 1;
        const int r0 = rowbase + T0;
        if (D == 0) {
#pragma unroll
            for (int r = 0; r < 16; ++r) __builtin_amdgcn_raw_buffer_store_b16((unsigned short)(cvt_pk_bf16(yl[r] + cp[r] * cin, 0.f) & 0xffffu), rsF, voF, __builtin_amdgcn_readfirstlane((r0 + r) * 2048), 0);
        } else {
#pragma unroll
            for (int r = 0; r < 16; ++r) { const float y = bf2f(hfv[r]) + (yl[r] + cp[r] * cin); const float ug = bf2f(ugr[r]);
                __builtin_amdgcn_raw_buffer_store_b16((unsigned short)(cvt_pk_bf16(y * gelu_tanh(ug), 0.f) & 0xffffu), rsR, voR, __builtin_amdgcn_readfirstlane((r0 + r) * 2048), 0); }
        }
        LDS_WAIT(); asm volatile("" ::: "memory");
    }
#undef LRU_GEOM
#undef LRU_XLOAD
#undef LRU_ROWOFF
#undef LRU_STEP
}
__device__ __forceinline__ void lru_unit(KP P, int l, int b, int nb, int hc, LAS unsigned char* lds, int lane, int wave) {
    unsigned char* ws = P->ws; const bf16* Y1 = (const bf16*)(ws + WS_Y1); bf16* REC = (bf16*)(ws + WS_REC);
    const int j = lane & 31;
    LAS unsigned char* BL = lds + 36864;
    const int chin = nb * 64 + lane, cho = nb * 64 + hc * 32 + j;
    const float cw0 = P->conv_w[(l * 4 + 0) * 1024 + chin], cw1 = P->conv_w[(l * 4 + 1) * 1024 + chin], cw2 = P->conv_w[(l * 4 + 2) * 1024 + chin], cw3 = P->conv_w[(l * 4 + 3) * 1024 + chin];
    const float cb = P->conv_b[l * 1024 + chin];
    constexpr float L2E = 1.4426950408889634f;
    const float brf = -L2E * P->lru_b_r[(l * 2 + 0) * 1024 + cho], bif = -L2E * P->lru_b_i[(l * 2 + 0) * 1024 + cho], brb = -L2E * P->lru_b_r[(l * 2 + 1) * 1024 + cho], bib = -L2E * P->lru_b_i[(l * 2 + 1) * 1024 + cho];
    const float spf = ((const float*)(ws + WS_SPT))[(l * 2 + 0) * 1024 + cho], spb = ((const float*)(ws + WS_SPT))[(l * 2 + 1) * 1024 + cho];
    {
        const bf16* WLT = (const bf16*)(ws + WS_WLT); const int tid_ = wave * 64 + lane;
#pragma unroll
        for (int rep = 0; rep < 2; ++rep) { const int c16 = tid_ + rep * 512, row = c16 >> 3, ch = c16 & 7, tl = row >> 5, col = row & 31;
            const int mat = (((l * 2 + (tl >> 1)) * 16 + nb) * 2 + (tl & 1));
            v4u t_ = *(const v4u*)(WLT + (size_t)mat * 4096 + (hc * 32 + col) * 64 + ch * 8); asm volatile("" : "+v"(t_));
            *(LAS v4u*)(BL + row * 144 + ch * 16) = t_; }
        __syncthreads();
    }
    lru_sweep<0>(b, nb, hc, lds, lane, wave, (const void*)Y1, (const void*)REC, (const void*)(ws + WS_H), cw0, cw1, cw2, cw3, cb, brf, bif, spf);
    asm volatile("s_waitcnt vmcnt(0)" ::: "memory"); __syncthreads();
    lru_sweep<1>(b, nb, hc, lds, lane, wave, (const void*)Y1, (const void*)REC, (const void*)(ws + WS_H), cw0, cw1, cw2, cw3, cb, brb, bib, spb);
    __syncthreads();
}

struct MapAB { const char* A; const char* B; size_t astep, bstep; int pm0, pn0;
    __device__ __forceinline__ void operator()(pg8::Unit& u) const { u.pm += pm0; u.pn += pn0; u.A = A + (size_t)u.pm * astep; u.B = B + (size_t)u.pn * bstep; } };
struct MapBr { const char* A; const char* B; const char* BR;
    __device__ __forceinline__ void operator()(pg8::Unit& u) const { u.A = A + (size_t)u.aux * (36 * MiB) + (size_t)u.pm * (256 * 1024 * 2);
        const bool mir = u.aux == 2 && u.pm < 64 && (u.pm & 7) >= 4;
        u.B = (mir ? BR : B + (size_t)u.aux * (2048 * 1024 * 2)) + (size_t)u.pn * (256 * 1024 * 2); } };
__device__ __forceinline__ void nyquist_rows(unsigned char* ws, int lane, int wave, int vcu, int G) {
    const bf16* PTN = (const bf16*)(ws + WS_PTL); bf16* FOU = (bf16*)(ws + WS_FOU);
    const int gw = vcu * NWAVES + wave, NGW = G * NWAVES;
    for (int r = gw; r < 8192; r += NGW) {
        const v4u w = *(const v4u*)(PTN + (size_t)r * 1024 + lane * 8);
        float s = (bflo(w.x) - bfhi(w.x)) + (bflo(w.y) - bfhi(w.y)) + (bflo(w.z) - bfhi(w.z)) + (bflo(w.w) - bfhi(w.w));
        s = wave_sum(s) * 0.001953125f;
        if (lane == 0) FOU[(size_t)((r >> 10) * 2048 + 1024) * 1024 + (r & 1023)] = (bf16)(cvt_pk_bf16(s, 0.f) & 0xffffu);
    }
}
struct MapF2 { const char* A; const char* B;
    __device__ __forceinline__ void operator()(pg8::Unit& u) const { u.A = A; u.B = B + (size_t)u.pm * ((size_t)8192 * 1024 * 2) + (size_t)u.pn * (256 * 1024 * 2); } };

__global__ void __launch_bounds__(NWAVES * 64, 2) fwd_kernel(Params Pv) {
    extern __shared__ __attribute__((aligned(16))) unsigned char lds_raw[];
    LAS unsigned char* lds = (LAS unsigned char*)lds_raw;
    volatile LAS unsigned* MISC = (volatile LAS unsigned*)(lds + MISC_OFF);
    const int wave0 = __builtin_amdgcn_readfirstlane((int)threadIdx.x >> 6);
#define FRESH_TID() const KP P = fresh_kp(); (void)P; int wave = wave0; asm volatile("" : "+s"(wave)); int lane; asm volatile("v_mbcnt_lo_u32_b32 %0, -1, 0\n\tv_mbcnt_hi_u32_b32 %0, -1, %0" : "=v"(lane)); const int tid = (wave << 6) | lane; (void)tid
    const int G = gridDim.x; int vcu; { const int bx = blockIdx.x; vcu = (G % 8 == 0) ? (bx % 8) * (G / 8) + bx / 8 : bx; }
    unsigned char* ws = fresh_kp()->ws;
    gu32* ctl = (gu32*)(ws + WS_CTL);
    for (int u = (int)threadIdx.x; u < (LDS_BYTES - LDSCTL_OFF) / 4; u += NWAVES * 64) ((LAS unsigned*)(lds + LDSCTL_OFF))[u] = 0u;
    __syncthreads();
    XcdBarrier bar = xcd_barrier_post((unsigned*)(ctl + CW_BAR), MISC + 8);
#define GRID_BAR() do { XcdBarrier b2_ = bar; asm volatile("" : "+s"(b2_.bar), "+s"(b2_.x)); { FRESH_TID(); xcd_barrier(b2_, tid == 0); } } while (0)

#define H ((bf16*)(ws + WS_H))
#define Y1 ((bf16*)(ws + WS_Y1))
#define Gt ((bf16*)(ws + WS_G))
#define ACT ((bf16*)(ws + WS_ACT))
#define KN ((bf16*)(ws + WS_KN))
#define ATT ((bf16*)(ws + WS_ATT))
#define FOU ((bf16*)(ws + WS_FOU))
#define MG ((bf16*)(ws + WS_MG))
#define X ((bf16*)(ws + WS_X))
#define MOD ((const float*)(ws + WS_MOD))
#define ROPE ((const float*)(ws + WS_ROPE))

    const int ph_lo = fresh_kp()->ph_lo, ph_hi = fresh_kp()->ph_hi;
#define DUP(bit) ((((PROBE_MASK) >> (bit)) & 1) + 1)
#define IN(k) (ph_lo <= (k) && (k) < ph_hi)
#define SEAM(k) do { if (IN(k) && IN((k) + 1)) { GRID_BAR(); if (DUP(14) > 1) GRID_BAR(); } } while (0)
    if (IN(0)) { FRESH_TID(); p0_prologue(P, lds, tid, lane, wave, vcu, G, DUP(8), DUP(9), DUP(10)); }
    SEAM(0);

#pragma unroll 1
    for (int l = 0; l < DEPTH; ++l) {
        const bool last = (l == DEPTH - 1);
        const int nMt = last ? 64 : 72;
        const unsigned char* wl = ws + WS_W + (size_t)l * W_LAYER;
        const int pb = 1 + 9 * l;
        if (IN(pb + 0)) { FRESH_TID(); norm_rows(P, l, 0, MT, l > 0, lane, wave, vcu, G, DUP(11)); }
        SEAM(pb + 0);
        if (IN(pb + 1)) {
            pg8::EpiG1T<false> E{Y1, Gt, fresh_kp()->b_gate + l * 6144, (const float*)(ws + WS_SH), (const unsigned*)(ws + WS_CMAX) + l * CMAX_L};
            pg8::EpiG1T<true> EG{Y1, Gt, fresh_kp()->b_gate + l * 6144, (const float*)(ws + WS_SH), (const unsigned*)(ws + WS_CMAX) + l * CMAX_L};
            pg8::EpiG1T<false, true> EQ{Y1, Gt, fresh_kp()->b_gate + l * 6144, (const float*)(ws + WS_SH), (const unsigned*)(ws + WS_CMAX) + l * CMAX_L};
            const int bx = (int)blockIdx.x;
            if (!last) {
                pg8::TileOrder<MapAB> S; S.map = MapAB{(const char*)H, (const char*)(wl + WO_W1), (size_t)256 * 2048 * 2, (size_t)256 * 2048 * 2, 0, 6}; S.init(72, 8, G, bx, 1, DUP(1));
                { FRESH_TID(); pg8::gemm_phase<pg8::EpiG1T<false>, pg8::TileOrder<MapAB>, true, true>(lds, pg8::Gemm{2048, 2048, 2048}, S, E, tid); }
            } else {
                pg8::TileOrder<MapAB> S; S.map = MapAB{(const char*)H, (const char*)(wl + WO_W1), (size_t)256 * 2048 * 2, (size_t)256 * 2048 * 2, 0, 6}; S.init(64, 8, G, bx, 1, DUP(1));
                { FRESH_TID(); pg8::gemm_phase<pg8::EpiG1T<false>, pg8::TileOrder<MapAB>, true, true>(lds, pg8::Gemm{2048, 2048, 2048}, S, E, tid); }
                pg8::TileOrder<MapAB> S2; S2.map = MapAB{(const char*)H, (const char*)(wl + WO_W1), (size_t)256 * 2048 * 2, (size_t)256 * 2048 * 2, 64, 6}; S2.init(8, 4, G, (bx + G / 2) % G, 1, 1);
                { FRESH_TID(); pg8::gemm_phase<pg8::EpiG1T<false>, pg8::TileOrder<MapAB>, true, true>(lds, pg8::Gemm{2048, 2048, 2048}, S2, E, tid); }
            }
            {
                pg8::TileOrder<MapAB> SQ; SQ.map = MapAB{(const char*)(ws + WS_H8), (const char*)(wl + WO_W1), (size_t)256 * 2048, (size_t)256 * 2048, 0, 0};
                SQ.init(72, 6, G, G == 256 ? (bx + 96) % G : bx, 1, 1);
                { FRESH_TID(); pg8::gemm_phase<pg8::EpiG1T<false, true>, pg8::TileOrder<MapAB>, true, true, 2>(lds, pg8::Gemm{1024, 1024, 1024}, SQ, EQ, tid); }
            }
            {
                pg8::TileOrder<MapAB> SU; SU.map = MapAB{(const char*)(ws + WS_H8), (const char*)(wl + WO_W1 + WO_UF8) - (size_t)14 * 256 * 2048, (size_t)256 * 2048, (size_t)256 * 2048, 0, 14};
                SU.init(last ? 64 : 72, 4, G, G == 256 ? (bx + 40) % G : bx, 1, 1);
                { FRESH_TID(); pg8::gemm_phase<pg8::EpiG1T<false, true>, pg8::TileOrder<MapAB>, true, true, 2>(lds, pg8::Gemm{1024, 1024, 1024}, SU, EQ, tid); }
            }
            {
                pg8::TileOrder<MapAB> S8; S8.map = MapAB{(const char*)(ws + WS_H8), (const char*)(wl + WO_W8) - (size_t)18 * 256 * 2048, (size_t)256 * 2048, (size_t)256 * 2048, 0, 18};
                S8.init(last ? 64 : 72, 24, G, G == 256 ? (bx + 192) % G : bx, 1, DUP(1));
                { FRESH_TID(); pg8::gemm_phase<pg8::EpiG1T<true>, pg8::TileOrder<MapAB>, true, true, 2>(lds, pg8::Gemm{1024, 1024, 1024}, S8, EG, tid); }
            }
        }
        SEAM(pb + 1);
        if (IN(pb + 2)) {
        { FRESH_TID(); f1_units(P, last, lds, tid, lane, wave, vcu, G, DUP(2)); }
        { FRESH_TID(); knorm_units(P, l, lane, wave, vcu, G, DUP(2)); }
        __syncthreads();
        { FRESH_TID(); for (int u_ = vcu; u_ < 256 * DUP(6); u_ += G) { const int u = u_ & 255; lru_unit(P, l, u >> 5, (u >> 1) & 15, u & 1, lds, lane, wave); } }
        }
        SEAM(pb + 2);
        if (IN(pb + 3)) {
            const bool evn = (vcu & 1) == 0; const int pr = vcu >> 1;
            { FRESH_TID(); if (G != 256) nyquist_rows(ws, lane, wave, vcu, G); else if (!evn) nyquist_rows(ws, lane, wave, pr, 128); }
            { FRESH_TID();
            const int nctx = (G == 256) ? ((!evn && !last && pr < 64) ? 1 : 0) : 0;
            const int ntot = (G == 256) ? 2 + nctx : 0;
            for (int ui_ = 0; ui_ < ntot * DUP(3); ++ui_) { const int ui = ui_ % ntot;
                const int U = ui < 2 ? 2 * vcu + ui : 512 + pr;
                const bf16 *Qb, *K0, *K1, *V0, *V1; bf16* Ob; int n0, NT; const float* rope;
                if (U < 512) { const int bh = U >> 3, qb = U & 7, b = bh >> 3, h = bh & 7, kvh = h >> 2; const size_t r0 = (size_t)b * 2048, rc = (size_t)ML + b * 256;
                    Qb = Y1 + (r0 + qb * 256) * LDY + YQ + h * 128; K0 = KN + r0 * 256 + kvh * 128; K1 = KN + rc * 256 + kvh * 128;
                    V0 = Y1 + r0 * LDY + YV + kvh * 128; V1 = Y1 + rc * LDY + YV + kvh * 128; n0 = 32; NT = 36; Ob = ATT + (r0 + qb * 256) * 1024 + h * 128; rope = ROPE + (size_t)qb * 256 * 64; }
                else { const int uc = U - 512, b = uc >> 3, h = uc & 7, kvh = h >> 2; const size_t rc = (size_t)ML + b * 256;
                    Qb = Y1 + rc * LDY + YQ + h * 128; K0 = KN + rc * 256 + kvh * 128; K1 = K0; V0 = Y1 + rc * LDY + YV + kvh * 128; V1 = V0; n0 = 4; NT = 4; Ob = ATT + rc * 1024 + h * 128; rope = nullptr; }
                att::attn_unit(Qb, LDY, K0, K1, V0, V1, n0, NT, 256, LDY, Ob, 1024, P->q_gain + l * 128, rope, (char*)lds_raw, tid);
            }
            if (G != 256) {
                const int nun = last ? 512 : 576;
                for (int U = vcu; U < nun; U += G) {
                    const bf16 *Qb, *K0, *K1, *V0, *V1; bf16* Ob; int n0, NT; const float* rope;
                    if (U < 512) { const int bh = U >> 3, qb = U & 7, b = bh >> 3, h = bh & 7, kvh = h >> 2; const size_t r0 = (size_t)b * 2048, rc = (size_t)ML + b * 256;
                        Qb = Y1 + (r0 + qb * 256) * LDY + YQ + h * 128; K0 = KN + r0 * 256 + kvh * 128; K1 = KN + rc * 256 + kvh * 128;
                        V0 = Y1 + r0 * LDY + YV + kvh * 128; V1 = Y1 + rc * LDY + YV + kvh * 128; n0 = 32; NT = 36; Ob = ATT + (r0 + qb * 256) * 1024 + h * 128; rope = ROPE + (size_t)qb * 256 * 64; }
                    else { const int uc = U - 512, b = uc >> 3, h = uc & 7, kvh = h >> 2; const size_t rc = (size_t)ML + b * 256;
                        Qb = Y1 + rc * LDY + YQ + h * 128; K0 = KN + rc * 256 + kvh * 128; K1 = K0; V0 = Y1 + rc * LDY + YV + kvh * 128; V1 = V0; n0 = 4; NT = 4; Ob = ATT + rc * 1024 + h * 128; rope = nullptr; }
                    att::attn_unit(Qb, LDY, K0, K1, V0, V1, n0, NT, 256, LDY, Ob, 1024, P->q_gain + l * 128, rope, (char*)lds_raw, tid);
                }
            }
            }
            __syncthreads();
            const int cF = (G == 256) ? (evn ? pr : 1 << 20) : (int)blockIdx.x;
            {
                pg8::TileOrder<MapF2> S; S.map = MapF2{(const char*)(ws + WS_DFTL), (const char*)(ws + WS_PTL)}; S.init(4, 32, G, cF, 1, DUP(5));
                pg8::EpiF2 E{FOU, 2048, 0, 1, 0.001953125f, 1};
                { FRESH_TID(); pg8::gemm_phase<pg8::EpiF2, pg8::TileOrder<MapF2>, true, true>(lds, pg8::Gemm{1024, 1024, 1024}, S, E, tid); }
            }
            if (!last) {
                pg8::TileOrder<MapAB> S; S.map = MapAB{(const char*)(ws + WS_DFTC), (const char*)(ws + WS_PTC), (size_t)256 * 512 * 2, (size_t)256 * 512 * 2, 0, 0}; S.init(1, 32, G, (G == 256) ? (!evn && pr >= 64 && pr < 96 ? pr - 64 : 1 << 20) : (int)blockIdx.x, 1, DUP(5));
                pg8::EpiF2 E{FOU, 256, ML, 0, 0.005524271728019903f, 0};
                { FRESH_TID(); pg8::gemm_phase<pg8::EpiF2, pg8::TileOrder<MapAB>, true, true>(lds, pg8::Gemm{512, 512, 512}, S, E, tid); }
            }
        }
        SEAM(pb + 3);
        if (IN(pb + 4)) {
            pg8::TileOrder<MapBr> S; S.map = MapBr{(const char*)ATT, (const char*)(wl + WO_WB), (const char*)(ws + WS_WBR + (size_t)l * 4 * MiB)}; S.init(nMt, 8, G, (int)blockIdx.x, 3, DUP(4));
            pg8::EpiBr E{Gt, MG};
            { FRESH_TID(); pg8::gemm_phase<pg8::EpiBr, pg8::TileOrder<MapBr>, true, true>(lds, pg8::Gemm{1024, 1024, 1024}, S, E, tid); }
        }
        SEAM(pb + 4);
        if (IN(pb + 5)) {
            pg8::TileOrder<MapAB> S; S.map = MapAB{(const char*)MG, (const char*)(wl + WO_WO), (size_t)256 * 2048 * 2, (size_t)256 * 2048 * 2, 0, 0}; S.init(64, 8, G, (int)blockIdx.x, 1, DUP(12));
            pg8::EpiRes E{X, MOD + (size_t)l * 9 * 12288 + 2 * 2048, (bf16*)(ws + WS_Y1)};
            { FRESH_TID(); pg8::gemm_phase<pg8::EpiRes, pg8::TileOrder<MapAB>, true, true>(lds, pg8::Gemm{2048, 2048, 2048}, S, E, tid); }
            if (!last) {
                pg8::QuarterOrder Q{G, (int)blockIdx.x, (const char*)MG, (const char*)(wl + WO_WO), (size_t)256 * 2048 * 2, (size_t)256 * 2048 * 2, (size_t)512 * 2};
                pg8::EpiResSlab EA{(float*)(ws + WS_SLAB), MOD + (size_t)l * 9 * 12288 + 2 * 2048};
                { FRESH_TID(); pg8::gemm_phase<pg8::EpiResSlab, pg8::QuarterOrder, true, true>(lds, pg8::Gemm{512, 2048, 2048}, Q, EA, tid); }
            }
        }
        SEAM(pb + 5);
        if (IN(pb + 6)) { FRESH_TID(); norm_rows(P, l, 1, nMt * 256, true, lane, wave, vcu, G, DUP(11)); }
        SEAM(pb + 6);
        if (IN(pb + 7)) {
            pg8::TileOrder<MapAB> S; S.map = MapAB{(const char*)(ws + WS_H8), (const char*)(wl + WO_WFI), (size_t)256 * 2048, (size_t)256 * 2048, 0, 0}; S.init(nMt, 44, G, (int)blockIdx.x, 1, DUP(7));
            pg8::EpiSwi8 E{ACT, (const float*)(ws + WS_SH), (const unsigned*)(ws + WS_CMAX) + l * CMAX_L + CMAX_FF};
            { FRESH_TID(); pg8::gemm_phase<pg8::EpiSwi8, pg8::TileOrder<MapAB>, true, true, 2>(lds, pg8::Gemm{1024, 1024, 1024}, S, E, tid); }
        }
        SEAM(pb + 7);
        if (IN(pb + 8)) {
            pg8::TileOrder<MapAB> S; S.map = MapAB{(const char*)ACT, (const char*)(wl + WO_WFO), (size_t)256 * 5632 * 2, (size_t)256 * 5632 * 2, 0, 0}; S.init(64, 8, G, (int)blockIdx.x, 1, DUP(13));
            pg8::EpiRes E{X, MOD + (size_t)l * 9 * 12288 + 5 * 2048, (bf16*)(ws + WS_Y1)};
            { FRESH_TID(); pg8::gemm_phase<pg8::EpiRes, pg8::TileOrder<MapAB>, true, true>(lds, pg8::Gemm{5632, 5632, 5632}, S, E, tid); }
            if (!last) {
                pg8::QuarterOrder Q{G, (int)blockIdx.x, (const char*)ACT, (const char*)(wl + WO_WFO), (size_t)256 * 5632 * 2, (size_t)256 * 5632 * 2, (size_t)1408 * 2};
                pg8::EpiResSlab EA{(float*)(ws + WS_SLAB), MOD + (size_t)l * 9 * 12288 + 5 * 2048};
                { FRESH_TID(); pg8::gemm_phase<pg8::EpiResSlab, pg8::QuarterOrder, true, true>(lds, pg8::Gemm{1408, 5632, 5632}, Q, EA, tid); }
            }
        }
        SEAM(pb + 8);
    }
    if (IN(37)) { FRESH_TID(); final_norm(P, lane, wave, vcu, G); }
#undef IN
#undef SEAM
#undef GRID_BAR
#undef H
#undef Y1
#undef Gt
#undef ACT
#undef KN
#undef ATT
#undef FOU
#undef MG
#undef X
#undef MOD
#undef ROPE
}

extern "C" void kernel_launch(void* const* d_in, const int* in_sizes, int n_in, void* d_out, int out_size, void* d_ws, size_t ws_size, hipStream_t stream) {
    static int grid = 0;
    if (grid == 0) {
        if (n_in != 25 || out_size != ML * DM || ws_size < WS_END) { fprintf(stderr, "kernel_launch: unexpected shapes (n_in %d out %d ws %zu, need %zu)\n", n_in, out_size, ws_size, (size_t)WS_END); grid = -1; return; }
        int dev = 0, cus = 0, per_cu = 0;
        if (hipGetDevice(&dev) != hipSuccess || hipDeviceGetAttribute(&cus, hipDeviceAttributeMultiprocessorCount, dev) != hipSuccess) { grid = -1; return; }
        if (hipFuncSetAttribute((const void*)fwd_kernel, hipFuncAttributeMaxDynamicSharedMemorySize, LDS_BYTES) != hipSuccess) { fprintf(stderr, "kernel_launch: hipFuncSetAttribute failed\n"); grid = -1; return; }
        if (hipOccupancyMaxActiveBlocksPerMultiprocessor(&per_cu, (const void*)fwd_kernel, NWAVES * 64, LDS_BYTES) != hipSuccess || per_cu < 1) fprintf(stderr, "kernel_launch: occupancy query reports %d\n", per_cu);
        (void)hipGetLastError();
        grid = cus > 256 ? 256 : cus;
    }
    if (grid < 0) return;
    if (hipMemsetAsync((char*)d_ws + WS_CTL, 0, CTL_ZERO_BYTES, stream) != hipSuccess) return;
    Params p{};
    const float** pf = (const float**)&p;
    for (int i = 0; i < 25; ++i) pf[i] = (const float*)d_in[i];
    p.out = (float*)d_out; p.ws = (unsigned char*)d_ws;
#ifndef MK_CUT_EVERY
#define MK_CUT_EVERY 0
#endif
    constexpr int NPH = 38;
    for (int lo = 0; lo < NPH;) {
        const int hi = MK_CUT_EVERY ? lo + 1 : NPH;
        p.ph_lo = lo; p.ph_hi = hi;
        if (lo > 0 && hipMemsetAsync((char*)d_ws + WS_CTL, 0, CTL_ZERO_BYTES, stream) != hipSuccess) return;
        hipLaunchKernelGGL(fwd_kernel, dim3(grid), dim3(NWAVES * 64), LDS_BYTES, stream, p);
        const hipError_t le = hipPeekAtLastError();
        if (le != hipSuccess) { fprintf(stderr, "kernel_launch: launch failed: %s\n", hipGetErrorName(le)); return; }
        lo = hi;
    }
}
```
